# Optimizing an MI355X kernel written in HIP

```python
import math
import jax, jax.numpy as jnp
from jax import lax
import numpy as np

D_MODEL = 1024
BATCH = 1
SEQ = 16384
DEPTH = 2

MLA_HEADS = 8
MLA_Q_LORA = 256
MLA_KV_LORA = 128
MLA_NOPE = 64
MLA_ROPE = 32
MLA_V = 64
Q_BLOCK = 128
ROPE_THETA = 10000.0
SWA_HEADS = 8
SWA_KV_HEADS = 2
SWA_HD = 64
WINDOW = 128
BLOCK = 128
REL_BUCKETS = 32
REL_MAX_DIST = 128
MEM_LEN = 256
MEM_HEADS = 4
MEM_HD = 128
N_BRANCH = 3
D_FF = 4 * D_MODEL
EPS = 1e-6

IN_SIZES = (
    MLA_Q_LORA,
    MLA_KV_LORA + MLA_ROPE,
    SWA_HEADS * SWA_HD,
    SWA_KV_HEADS * SWA_HD,
    SWA_KV_HEADS * SWA_HD,
    MEM_HEADS * MEM_HD,
    N_BRANCH * D_MODEL,
)
IN_COLS = sum(IN_SIZES)

kernel_name = "hybrid_mla_swa_mem_gated_block"


def rms_norm(x, g):
    x32 = x.astype(jnp.float32)
    y = x32 * lax.rsqrt(jnp.mean(x32 * x32, axis=-1, keepdims=True) + EPS)
    return y.astype(x.dtype) * g


def split_points():
    pts, acc = [], 0
    for s in IN_SIZES[:-1]:
        acc += s
        pts.append(acc)
    return pts


def rope_tables(seq):
    pos = jnp.arange(seq, dtype=jnp.float32)
    inv = 1.0 / (ROPE_THETA ** (jnp.arange(0, MLA_ROPE, 2, dtype=jnp.float32) / MLA_ROPE))
    ang = pos[:, None] * inv[None, :]
    return jnp.cos(ang), jnp.sin(ang)


def apply_rope(t, cos, sin):
    cos = cos.astype(t.dtype)
    sin = sin.astype(t.dtype)
    t1, t2 = jnp.split(t, 2, axis=-1)
    return jnp.concatenate([t1 * cos - t2 * sin, t2 * cos + t1 * sin], axis=-1)


def t5_bucket(dist):
    n = jnp.maximum(dist, 0)
    max_exact = REL_BUCKETS // 2
    nf = jnp.maximum(n, 1).astype(jnp.float32)
    large = max_exact + (jnp.log(nf / max_exact) / math.log(REL_MAX_DIST / max_exact)
                         * (REL_BUCKETS - max_exact)).astype(jnp.int32)
    large = jnp.minimum(large, REL_BUCKETS - 1)
    return jnp.where(n < max_exact, n, large)


def mla_attention(q_nope, q_rope, k_nope, k_rope, v):
    B, S = q_nope.shape[0], q_nope.shape[1]
    nb = S // Q_BLOCK
    scale = (MLA_NOPE + MLA_ROPE) ** -0.5
    k_pos = jnp.arange(S)

    def to_blocks(t):
        return jnp.moveaxis(t.reshape(B, nb, Q_BLOCK, *t.shape[2:]), 1, 0)

    def one_block(args):
        qn, qr, i = args
        s = (jnp.einsum('bqhd,bkhd->bhqk', qn, k_nope)
             + jnp.einsum('bqhd,bkd->bhqk', qr, k_rope)).astype(jnp.float32) * scale
        q_pos = i * Q_BLOCK + jnp.arange(Q_BLOCK)
        s = jnp.where(k_pos[None, :] <= q_pos[:, None], s, -jnp.inf)
        p = jax.nn.softmax(s, axis=-1).astype(v.dtype)
        return jnp.einsum('bhqk,bkhd->bqhd', p, v)

    out = lax.map(one_block, (to_blocks(q_nope), to_blocks(q_rope), jnp.arange(nb)))
    return jnp.moveaxis(out, 0, 1).reshape(B, S, MLA_HEADS * MLA_V)


def swa_attention(q, k, v, rel_bias, sinks):
    B, S = q.shape[0], q.shape[1]
    nb = S // BLOCK
    G, R = SWA_KV_HEADS, SWA_HEADS // SWA_KV_HEADS
    qb = q.reshape(B, nb, BLOCK, G, R, SWA_HD)
    kb = k.reshape(B, nb, BLOCK, G, SWA_HD)
    vb = v.reshape(B, nb, BLOCK, G, SWA_HD)

    def with_prev(t):
        prev = jnp.pad(t, ((0, 0), (1, 0), (0, 0), (0, 0), (0, 0)))[:, :-1]
        return jnp.concatenate([prev, t], axis=2)

    kk, vv = with_prev(kb), with_prev(vb)
    s = jnp.einsum('bnqgrd,bnkgd->bngrqk', qb, kk).astype(jnp.float32) * (SWA_HD ** -0.5)

    qi = jnp.arange(BLOCK)[:, None]
    kj = jnp.arange(2 * BLOCK)[None, :]
    dist = qi + BLOCK - kj
    bias = rel_bias.astype(jnp.float32)[t5_bucket(dist)]
    bias = jnp.transpose(bias, (2, 0, 1)).reshape(G, R, BLOCK, 2 * BLOCK)
    band = (dist >= 0) & (dist < WINDOW)
    has_prev = (jnp.arange(nb) > 0)[:, None, None] | (kj >= BLOCK)[None]
    valid = band[None] & has_prev
    s = jnp.where(valid[None, :, None, None], s + bias, -jnp.inf)

    sink = jnp.broadcast_to(sinks.astype(jnp.float32).reshape(1, 1, G, R, 1, 1),
                            s.shape[:-1] + (1,))
    p = jax.nn.softmax(jnp.concatenate([s, sink], axis=-1), axis=-1)[..., :-1].astype(v.dtype)
    o = jnp.einsum('bngrqk,bnkgd->bnqgrd', p, vv)
    return o.reshape(B, S, SWA_HEADS * SWA_HD)


def mem_attention(q, km, vm):
    B, S = q.shape[0], q.shape[1]
    s = jnp.einsum('bshd,bmhd->bhsm', q, km).astype(jnp.float32) * (MEM_HD ** -0.5)
    p = jax.nn.softmax(s, axis=-1).astype(vm.dtype)
    return jnp.einsum('bhsm,bmhd->bshd', p, vm).reshape(B, S, MEM_HEADS * MEM_HD)


def setup_inputs(seed: int = 0) -> dict:
    key = jax.random.key(seed)
    ks = jax.random.split(key, 24)

    def nrm(k, shape, scale):
        return jax.random.normal(k, shape, jnp.float32) * scale

    def gain(k, shape):
        return 1.0 + 0.02 * jax.random.normal(k, shape, jnp.float32)

    L, D = DEPTH, D_MODEL
    return {
        "x": nrm(ks[0], (BATCH, SEQ, D), 1.0),
        "mem": nrm(ks[1], (BATCH, MEM_LEN, D), 1.0),
        "rel_bias": nrm(ks[2], (REL_BUCKETS, SWA_HEADS), 0.5),
        "attn_norm": gain(ks[3], (L, D)),
        "mem_norm": gain(ks[4], (L, D)),
        "w_in": nrm(ks[5], (L, D, IN_COLS), D ** -0.5),
        "b_gate": nrm(ks[6], (L, N_BRANCH * D), 0.02),
        "mla_q_norm": gain(ks[7], (L, MLA_Q_LORA)),
        "w_uq": nrm(ks[8], (L, MLA_Q_LORA, MLA_HEADS * (MLA_NOPE + MLA_ROPE)), MLA_Q_LORA ** -0.5),
        "mla_kv_norm": gain(ks[9], (L, MLA_KV_LORA)),
        "w_ukv": nrm(ks[10], (L, MLA_KV_LORA, MLA_HEADS * (MLA_NOPE + MLA_V)), MLA_KV_LORA ** -0.5),
        "attn_sinks": nrm(ks[11], (L, SWA_HEADS), 0.5),
        "w_mem_kv": nrm(ks[12], (L, D, 2 * MEM_HEADS * MEM_HD), D ** -0.5),
        "w_o_mla": nrm(ks[13], (L, MLA_HEADS * MLA_V, D), (MLA_HEADS * MLA_V) ** -0.5),
        "w_o_swa": nrm(ks[14], (L, SWA_HEADS * SWA_HD, D), (SWA_HEADS * SWA_HD) ** -0.5),
        "w_o_mem": nrm(ks[15], (L, MEM_HEADS * MEM_HD, D), (MEM_HEADS * MEM_HD) ** -0.5),
        "w_out": nrm(ks[16], (L, D, D), D ** -0.5),
        "mlp_norm": gain(ks[17], (L, D)),
        "w_up": nrm(ks[18], (L, D, D_FF), D ** -0.5),
        "w_down": nrm(ks[19], (L, D_FF, D), D_FF ** -0.5),
        "final_norm": gain(ks[20], (D,)),
    }


def reference(x, mem, rel_bias, attn_norm, mem_norm, w_in, b_gate, mla_q_norm, w_uq,
              mla_kv_norm, w_ukv, attn_sinks, w_mem_kv, w_o_mla, w_o_swa, w_o_mem,
              w_out, mlp_norm, w_up, w_down, final_norm):
    B, S, D = x.shape
    cos, sin = rope_tables(S)
    pts = split_points()

    for l in range(DEPTH):
        h = rms_norm(x, attn_norm[l])
        proj = h @ w_in[l]
        c_q, kv_a, q_s, k_s, v_s, q_m, gates = jnp.split(proj, pts, axis=-1)

        c_q = rms_norm(c_q, mla_q_norm[l])
        q = (c_q @ w_uq[l]).reshape(B, S, MLA_HEADS, MLA_NOPE + MLA_ROPE)
        q_nope = q[..., :MLA_NOPE]
        q_pe = apply_rope(q[..., MLA_NOPE:], cos[:, None, :], sin[:, None, :])
        c_kv = rms_norm(kv_a[..., :MLA_KV_LORA], mla_kv_norm[l])
        k_pe = apply_rope(kv_a[..., MLA_KV_LORA:], cos, sin)
        kv = (c_kv @ w_ukv[l]).reshape(B, S, MLA_HEADS, MLA_NOPE + MLA_V)
        o_mla = mla_attention(q_nope, q_pe, kv[..., :MLA_NOPE], k_pe, kv[..., MLA_NOPE:])

        o_swa = swa_attention(q_s.reshape(B, S, SWA_HEADS, SWA_HD),
                              k_s.reshape(B, S, SWA_KV_HEADS, SWA_HD),
                              v_s.reshape(B, S, SWA_KV_HEADS, SWA_HD),
                              rel_bias, attn_sinks[l])

        mn = rms_norm(mem, mem_norm[l])
        kvm = (mn @ w_mem_kv[l]).reshape(mem.shape[0], MEM_LEN, 2, MEM_HEADS, MEM_HD)
        o_mem = mem_attention(q_m.reshape(B, S, MEM_HEADS, MEM_HD), kvm[:, :, 0], kvm[:, :, 1])

        g = jax.nn.sigmoid(gates + b_gate[l]).reshape(B, S, N_BRANCH, D)
        y = (g[..., 0, :] * (o_mla @ w_o_mla[l])
             + g[..., 1, :] * (o_swa @ w_o_swa[l])
             + g[..., 2, :] * (o_mem @ w_o_mem[l]))
        x = x + y @ w_out[l]

        h = rms_norm(x, mlp_norm[l])
        x = x + jnp.square(jax.nn.relu(h @ w_up[l])) @ w_down[l]

    return rms_norm(x, final_norm)
```

```cpp
#include <hip/hip_runtime.h>
#include <hip/hip_cooperative_groups.h>
#include <cstdio>
#include <cstdint>
namespace cg = cooperative_groups;
namespace pg8 {
#define PG8_LAS __attribute__((address_space(3)))
typedef unsigned short bf16_t;
typedef short bf16x8 __attribute__((ext_vector_type(8)));
typedef float f32x4 __attribute__((ext_vector_type(4)));
typedef unsigned u32x4 __attribute__((ext_vector_type(4)));
constexpr int BM = 256, BK = 64, HALF = 128, HTB = HALF * BK * 2  , STAGE_BYTES = 8 * HTB, NXCD = 8, WGM = 8;

__host__ __device__ __forceinline__ int lds_byte(int r, int c) { const int st = (r >> 4) * 2 + (c >> 5), rr = r & 15, cc = c & 31, ob = rr * 64 + cc * 2; return st * 1024 + (ob ^ (((ob >> 9) & 1) << 5)); }
__host__ __device__ __forceinline__ void stage_rc(int b, int& R, int& C) { const int st = b / 1024, sb = b % 1024, swz = sb ^ (((sb >> 9) & 1) << 5); R = (st >> 1) * 16 + swz / 64; C = (st & 1) * 32 + (swz % 64) / 2; }
__host__ __device__ __forceinline__ int perm32(int rho) { const int n = rho >> 4, i = rho & 15; return 8 * (i >> 2) + 4 * n + (i & 3); }

struct Unit { int pm, pn; };
struct Gemm { const bf16_t* A; const bf16_t* Bt; int M, N, K; };

struct StaticOrder {
    int nM, nN, nwg, G, c;
    __host__ __device__ void init(int M, int N, int G_, int c_) { nM = M / BM; nN = N / BM; nwg = nM * nN; G = G_; c = c_; }
    __host__ __device__ bool next(int i, Unit& u) const {
        const long L = (long)i * G + c; if (L >= nwg) return false;
        int wgid = (int)L; { const int q = nwg / NXCD, r = nwg % NXCD, xcd = wgid % NXCD, off = wgid / NXCD; wgid = (xcd < r ? xcd * (q + 1) : r * (q + 1) + (xcd - r) * q) + off; }
        const int nig = WGM * nN, gid = wgid / nig, fm = gid * WGM, gsz = (nM - fm) < WGM ? (nM - fm) : WGM;
        u.pm = fm + ((wgid % nig) % gsz); u.pn = (wgid % nig) / gsz; return true;
    }
    __device__ __forceinline__ void a_ready(const Unit&) const {}
    __device__ __forceinline__ void done(const Unit&) const {}
};

__device__ __forceinline__ unsigned cvt_pk_bf16(float lo, float hi) { unsigned r; asm volatile("v_cvt_pk_bf16_f32 %0, %1, %2" : "=v"(r) : "v"(lo), "v"(hi)); return r; }
typedef float f32x2 __attribute__((ext_vector_type(2)));
template <class Epi, class Sched, bool ALIGN_EPI = false, bool SP2 = false>
__device__ __forceinline__ void gemm_phase(PG8_LAS unsigned char* lds, const Gemm g, const Sched& S, const Epi& E) {
    const int tid = threadIdx.x, wid = __builtin_amdgcn_readfirstlane(tid >> 6), lane = tid & 63, wr = wid >> 2, wc = wid & 3, fr = lane & 15, fq = lane >> 4;
    const int K = g.K, nt = K / BK;
    unsigned voffA[2], voffB[2];
#pragma unroll
    for (int i = 0; i < 2; ++i) { int R, C; stage_rc(tid * 16 + i * 8192, R, C); const int Rb = Epi::PERM ? ((R & ~31) + perm32(R & 31)) : R;
        voffA[i] = (unsigned)(R * K + C) * 2u; voffB[i] = (unsigned)(Rb * K + C) * 2u; }
    const size_t kstep = (size_t)(BK * 2);
    const size_t hstep = (size_t)HALF * K * 2;
    const size_t tstep = 2 * hstep;
    const unsigned ldsw = (unsigned)wid * 1024u;
    const int aoff = lds_byte(wr * 64 + fr, fq * 8), boff = lds_byte(wc * 32 + fr, fq * 8);
#define PG8_SA(b, h) (((b) * 2 + (h)) * HTB)
#define PG8_SB(b, h) ((4 + (b) * 2 + (h)) * HTB)
#define PG8_STAGE(bufoff, gbase, voff) do { _Pragma("unroll") for (int _i = 0; _i < 2; ++_i) \
        __builtin_amdgcn_global_load_lds((const unsigned*)((const char*)(gbase) + (voff)[_i]), (PG8_LAS unsigned*)(lds + (bufoff) + ldsw + _i * 8192), 16, 0, 0); } while (0)
#define PG8_LDA(dst, b, h) do { _Pragma("unroll") for (int m = 0; m < 4; ++m) _Pragma("unroll") for (int k = 0; k < 2; ++k) dst[m][k] = *(const PG8_LAS bf16x8*)(lds + PG8_SA(b, h) + aoff + m * 2048 + k * 1024); } while (0)
#define PG8_LDB(dst, b, h) do { _Pragma("unroll") for (int n = 0; n < 2; ++n) _Pragma("unroll") for (int k = 0; k < 2; ++k) dst[n][k] = *(const PG8_LAS bf16x8*)(lds + PG8_SB(b, h) + boff + n * 2048 + k * 1024); } while (0)
#define PG8_MMA(ai, bj, At, Bt) do { __builtin_amdgcn_s_setprio(1); _Pragma("unroll") for (int m = 0; m < 4; ++m) _Pragma("unroll") for (int n = 0; n < 2; ++n) _Pragma("unroll") for (int k = 0; k < 2; ++k) \
        acc[ai][bj][m][n] = __builtin_amdgcn_mfma_f32_16x16x32_bf16(Bt[n][k], At[m][k], acc[ai][bj][m][n], 0, 0, 0); __builtin_amdgcn_s_setprio(0); } while (0)
#define PG8_WAIT_V(n) asm volatile("s_waitcnt vmcnt(" #n ")" ::: "memory")
#define PG8_WAIT_L(n) asm volatile("s_waitcnt lgkmcnt(" #n ")" ::: "memory")
#define PG8_BAR __builtin_amdgcn_s_barrier()
#define PG8_SCHED __builtin_amdgcn_sched_barrier(0)
    Unit cur, nxt; int ui = 0;
    if (!S.next(0, cur)) return;
    f32x4 acc[2][2][4][2];
#pragma unroll
    for (int a = 0; a < 2; ++a)
#pragma unroll
        for (int b = 0; b < 2; ++b)
#pragma unroll
            for (int m = 0; m < 4; ++m)
#pragma unroll
                for (int n = 0; n < 2; ++n) acc[a][b][m][n] = (f32x4){0.f, 0.f, 0.f, 0.f};
    bf16x8 At[4][2], B0[2][2], B1[2][2];
    const char* cA = (const char*)g.A + (size_t)cur.pm * tstep; const char* cB = (const char*)g.Bt + (size_t)cur.pn * tstep;
    S.a_ready(cur);
    if constexpr (SP2) {
        PG8_STAGE(PG8_SB(0, 0), cB, voffB); PG8_STAGE(PG8_SB(0, 1), cB + hstep, voffB); PG8_STAGE(PG8_SA(0, 0), cA, voffA); PG8_STAGE(PG8_SA(0, 1), cA + hstep, voffA);
        if (wr == 1) PG8_BAR;
        PG8_WAIT_V(2); PG8_BAR;
        PG8_STAGE(PG8_SB(1, 0), cB + kstep, voffB); PG8_STAGE(PG8_SA(1, 0), cA + kstep, voffA); PG8_STAGE(PG8_SB(1, 1), cB + hstep + kstep, voffB);
        PG8_WAIT_V(6); PG8_BAR;
    } else {
        PG8_STAGE(PG8_SB(0, 0), cB, voffB); PG8_STAGE(PG8_SA(0, 0), cA, voffA); PG8_STAGE(PG8_SB(0, 1), cB + hstep, voffB); PG8_STAGE(PG8_SA(0, 1), cA + hstep, voffA);
        if (wr == 1) PG8_BAR;
        PG8_WAIT_V(4); PG8_BAR;
        PG8_STAGE(PG8_SB(1, 0), cB + kstep, voffB); PG8_STAGE(PG8_SA(1, 0), cA + kstep, voffA); PG8_STAGE(PG8_SB(1, 1), cB + hstep + kstep, voffB);
        PG8_WAIT_V(6); PG8_BAR;
    }
    for (;;) {
        const bool has_next = S.next(ui + 1, nxt);
        const char* nA = has_next ? (const char*)g.A + (size_t)nxt.pm * tstep : cA; const char* nB = has_next ? (const char*)g.Bt + (size_t)nxt.pn * tstep : cB;
        for (int t = 0; t < nt; t += 2) {
            const bool last = (t == nt - 2);
            const char* a1 = cA + (size_t)(t + 1) * kstep;
            const char* a2 = last ? nA : cA + (size_t)(t + 2) * kstep; const char* b2 = last ? nB : cB + (size_t)(t + 2) * kstep;
            const char* a3 = a2 + kstep; const char* b3 = b2 + kstep;
            if (last && has_next) S.a_ready(nxt);
            if constexpr (SP2) {
            PG8_LDB(B0, 0, 0); PG8_LDB(B1, 0, 1); PG8_SCHED; PG8_LDA(At, 0, 0); PG8_STAGE(PG8_SA(1, 1), a1 + hstep, voffA);
            PG8_WAIT_V(8); PG8_WAIT_L(0); PG8_BAR; PG8_MMA(0, 0, At, B0); PG8_MMA(0, 1, At, B1); PG8_BAR; PG8_SCHED;
            PG8_LDA(At, 0, 1); PG8_STAGE(PG8_SB(0, 0), b2, voffB); PG8_STAGE(PG8_SB(0, 1), b2 + hstep, voffB); PG8_STAGE(PG8_SA(0, 0), a2, voffA);
            PG8_WAIT_V(8); PG8_WAIT_L(0); PG8_BAR; PG8_MMA(1, 0, At, B0); PG8_MMA(1, 1, At, B1); PG8_BAR; PG8_SCHED;
            PG8_LDB(B0, 1, 0); PG8_LDB(B1, 1, 1); PG8_SCHED; PG8_LDA(At, 1, 0); PG8_STAGE(PG8_SA(0, 1), a2 + hstep, voffA);
            PG8_WAIT_V(8); PG8_WAIT_L(0); PG8_BAR; PG8_MMA(0, 0, At, B0); PG8_MMA(0, 1, At, B1); PG8_BAR; PG8_SCHED;
            PG8_LDA(At, 1, 1); PG8_STAGE(PG8_SB(1, 0), b3, voffB); PG8_STAGE(PG8_SB(1, 1), b3 + hstep, voffB); PG8_STAGE(PG8_SA(1, 0), a3, voffA);
            PG8_WAIT_V(8); PG8_WAIT_L(0); PG8_BAR; PG8_MMA(1, 0, At, B0); PG8_MMA(1, 1, At, B1); PG8_BAR; PG8_SCHED;
            } else {
            PG8_LDB(B0, 0, 0); PG8_SCHED; PG8_LDA(At, 0, 0); PG8_STAGE(PG8_SA(1, 1), a1 + hstep, voffA);
            PG8_WAIT_L(8); PG8_BAR; PG8_WAIT_L(0); PG8_MMA(0, 0, At, B0); PG8_BAR; PG8_SCHED;
            PG8_LDB(B1, 0, 1); PG8_STAGE(PG8_SB(0, 0), b2, voffB);
            PG8_BAR; PG8_WAIT_L(0); PG8_MMA(0, 1, At, B1); PG8_BAR;
            PG8_LDA(At, 0, 1); PG8_STAGE(PG8_SA(0, 0), a2, voffA);
            PG8_BAR; PG8_WAIT_L(0); PG8_MMA(1, 0, At, B0); PG8_BAR; PG8_SCHED;
            PG8_STAGE(PG8_SB(0, 1), b2 + hstep, voffB);
            PG8_WAIT_V(6); PG8_BAR; PG8_MMA(1, 1, At, B1); PG8_BAR;
            PG8_LDB(B0, 1, 0); PG8_SCHED; PG8_LDA(At, 1, 0); PG8_STAGE(PG8_SA(0, 1), a2 + hstep, voffA);
            PG8_WAIT_L(8); PG8_BAR; PG8_WAIT_L(0); PG8_MMA(0, 0, At, B0); PG8_BAR; PG8_SCHED;
            PG8_LDB(B1, 1, 1); PG8_STAGE(PG8_SB(1, 0), b3, voffB);
            PG8_BAR; PG8_WAIT_L(0); PG8_MMA(0, 1, At, B1); PG8_BAR;
            PG8_LDA(At, 1, 1); PG8_STAGE(PG8_SA(1, 0), a3, voffA);
            PG8_BAR; PG8_WAIT_L(0); PG8_MMA(1, 0, At, B0); PG8_BAR; PG8_SCHED;
            PG8_STAGE(PG8_SB(1, 1), b3 + hstep, voffB);
            PG8_WAIT_V(6); PG8_BAR; PG8_MMA(1, 1, At, B1); PG8_BAR;
            }
        }
        if constexpr (ALIGN_EPI) { if (wr == 0) PG8_BAR; }
        if constexpr (!Epi::AFTER_DRAIN) { E(acc, cur, wr, wc, fr, fq); S.done(cur); }
        if (!has_next) break;
#pragma unroll
        for (int a = 0; a < 2; ++a)
#pragma unroll
            for (int b = 0; b < 2; ++b)
#pragma unroll
                for (int m = 0; m < 4; ++m)
#pragma unroll
                    for (int n = 0; n < 2; ++n) acc[a][b][m][n] = (f32x4){0.f, 0.f, 0.f, 0.f};
        cur = nxt; cA = nA; cB = nB; ++ui;
        if constexpr (ALIGN_EPI) { if (wr == 1) PG8_BAR; }
    }
    PG8_WAIT_V(0);
    if constexpr (!ALIGN_EPI) { if (wr == 0) PG8_BAR; }
    PG8_BAR;
    if constexpr (Epi::AFTER_DRAIN) { E.fused(acc, cur, wr, wc, fr, fq, lds, wid, lane); S.done(cur); }
#undef PG8_SA
#undef PG8_SB
#undef PG8_STAGE
#undef PG8_LDA
#undef PG8_LDB
#undef PG8_MMA
#undef PG8_WAIT_V
#undef PG8_WAIT_L
#undef PG8_BAR
#undef PG8_SCHED
}
}

typedef unsigned short bf16_t;
typedef short bf16x8 __attribute__((ext_vector_type(8)));
typedef float f32x4 __attribute__((ext_vector_type(4)));
typedef float f32x2 __attribute__((ext_vector_type(2)));
typedef float f32x16 __attribute__((ext_vector_type(16)));
typedef unsigned u32x4 __attribute__((ext_vector_type(4)));
typedef unsigned u32x2 __attribute__((ext_vector_type(2)));
typedef __bf16 bf16x2_t __attribute__((ext_vector_type(2)));
#define LAS __attribute__((address_space(3)))

constexpr int S = 16384, D = 1024, DFF = 4096, NL = 2, MEML = 256;
constexpr int INCOLS = 4768;
constexpr float EPS = 1e-6f;
constexpr float LOG2E = 1.4426950408889634f;
constexpr float QS_SCALE = 0.125f * LOG2E;
constexpr float QM_SCALE = 0.08838834764831845f * LOG2E;
constexpr float QMLA_SCALE = 0.10206207261596575f * LOG2E;

constexpr size_t W_IN = 0;
constexpr size_t W_G = W_IN + (size_t)1792 * 1024;
constexpr size_t W_UQ = W_G + (size_t)3072 * 1024;
constexpr size_t W_UKV = W_UQ + (size_t)768 * 256;
constexpr size_t W_MEM = W_UKV + (size_t)1024 * 128;
constexpr size_t W_O = W_MEM + (size_t)1024 * 1024;
constexpr size_t W_OUT = W_O + (size_t)3 * 1024 * 512;
constexpr size_t W_UP = W_OUT + (size_t)1024 * 1024;
constexpr size_t W_DOWN = W_UP + (size_t)4096 * 1024;
constexpr size_t W_LAYER_ELEMS = W_DOWN + (size_t)1024 * 4096;
constexpr size_t MiB = 1u << 20;
constexpr size_t W_LAYER_BYTES = 34 * MiB;
static_assert(W_LAYER_ELEMS * 2 <= W_LAYER_BYTES, "weights");
constexpr size_t WS_W = 0;
constexpr size_t WS_XB = 68 * MiB;
constexpr size_t WS_SMALL = 100 * MiB;
constexpr size_t WS_RS = WS_SMALL;
constexpr size_t WS_RSTDM = WS_RS + 9 * (size_t)S * 4;
constexpr size_t WS_BIAS = WS_RSTDM + 1024;
constexpr size_t WS_ROPE = WS_BIAS + 4096;
constexpr size_t WS_MEMB = WS_ROPE + (size_t)S * 16 * 8;
constexpr size_t WS_KMEM = WS_MEMB + (size_t)256 * 1024 * 2;
constexpr size_t WS_VMEM = WS_KMEM + (size_t)256 * 512 * 2;
constexpr size_t WS_PTAB = WS_VMEM + (size_t)256 * 512 * 2;
constexpr size_t WS_BG = WS_PTAB + 64;
constexpr size_t WS_SINK = WS_BG + 2 * 3072 * 4;
constexpr size_t WS_FN = WS_SINK + 64;
static_assert(WS_FN + 4096 <= 104 * MiB, "small region");
constexpr size_t WS_H = 104 * MiB;
constexpr size_t WS_QMLA = 104 * MiB;
constexpr size_t WS_KMLA = 128 * MiB;
constexpr size_t WS_VMLA = 152 * MiB;
constexpr size_t WS_QS = 168 * MiB;
constexpr size_t WS_KS = 184 * MiB;
constexpr size_t WS_VS = 188 * MiB;
constexpr size_t WS_QM = 192 * MiB;
constexpr size_t WS_CQ = 208 * MiB;
constexpr size_t WS_CKV = 216 * MiB;
constexpr size_t WS_OMLA = 220 * MiB;
constexpr size_t WS_T = 104 * MiB;
constexpr size_t WS_YB = 136 * MiB;
static_assert(WS_OMLA + (size_t)S * 512 * 2 <= 256 * MiB, "ws");

struct Args {
    const float* in[21];
    float* out; unsigned char* ws;
};
enum { I_X = 0, I_MEM, I_RELB, I_ATTN_NORM, I_MEM_NORM, I_W_IN, I_B_GATE, I_QNORM, I_W_UQ, I_KVNORM, I_W_UKV, I_SINKS, I_W_MEMKV, I_WO_MLA, I_WO_SWA, I_WO_MEM, I_W_OUT, I_MLP_NORM, I_W_UP, I_W_DOWN, I_FNORM };

__device__ __forceinline__ unsigned cvtpk(float lo, float hi) { f32x2 v = {lo, hi}; bf16x2_t b = __builtin_convertvector(v, bf16x2_t); return __builtin_bit_cast(unsigned, b); }
__device__ __forceinline__ float bf_lo(unsigned u) { return __uint_as_float(u << 16); }
__device__ __forceinline__ float bf_hi(unsigned u) { return __uint_as_float(u & 0xffff0000u); }
__device__ __forceinline__ float wave_sum(float v) {
#pragma unroll
    for (int o = 1; o < 64; o <<= 1) v += __shfl_xor(v, o);
    return v;
}

enum { M_WIN = 0, M_MEM, M_UQ, M_UKV, M_GATE, M_Z, M_RES, M_UP };
struct Epi {
    static constexpr bool PERM = true, AFTER_DRAIN = false;
    int mode, br, layer; unsigned char* ws;
    __device__ __forceinline__ void store8(bf16_t* dst, const f32x4& a, const f32x4& b) const {
        u32x4 w; w.x = cvtpk(a[0], a[1]); w.y = cvtpk(a[2], a[3]); w.z = cvtpk(b[0], b[1]); w.w = cvtpk(b[2], b[3]);
        *(u32x4*)dst = w;
    }
    __device__ __forceinline__ float sq8(const f32x4& a0, const f32x4& a1) const { return (a0[0]*a0[0] + a0[1]*a0[1]) + (a0[2]*a0[2] + a0[3]*a0[3]) + (a1[0]*a1[0] + a1[1]*a1[1]) + (a1[2]*a1[2] + a1[3]*a1[3]); }
    __device__ __forceinline__ void operator()(const f32x4 (&acc)[2][2][4][2], const pg8::Unit& u, int wr, int wc, int fr_in, int fq_in) const {
        int fr = fr_in, fq = fq_in; asm volatile("" : "+v"(fr), "+v"(fq));
        const int pn = u.pn;
        float* RS = (float*)(ws + WS_RS);
        const float* rs_in = RS + (size_t)(4 * layer) * S; float inv_k = 1.0f / 1024.0f;
        if (mode == M_MEM) rs_in = (const float*)(ws + WS_RSTDM);
        if (mode == M_UQ) { rs_in = RS + (size_t)(4 * layer + 1) * S; inv_k = 1.0f / 256.0f; }
        if (mode == M_UKV) { rs_in = RS + (size_t)(4 * layer + 2) * S; inv_k = 1.0f / 128.0f; }
        if (mode == M_UP) rs_in = RS + (size_t)(4 * layer + 3) * S;
        float* rs_out = RS + (size_t)(4 * layer + 1) * S;
        if (mode == M_WIN && pn == 1) rs_out = RS + (size_t)(4 * layer + 2) * S;
        if (mode == M_RES) rs_out = RS + (size_t)(4 * layer + 3 + br) * S;
        const float* resid = nullptr; float* X = nullptr;
        if (mode == M_RES) { X = *(float* const*)(ws + WS_PTAB + 8); resid = (layer == 0 && br == 0) ? *(const float* const*)(ws + WS_PTAB) : X; }
#pragma unroll
        for (int ai = 0; ai < 2; ++ai)
#pragma unroll
            for (int m = 0; m < 4; ++m) {
                const int row = u.pm * 256 + ai * 128 + wr * 64 + m * 16 + fr;
                float sc = 1.f;
                if (mode == M_MEM) sc = rs_in[row];
                else if (mode != M_Z && mode != M_RES) sc = __builtin_amdgcn_rsqf(rs_in[row] * inv_k + EPS);
                if (mode == M_UQ) sc *= QMLA_SCALE;
                float ss = 0.f;
#pragma unroll
                for (int bj = 0; bj < 2; ++bj) {
                    const int ct = bj * 128 + wc * 32 + 8 * fq;
                    f32x4 a0 = acc[ai][bj][m][0] * sc, a1 = acc[ai][bj][m][1] * sc;
                    switch (mode) {
                    case M_WIN: {
                        if (pn == 0) { store8((bf16_t*)(ws + WS_CQ) + (size_t)row * 256 + ct, a0, a1); ss += sq8(a0, a1); }
                        else if (pn == 1) {
                            if (bj == 0) { store8((bf16_t*)(ws + WS_CKV) + (size_t)row * 128 + ct, a0, a1); ss += sq8(a0, a1); }
                            else if (wc == 0) {
                                const f32x2* cs = (const f32x2*)(ws + WS_ROPE) + (size_t)row * 16 + 4 * fq;
                                f32x4 o1, o2;
#pragma unroll
                                for (int e = 0; e < 4; ++e) { const f32x2 c = cs[e]; o1[e] = a0[e] * c.x - a1[e] * c.y; o2[e] = a1[e] * c.x + a0[e] * c.y; }
                                u32x2 w1, w2; w1.x = cvtpk(o1[0], o1[1]); w1.y = cvtpk(o1[2], o1[3]); w2.x = cvtpk(o2[0], o2[1]); w2.y = cvtpk(o2[2], o2[3]);
                                bf16_t* kr = (bf16_t*)(ws + WS_KMLA) + (size_t)row * 768 + 64 + 4 * fq;
#pragma unroll
                                for (int hh = 0; hh < 8; ++hh) { *(u32x2*)(kr + hh * 96) = w1; *(u32x2*)(kr + hh * 96 + 16) = w2; }
                            }
                        }
                        else if (pn < 4) { store8((bf16_t*)(ws + WS_QS) + (size_t)row * 512 + (pn - 2) * 256 + ct, a0 * QS_SCALE, a1 * QS_SCALE); }
                        else if (pn == 4) { if (bj == 0) store8((bf16_t*)(ws + WS_KS) + (size_t)row * 128 + ct, a0, a1); else store8((bf16_t*)(ws + WS_VS) + (size_t)row * 128 + ct - 128, a0, a1); }
                        else { store8((bf16_t*)(ws + WS_QM) + (size_t)row * 512 + (pn - 5) * 256 + ct, a0 * QM_SCALE, a1 * QM_SCALE); }
                    } break;
                    case M_MEM: {
                        if (pn < 2) store8((bf16_t*)(ws + WS_KMEM) + (size_t)row * 512 + pn * 256 + ct, a0, a1);
                        else store8((bf16_t*)(ws + WS_VMEM) + (size_t)row * 512 + (pn - 2) * 256 + ct, a0, a1);
                    } break;
                    case M_UQ: {
                        if (pn < 2) { const int c = pn * 256 + ct; store8((bf16_t*)(ws + WS_QMLA) + (size_t)row * 768 + (c >> 6) * 96 + (c & 63), a0, a1); }
                        else {
                            const int head = 4 * bj + wc;
                            const f32x2* cs = (const f32x2*)(ws + WS_ROPE) + (size_t)row * 16 + 4 * fq;
                            f32x4 o1, o2;
#pragma unroll
                            for (int e = 0; e < 4; ++e) { const f32x2 c = cs[e]; o1[e] = a0[e] * c.x - a1[e] * c.y; o2[e] = a1[e] * c.x + a0[e] * c.y; }
                            u32x2 w1, w2; w1.x = cvtpk(o1[0], o1[1]); w1.y = cvtpk(o1[2], o1[3]); w2.x = cvtpk(o2[0], o2[1]); w2.y = cvtpk(o2[2], o2[3]);
                            bf16_t* qrp = (bf16_t*)(ws + WS_QMLA) + (size_t)row * 768 + head * 96 + 64 + 4 * fq;
                            *(u32x2*)qrp = w1; *(u32x2*)(qrp + 16) = w2;
                        }
                    } break;
                    case M_UKV: {
                        if (pn < 2) { const int c = pn * 256 + ct; store8((bf16_t*)(ws + WS_KMLA) + (size_t)row * 768 + (c >> 6) * 96 + (c & 63), a0, a1); }
                        else store8((bf16_t*)(ws + WS_VMLA) + (size_t)row * 512 + (pn - 2) * 256 + ct, a0, a1);
                    } break;
                    case M_GATE: {
                        const int c = pn * 256 + ct;
                        const float* bg = (const float*)(ws + WS_BG) + layer * 3072 + br * 1024 + c;
                        const f32x4 b0 = *(const f32x4*)bg, b1 = *(const f32x4*)(bg + 4);
                        f32x4 g0, g1;
#pragma unroll
                        for (int e = 0; e < 4; ++e) { g0[e] = __builtin_amdgcn_rcpf(1.f + __builtin_amdgcn_exp2f(-(a0[e] + b0[e]) * LOG2E)); g1[e] = __builtin_amdgcn_rcpf(1.f + __builtin_amdgcn_exp2f(-(a1[e] + b1[e]) * LOG2E)); }
                        store8((bf16_t*)(ws + WS_T) + (size_t)row * 1024 + c, g0, g1);
                    } break;
                    case M_Z: {
                        const int c = pn * 256 + ct;
                        const u32x4 t = *(const u32x4*)((bf16_t*)(ws + WS_T) + (size_t)row * 1024 + c);
                        bf16_t* yp = (bf16_t*)(ws + WS_YB) + (size_t)row * 1024 + c;
                        f32x4 y0 = {0.f, 0.f, 0.f, 0.f}, y1 = {0.f, 0.f, 0.f, 0.f};
                        if (br > 0) { const u32x4 yo = *(const u32x4*)yp;
                            y0 = (f32x4){bf_lo(yo.x), bf_hi(yo.x), bf_lo(yo.y), bf_hi(yo.y)}; y1 = (f32x4){bf_lo(yo.z), bf_hi(yo.z), bf_lo(yo.w), bf_hi(yo.w)}; }
                        y0 += a0 * (f32x4){bf_lo(t.x), bf_hi(t.x), bf_lo(t.y), bf_hi(t.y)};
                        y1 += a1 * (f32x4){bf_lo(t.z), bf_hi(t.z), bf_lo(t.w), bf_hi(t.w)};
                        store8(yp, y0, y1);
                    } break;
                    case M_RES: {
                        const int c = pn * 256 + ct;
                        const f32x4 x0 = *(const f32x4*)(resid + (size_t)row * 1024 + c) + a0, x1 = *(const f32x4*)(resid + (size_t)row * 1024 + c + 4) + a1;
                        *(f32x4*)(X + (size_t)row * 1024 + c) = x0; *(f32x4*)(X + (size_t)row * 1024 + c + 4) = x1;
                        store8((bf16_t*)(ws + WS_XB) + (size_t)row * 1024 + c, x0, x1);
                        ss += sq8(x0, x1);
                    } break;
                    default: {
                        f32x4 r0, r1;
#pragma unroll
                        for (int e = 0; e < 4; ++e) { const float v0 = fmaxf(a0[e], 0.f), v1 = fmaxf(a1[e], 0.f); r0[e] = v0 * v0; r1[e] = v1 * v1; }
                        store8((bf16_t*)(ws + WS_H) + (size_t)row * 4096 + pn * 256 + ct, r0, r1);
                    } break;
                    }
                }
                if (mode == M_RES || (mode == M_WIN && pn < 2)) {
                    ss += __shfl_xor(ss, 16); ss += __shfl_xor(ss, 32);
                    if (fq == 0) atomicAdd(rs_out + row, ss);
                }
            }
    }
};

__device__ __forceinline__ int crow(int i, int h) { return (i & 3) + 8 * (i >> 2) + 4 * h; }
#define MFMA32(a, b, c) __builtin_amdgcn_mfma_f32_32x32x16_bf16((a), (b), (c), 0, 0, 0)

template <int DQK, int DV, int MODE>
__device__ __forceinline__ void attn_unit(LAS unsigned char* lds, const bf16_t* Q, int qpitch, const bf16_t* K, int kpitch, const bf16_t* V, int vpitch,
                                          bf16_t* O, int opitch, int q0, int t_begin, int t_end, const float* biasrow, float sink_l2, int tid) {
    constexpr int KSTR = (DQK + 8) * 2, VSTR = 144, KBUF = 64 * KSTR, VBUF = DV * VSTR;
    constexpr int NKC = DQK / 8, NKCH = 64 * NKC, KIT = (NKCH + 511) / 512, VIT = DV / 64, NC = DQK / 16, NDB = DV / 32;
    constexpr int OFF_K = 0, OFF_V = 2 * KBUF, OFF_BIAS = 2 * KBUF + 2 * VBUF;
    static_assert(OFF_BIAS + 512 <= 131072, "attention lds");
    const int lane = tid & 63, w = __builtin_amdgcn_readfirstlane(tid >> 6), r = lane & 31, h = lane >> 5;
    const int R0 = q0 + 32 * w;
    LAS float* biasl = (LAS float*)(lds + OFF_BIAS);
    if (MODE == 1) { if (tid < 128) biasl[tid] = biasrow[tid]; }
    bf16x8 qr[NC];
#pragma unroll
    for (int c = 0; c < NC; ++c) qr[c] = *(const bf16x8*)(Q + (size_t)(R0 + r) * qpitch + 16 * c + 8 * h);
    u32x4 kst[KIT], vst[VIT];
    const int vpos = (lane & ~15) | (((lane >> 2) & 1) << 3) | (((lane >> 3) & 1) << 2) | (lane & 3);
#define ATT_LOAD(t) do { \
        _Pragma("unroll") for (int i_ = 0; i_ < KIT; ++i_) { const int c_ = tid + 512 * i_; if (c_ < NKCH) { const int row_ = c_ / NKC, col_ = c_ % NKC; \
            kst[i_] = *(const u32x4*)(K + (size_t)(64 * (t) + row_) * kpitch + col_ * 8); } } \
        _Pragma("unroll") for (int i_ = 0; i_ < VIT; ++i_) vst[i_] = *(const u32x4*)(V + (size_t)(64 * (t) + lane) * vpitch + (w + 8 * i_) * 8); } while (0)
#define ATT_STORE(buf) do { \
        _Pragma("unroll") for (int i_ = 0; i_ < KIT; ++i_) { const int c_ = tid + 512 * i_; if (c_ < NKCH) { const int row_ = c_ / NKC, col_ = c_ % NKC; \
            *(LAS u32x4*)(lds + OFF_K + (buf) * KBUF + row_ * KSTR + col_ * 16) = kst[i_]; } } \
        _Pragma("unroll") for (int i_ = 0; i_ < VIT; ++i_) { LAS unsigned short* vd_ = (LAS unsigned short*)(lds + OFF_V + (buf) * VBUF + ((w + 8 * i_) * 8) * VSTR + vpos * 2); \
            const u32x4 v_ = vst[i_]; \
            vd_[0 * (VSTR / 2)] = (unsigned short)(v_.x & 0xffffu); vd_[1 * (VSTR / 2)] = (unsigned short)(v_.x >> 16); \
            vd_[2 * (VSTR / 2)] = (unsigned short)(v_.y & 0xffffu); vd_[3 * (VSTR / 2)] = (unsigned short)(v_.y >> 16); \
            vd_[4 * (VSTR / 2)] = (unsigned short)(v_.z & 0xffffu); vd_[5 * (VSTR / 2)] = (unsigned short)(v_.z >> 16); \
            vd_[6 * (VSTR / 2)] = (unsigned short)(v_.w & 0xffffu); vd_[7 * (VSTR / 2)] = (unsigned short)(v_.w >> 16); } } while (0)

    float mrun = (MODE == 1) ? sink_l2 : -INFINITY;
    float lrun = (MODE == 1 && h == 0) ? 1.f : 0.f;
    f32x16 o[NDB];
#pragma unroll
    for (int db = 0; db < NDB; ++db)
#pragma unroll
        for (int i = 0; i < 16; ++i) o[db][i] = 0.f;

    ATT_LOAD(t_begin);
    ATT_STORE(0);
    __syncthreads();
    for (int t = t_begin; t < t_end; ++t) {
        const int buf = (t - t_begin) & 1;
        const bool more = (t + 1 < t_end);
        if (more) ATT_LOAD(t + 1);
        bool skip = false;
        if (MODE == 0) skip = (64 * t > R0 + 31);
        if (MODE == 1) skip = (64 * t > R0 + 31) || (64 * t + 63 < R0 - 127);
        if (!skip) {
            f32x16 p0, p1;
#pragma unroll
            for (int i = 0; i < 16; ++i) { p0[i] = 0.f; p1[i] = 0.f; }
            const LAS unsigned char* kp = lds + OFF_K + buf * KBUF + r * KSTR + h * 16;
#pragma unroll
            for (int c = 0; c < NC; ++c) {
                const bf16x8 k0 = *(const LAS bf16x8*)(kp + c * 32);
                const bf16x8 k1 = *(const LAS bf16x8*)(kp + 32 * KSTR + c * 32);
                p0 = MFMA32(k0, qr[c], p0); p1 = MFMA32(k1, qr[c], p1);
            }
            const int qa = R0 + r;
            if (MODE == 0) {
                if (64 * t + 63 > R0) {
#pragma unroll
                    for (int i = 0; i < 16; ++i) { const int kv = 64 * t + crow(i, h); if (kv > qa) p0[i] = -INFINITY; if (kv + 32 > qa) p1[i] = -INFINITY; }
                }
            }
            if (MODE == 1) {
#pragma unroll
                for (int i = 0; i < 16; ++i) { const int d0 = qa - (64 * t + crow(i, h)), d1 = d0 - 32;
                    const float b0 = biasl[d0 & 127], b1 = biasl[d1 & 127];
                    p0[i] = (d0 >= 0 && d0 < 128) ? p0[i] + b0 : -INFINITY; p1[i] = (d1 >= 0 && d1 < 128) ? p1[i] + b1 : -INFINITY; }
            }
            float mx = fmaxf(p0[0], p1[0]);
#pragma unroll
            for (int i = 1; i < 16; ++i) mx = fmaxf(mx, fmaxf(p0[i], p1[i]));
            mx = fmaxf(mx, __shfl_xor(mx, 32));
            const float mnew = fmaxf(mrun, mx);
            const float alpha = __builtin_amdgcn_exp2f(mrun - mnew);
            mrun = mnew;
            float ls = 0.f;
#pragma unroll
            for (int i = 0; i < 16; ++i) { p0[i] = __builtin_amdgcn_exp2f(p0[i] - mnew); p1[i] = __builtin_amdgcn_exp2f(p1[i] - mnew); ls += p0[i] + p1[i]; }
            lrun = lrun * alpha + ls;
#pragma unroll
            for (int db = 0; db < NDB; ++db)
#pragma unroll
                for (int i = 0; i < 16; ++i) o[db][i] *= alpha;
            bf16x8 pa[4];
#pragma unroll
            for (int s = 0; s < 4; ++s) {
                u32x4 pk;
                if (s < 2) { pk.x = cvtpk(p0[8 * s + 0], p0[8 * s + 1]); pk.y = cvtpk(p0[8 * s + 2], p0[8 * s + 3]); pk.z = cvtpk(p0[8 * s + 4], p0[8 * s + 5]); pk.w = cvtpk(p0[8 * s + 6], p0[8 * s + 7]); }
                else { const int s2 = s - 2; pk.x = cvtpk(p1[8 * s2 + 0], p1[8 * s2 + 1]); pk.y = cvtpk(p1[8 * s2 + 2], p1[8 * s2 + 3]); pk.z = cvtpk(p1[8 * s2 + 4], p1[8 * s2 + 5]); pk.w = cvtpk(p1[8 * s2 + 6], p1[8 * s2 + 7]); }
                pa[s] = __builtin_bit_cast(bf16x8, pk);
            }
            const LAS unsigned char* vp = lds + OFF_V + buf * VBUF + r * VSTR + h * 16;
#pragma unroll
            for (int db = 0; db < NDB; ++db)
#pragma unroll
                for (int s = 0; s < 4; ++s) {
                    const bf16x8 vf = *(const LAS bf16x8*)(vp + db * 32 * VSTR + s * 32);
                    o[db] = MFMA32(vf, pa[s], o[db]);
                }
        }
        if (more) ATT_STORE(buf ^ 1);
        __syncthreads();
    }
    lrun += __shfl_xor(lrun, 32);
    const float inv = 1.f / lrun;
    bf16_t* orow = O + (size_t)(R0 + r) * opitch;
#pragma unroll
    for (int db = 0; db < NDB; ++db)
#pragma unroll
        for (int g = 0; g < 4; ++g) {
            u32x2 wv; wv.x = cvtpk(o[db][4 * g + 0] * inv, o[db][4 * g + 1] * inv); wv.y = cvtpk(o[db][4 * g + 2] * inv, o[db][4 * g + 3] * inv);
            *(u32x2*)(orow + 32 * db + 8 * g + 4 * h) = wv;
        }
#undef ATT_LOAD
#undef ATT_STORE
}

__device__ __forceinline__ int map_col(int kind, int off, int n) {
    switch (kind) {
    case 1: {
        if (n < 256) return n;
        if (n < 512) { const int j = n - 256; if (j < 128) return 256 + j; if (j < 160) { const int p = j - 128; return 384 + 16 * ((p >> 2) & 1) + 4 * (p >> 3) + (p & 3); } return -1; }
        if (n < 1024) return 416 + (n - 512);
        if (n < 1280) return 928 + (n - 1024);
        return 1184 + (n - 1280);
    }
    case 2: {
        if (n < 512) return (n >> 6) * 96 + (n & 63);
        const int j = n - 512, hd = j >> 5, p = j & 31; return hd * 96 + 64 + 16 * ((p >> 2) & 1) + 4 * (p >> 3) + (p & 3);
    }
    case 3: {
        if (n < 512) return (n >> 6) * 128 + (n & 63);
        const int j = n - 512; return (j >> 6) * 128 + 64 + (j & 63);
    }
    default: return off + n;
    }
}
__device__ __forceinline__ void conv_matrix(const float* W, int K, int Nsrc, const float* gain, bf16_t* WT, int Ndst, int kind, int off, LAS float* scr, int gw, int ngw, int lane) {
    const int nblk = Ndst / 32, nitems = (K / 64) * nblk;
    for (int it = gw; it < nitems; it += ngw) {
        const int kb = it / nblk, nb = it % nblk, k0 = 64 * kb, n0 = 32 * nb;
        const int src = map_col(kind, off, n0 + (lane & 31));
#pragma unroll 8
        for (int i = 0; i < 32; ++i) { const int kk = 2 * i + (lane >> 5);
            float v = 0.f; if (src >= 0) v = W[(size_t)(k0 + kk) * Nsrc + src];
            if (gain) v *= gain[k0 + kk];
            scr[kk * 33 + (lane & 31)] = v; }
        asm volatile("s_waitcnt lgkmcnt(0)" ::: "memory");
        const int c = lane & 7;
#pragma unroll
        for (int j = 0; j < 4; ++j) { const int n = (lane >> 3) + 8 * j; const LAS float* s = scr + (8 * c) * 33 + n;
            u32x4 o; o.x = cvtpk(s[0 * 33], s[1 * 33]); o.y = cvtpk(s[2 * 33], s[3 * 33]); o.z = cvtpk(s[4 * 33], s[5 * 33]); o.w = cvtpk(s[6 * 33], s[7 * 33]);
            *(u32x4*)(WT + (size_t)(n0 + n) * K + k0 + 8 * c) = o; }
        asm volatile("s_waitcnt lgkmcnt(0)" ::: "memory");
    }
}
__device__ __forceinline__ float row_to_bf16(const float* xrow, bf16_t* orow, int lane) {
    const f32x4* xr = (const f32x4*)xrow + lane;
    f32x4 v[4]; float s = 0.f;
#pragma unroll
    for (int j = 0; j < 4; ++j) { v[j] = xr[64 * j]; s += (v[j][0] * v[j][0] + v[j][1] * v[j][1]) + (v[j][2] * v[j][2] + v[j][3] * v[j][3]); }
    u32x2* o8 = (u32x2*)orow + lane;
#pragma unroll
    for (int j = 0; j < 4; ++j) { u32x2 wv; wv.x = cvtpk(v[j][0], v[j][1]); wv.y = cvtpk(v[j][2], v[j][3]); o8[64 * j] = wv; }
    return wave_sum(s);
}
__device__ __forceinline__ float rope_inv(int i) {
    const float t[16] = {1.000000000e+00f, 5.623413324e-01f, 3.162277639e-01f, 1.778279394e-01f, 1.000000015e-01f, 5.623412877e-02f, 3.162277862e-02f, 1.778279431e-02f,
                         9.999999776e-03f, 5.623413250e-03f, 3.162277862e-03f, 1.778279431e-03f, 1.000000047e-03f, 5.623413017e-04f, 3.162277862e-04f, 1.778279402e-04f};
    float r = t[0];
#pragma unroll
    for (int k = 1; k < 16; ++k) r = (i == k) ? t[k] : r;
    return r;
}

constexpr int LDS_BYTES = 147456;
__global__ void __launch_bounds__(512, 2) fwd_mega(Args a) {
    extern __shared__ __attribute__((aligned(16))) unsigned char lds_raw[];
    LAS unsigned char* lds = (LAS unsigned char*)lds_raw;
    cg::grid_group grid = cg::this_grid();
    const int tid = threadIdx.x, lane = tid & 63, wave = __builtin_amdgcn_readfirstlane(tid >> 6);
    const int G = gridDim.x, bid = blockIdx.x;
    unsigned char* ws = a.ws;

    {
        bf16_t* XB = (bf16_t*)(ws + WS_XB);
        float* RS = (float*)(ws + WS_RS);
        LAS float* scr = (LAS float*)(lds + wave * 16384);
        const int gw = bid * 8 + wave, ngw = G * 8;
        for (int l = 0; l < NL; ++l) {
            bf16_t* WL = (bf16_t*)(ws + WS_W + (size_t)l * W_LAYER_BYTES);
            const float* an = a.in[I_ATTN_NORM] + l * D;
            conv_matrix(a.in[I_W_IN] + (size_t)l * D * INCOLS, D, INCOLS, an, WL + W_IN, 1792, 1, 0, scr, gw, ngw, lane);
            conv_matrix(a.in[I_W_IN] + (size_t)l * D * INCOLS, D, INCOLS, an, WL + W_G, 3072, 0, 1696, scr, gw, ngw, lane);
            conv_matrix(a.in[I_W_UQ] + (size_t)l * 256 * 768, 256, 768, a.in[I_QNORM] + l * 256, WL + W_UQ, 768, 2, 0, scr, gw, ngw, lane);
            conv_matrix(a.in[I_W_UKV] + (size_t)l * 128 * 1024, 128, 1024, a.in[I_KVNORM] + l * 128, WL + W_UKV, 1024, 3, 0, scr, gw, ngw, lane);
            conv_matrix(a.in[I_W_MEMKV] + (size_t)l * D * 1024, D, 1024, a.in[I_MEM_NORM] + l * D, WL + W_MEM, 1024, 0, 0, scr, gw, ngw, lane);
            conv_matrix(a.in[I_WO_MLA] + (size_t)l * 512 * D, 512, D, nullptr, WL + W_O, 1024, 0, 0, scr, gw, ngw, lane);
            conv_matrix(a.in[I_WO_SWA] + (size_t)l * 512 * D, 512, D, nullptr, WL + W_O + (size_t)1024 * 512, 1024, 0, 0, scr, gw, ngw, lane);
            conv_matrix(a.in[I_WO_MEM] + (size_t)l * 512 * D, 512, D, nullptr, WL + W_O + (size_t)2 * 1024 * 512, 1024, 0, 0, scr, gw, ngw, lane);
            conv_matrix(a.in[I_W_OUT] + (size_t)l * D * D, D, D, nullptr, WL + W_OUT, 1024, 0, 0, scr, gw, ngw, lane);
            conv_matrix(a.in[I_W_UP] + (size_t)l * D * DFF, D, DFF, a.in[I_MLP_NORM] + l * D, WL + W_UP, 4096, 0, 0, scr, gw, ngw, lane);
            conv_matrix(a.in[I_W_DOWN] + (size_t)l * DFF * D, DFF, D, nullptr, WL + W_DOWN, 1024, 0, 0, scr, gw, ngw, lane);
        }
        for (int m = gw; m < S; m += ngw) { const float ss = row_to_bf16(a.in[I_X] + (size_t)m * D, XB + (size_t)m * D, lane); if (lane == 0) RS[m] = ss; }
        { bf16_t* MEMB = (bf16_t*)(ws + WS_MEMB); float* RSTDM = (float*)(ws + WS_RSTDM);
          for (int m = gw; m < MEML; m += ngw) { const float ss = row_to_bf16(a.in[I_MEM] + (size_t)m * D, MEMB + (size_t)m * D, lane); if (lane == 0) RSTDM[m] = 1.0f / sqrtf(ss * (1.0f / D) + EPS); } }
        const int gt = bid * 512 + tid, ngt = G * 512;
        for (int i = gt; i < 8 * S; i += ngt) RS[S + i] = 0.f;
        { f32x2* ROPE = (f32x2*)(ws + WS_ROPE);
          for (int i = gt; i < S * 16; i += ngt) {
            const int pos = i >> 4, fi = i & 15;
            const float ang = (float)pos * rope_inv(fi);
            const double rev = (double)ang * 0.15915494309189535;
            const float fr = (float)(rev - __builtin_rint(rev));
            f32x2 cs; cs.x = __builtin_amdgcn_cosf(fr); cs.y = __builtin_amdgcn_sinf(fr);
            ROPE[i] = cs;
          } }
        { float* BIAS = (float*)(ws + WS_BIAS);
          for (int i = gt; i < 8 * 128; i += ngt) {
            const int hh = i >> 7, n = i & 127;
            int bucket = n;
            if (n >= 16) { const float lg = __builtin_amdgcn_logf((float)n * 0.0625f) * (16.0f / 3.0f); bucket = 16 + (int)lg; if (bucket > 31) bucket = 31; }
            BIAS[i] = a.in[I_RELB][bucket * 8 + hh] * LOG2E;
          } }
        { float* BG = (float*)(ws + WS_BG); float* SK = (float*)(ws + WS_SINK); float* FN = (float*)(ws + WS_FN);
          for (int i = gt; i < 2 * 3072; i += ngt) BG[i] = a.in[I_B_GATE][i];
          for (int i = gt; i < 16; i += ngt) SK[i] = a.in[I_SINKS][i] * LOG2E;
          for (int i = gt; i < 1024; i += ngt) FN[i] = a.in[I_FNORM][i];
          if (gt == 0) { unsigned long long* pt = (unsigned long long*)(ws + WS_PTAB); pt[0] = (unsigned long long)(uintptr_t)a.in[I_X]; pt[1] = (unsigned long long)(uintptr_t)a.out; } }
    }
    grid.sync();

    constexpr int NSTEPS = 14 * NL;
    for (int step = 0; step < NSTEPS; ++step) {
        bool do_sync = true;
        const int l = step / 14, k = step % 14;
        if (k == 4) {
            int tidv = threadIdx.x; asm volatile("" : "+v"(tidv));
            bf16_t* QMLA = (bf16_t*)(ws + WS_QMLA); bf16_t* KMLA = (bf16_t*)(ws + WS_KMLA); bf16_t* VMLA = (bf16_t*)(ws + WS_VMLA); bf16_t* OMLA = (bf16_t*)(ws + WS_OMLA);
            for (int u = bid; u < 256; u += G) {
                const int hh = u & 7, j = u >> 3;
                for (int kk = 0; kk < 2; ++kk) {
                    const int qb = kk == 0 ? 63 - j : j;
                    attn_unit<96, 64, 0>(lds, QMLA + hh * 96, 768, KMLA + hh * 96, 768, VMLA + hh * 64, 512, OMLA + hh * 64, 512, 256 * qb, 0, 4 * (qb + 1), nullptr, 0.f, tidv);
                }
            }
            bf16_t* QS = (bf16_t*)(ws + WS_QS); bf16_t* KS = (bf16_t*)(ws + WS_KS); bf16_t* VS = (bf16_t*)(ws + WS_VS);
            const float* BIAS = (const float*)(ws + WS_BIAS); const float* SK = (const float*)(ws + WS_SINK);
            for (int u = bid; u < 512; u += G) {
                const int hh = u >> 6, qb = u & 63, g = hh >> 2;
                const int tb = 4 * qb - 2 < 0 ? 0 : 4 * qb - 2;
                attn_unit<64, 64, 1>(lds, QS + hh * 64, 512, KS + g * 64, 128, VS + g * 64, 128, QS + hh * 64, 512, 256 * qb, tb, 4 * qb + 4, BIAS + hh * 128, SK[l * 8 + hh], tidv);
            }
            bf16_t* QM = (bf16_t*)(ws + WS_QM); bf16_t* KMEM = (bf16_t*)(ws + WS_KMEM); bf16_t* VMEM = (bf16_t*)(ws + WS_VMEM);
            for (int u = bid; u < 256; u += G) {
                const int hh = u >> 6, qb = u & 63;
                attn_unit<128, 128, 2>(lds, QM + hh * 128, 512, KMEM + hh * 128, 512, VMEM + hh * 128, 512, QM + hh * 128, 512, 256 * qb, 0, 4, nullptr, 0.f, tidv);
            }
        } else {
            const bf16_t* WL = (const bf16_t*)(ws + WS_W + (size_t)l * W_LAYER_BYTES);
            const bf16_t* XB = (const bf16_t*)(ws + WS_XB);
            pg8::Gemm g{}; Epi E{}; int cid = bid;
            E.ws = ws; E.layer = l;
            switch (k) {
            case 0: g = pg8::Gemm{XB, WL + W_IN, S, 1792, 1024}; E.mode = M_WIN; do_sync = false; break;
            case 1: g = pg8::Gemm{(const bf16_t*)(ws + WS_MEMB), WL + W_MEM, MEML, 1024, 1024}; E.mode = M_MEM; cid = G - 1 - bid; break;
            case 2: g = pg8::Gemm{(const bf16_t*)(ws + WS_CQ), WL + W_UQ, S, 768, 256}; E.mode = M_UQ; do_sync = false; break;
            case 3: g = pg8::Gemm{(const bf16_t*)(ws + WS_CKV), WL + W_UKV, S, 1024, 128}; E.mode = M_UKV; cid = G - 1 - bid; break;
            case 5: case 7: case 9: { const int br = (k - 5) >> 1; g = pg8::Gemm{XB, WL + W_G + (size_t)br * 1024 * 1024, S, 1024, 1024}; E.mode = M_GATE; E.br = br; do_sync = false; } break;
            case 6: case 8: case 10: { const int br = (k - 6) >> 1; const bf16_t* Ab = (const bf16_t*)(ws + (br == 0 ? WS_OMLA : (br == 1 ? WS_QS : WS_QM)));
                    g = pg8::Gemm{Ab, WL + W_O + (size_t)br * 1024 * 512, S, 1024, 512}; E.mode = M_Z; E.br = br; do_sync = (k == 10); } break;
            case 11: g = pg8::Gemm{(const bf16_t*)(ws + WS_YB), WL + W_OUT, S, 1024, 1024}; E.mode = M_RES; E.br = 0; break;
            case 12: g = pg8::Gemm{XB, WL + W_UP, S, 4096, 1024}; E.mode = M_UP; break;
            default: g = pg8::Gemm{(const bf16_t*)(ws + WS_H), WL + W_DOWN, S, 1024, 4096}; E.mode = M_RES; E.br = 1; break;
            }
            pg8::StaticOrder SO; SO.init(g.M, g.N, G, cid);
            pg8::gemm_phase<Epi, pg8::StaticOrder, true, true>(lds, g, SO, E);
        }
        if (do_sync) grid.sync();
    }
    {
        const int gw = bid * 8 + wave, ngw = G * 8;
        float* X = *(float* const*)(ws + WS_PTAB + 8);
        const float* rsf = (const float*)(ws + WS_RS) + (size_t)(4 * NL) * S;
        const f32x4* gn = (const f32x4*)(ws + WS_FN) + lane;
        for (int m = gw; m < S; m += ngw) {
            f32x4* xr = (f32x4*)(X + (size_t)m * D) + lane;
            const float rstd = 1.0f / sqrtf(rsf[m] * (1.0f / D) + EPS);
#pragma unroll
            for (int j = 0; j < 4; ++j) { f32x4 v = xr[64 * j]; v = v * rstd * gn[64 * j]; xr[64 * j] = v; }
        }
    }
}

extern "C" void kernel_launch(void* const* d_in, const int* in_sizes, int n_in, void* d_out, int out_size, void* d_ws, size_t ws_size, hipStream_t stream) {
    static int grid = 0;
    if (grid == 0) {
        int dev = 0, cus = 0, per_cu = 0;
        (void)hipGetDevice(&dev);
        (void)hipDeviceGetAttribute(&cus, hipDeviceAttributeMultiprocessorCount, dev);
        (void)hipFuncSetAttribute((const void*)fwd_mega, hipFuncAttributeMaxDynamicSharedMemorySize, LDS_BYTES);
        (void)hipOccupancyMaxActiveBlocksPerMultiprocessor(&per_cu, (const void*)fwd_mega, 512, LDS_BYTES);
        if (per_cu < 1) per_cu = 1;
        grid = cus * per_cu;
        if (grid <= 0) grid = 256;
    }
    Args a{};
    for (int i = 0; i < 21; ++i) a.in[i] = (const float*)d_in[i];
    a.out = (float*)d_out; a.ws = (unsigned char*)d_ws;
    void* args[] = {&a};
    hipError_t e = hipLaunchCooperativeKernel((void*)fwd_mega, dim3(grid), dim3(512), args, LDS_BYTES, stream);
    if (e != hipSuccess) fprintf(stderr, "cooperative launch failed: %s (grid %d)\n", hipGetErrorString(e), grid);
}
```

```cpp
#include <hip/hip_runtime.h>
#include <hip/hip_cooperative_groups.h>
#include <cstdio>
#include <cstdint>
namespace cg = cooperative_groups;
namespace pg8 {
#define PG8_LAS __attribute__((address_space(3)))
typedef unsigned short bf16_t;
typedef short bf16x8 __attribute__((ext_vector_type(8)));
typedef float f32x4 __attribute__((ext_vector_type(4)));
typedef unsigned u32x4 __attribute__((ext_vector_type(4)));
constexpr int BM = 256, BK = 64, HALF = 128, HTB = HALF * BK * 2  , STAGE_BYTES = 8 * HTB, NXCD = 8, WGM = 8;

__host__ __device__ __forceinline__ int lds_byte(int r, int c) { const int st = (r >> 4) * 2 + (c >> 5), rr = r & 15, cc = c & 31, ob = rr * 64 + cc * 2; return st * 1024 + (ob ^ (((ob >> 9) & 1) << 5)); }
__host__ __device__ __forceinline__ void stage_rc(int b, int& R, int& C) { const int st = b / 1024, sb = b % 1024, swz = sb ^ (((sb >> 9) & 1) << 5); R = (st >> 1) * 16 + swz / 64; C = (st & 1) * 32 + (swz % 64) / 2; }
__host__ __device__ __forceinline__ int perm32(int rho) { const int n = rho >> 4, i = rho & 15; return 8 * (i >> 2) + 4 * n + (i & 3); }

struct Unit { int pm, pn; };
struct Gemm { const bf16_t* A; const bf16_t* Bt; int M, N, K; };

struct StaticOrder {
    int nM, nN, nwg, G, c;
    __host__ __device__ void init(int M, int N, int G_, int c_) { nM = M / BM; nN = N / BM; nwg = nM * nN; G = G_; c = c_; }
    __host__ __device__ bool next(int i, Unit& u) const {
        const long L = (long)i * G + c; if (L >= nwg) return false;
        int wgid = (int)L; { const int q = nwg / NXCD, r = nwg % NXCD, xcd = wgid % NXCD, off = wgid / NXCD; wgid = (xcd < r ? xcd * (q + 1) : r * (q + 1) + (xcd - r) * q) + off; }
        const int nig = WGM * nN, gid = wgid / nig, fm = gid * WGM, gsz = (nM - fm) < WGM ? (nM - fm) : WGM;
        u.pm = fm + ((wgid % nig) % gsz); u.pn = (wgid % nig) / gsz; return true;
    }
    __device__ __forceinline__ void a_ready(const Unit&) const {}
    __device__ __forceinline__ void done(const Unit&) const {}
};

__device__ __forceinline__ unsigned cvt_pk_bf16(float lo, float hi) { unsigned r; asm volatile("v_cvt_pk_bf16_f32 %0, %1, %2" : "=v"(r) : "v"(lo), "v"(hi)); return r; }
typedef float f32x2 __attribute__((ext_vector_type(2)));
template <class Epi, class Sched, bool ALIGN_EPI = false, bool SP2 = false>
__device__ __forceinline__ void gemm_phase(PG8_LAS unsigned char* lds, const Gemm g, const Sched& S, const Epi& E) {
    const int tid = threadIdx.x, wid = __builtin_amdgcn_readfirstlane(tid >> 6), lane = tid & 63, wr = wid >> 2, wc = wid & 3, fr = lane & 15, fq = lane >> 4;
    const int K = g.K, nt = K / BK;
    unsigned voffA[2], voffB[2];
#pragma unroll
    for (int i = 0; i < 2; ++i) { int R, C; stage_rc(tid * 16 + i * 8192, R, C); const int Rb = Epi::PERM ? ((R & ~31) + perm32(R & 31)) : R;
        voffA[i] = (unsigned)(R * K + C) * 2u; voffB[i] = (unsigned)(Rb * K + C) * 2u; }
    const size_t kstep = (size_t)(BK * 2);
    const size_t hstep = (size_t)HALF * K * 2;
    const size_t tstep = 2 * hstep;
    const unsigned ldsw = (unsigned)wid * 1024u;
    const int aoff = lds_byte(wr * 64 + fr, fq * 8), boff = lds_byte(wc * 32 + fr, fq * 8);
#define PG8_SA(b, h) (((b) * 2 + (h)) * HTB)
#define PG8_SB(b, h) ((4 + (b) * 2 + (h)) * HTB)
#define PG8_STAGE(bufoff, gbase, voff) do { _Pragma("unroll") for (int _i = 0; _i < 2; ++_i) \
        __builtin_amdgcn_global_load_lds((const unsigned*)((const char*)(gbase) + (voff)[_i]), (PG8_LAS unsigned*)(lds + (bufoff) + ldsw + _i * 8192), 16, 0, 0); } while (0)
#define PG8_LDA(dst, b, h) do { _Pragma("unroll") for (int m = 0; m < 4; ++m) _Pragma("unroll") for (int k = 0; k < 2; ++k) dst[m][k] = *(const PG8_LAS bf16x8*)(lds + PG8_SA(b, h) + aoff + m * 2048 + k * 1024); } while (0)
#define PG8_LDB(dst, b, h) do { _Pragma("unroll") for (int n = 0; n < 2; ++n) _Pragma("unroll") for (int k = 0; k < 2; ++k) dst[n][k] = *(const PG8_LAS bf16x8*)(lds + PG8_SB(b, h) + boff + n * 2048 + k * 1024); } while (0)
#define PG8_MMA(ai, bj, At, Bt) do { __builtin_amdgcn_s_setprio(1); _Pragma("unroll") for (int m = 0; m < 4; ++m) _Pragma("unroll") for (int n = 0; n < 2; ++n) _Pragma("unroll") for (int k = 0; k < 2; ++k) \
        acc[ai][bj][m][n] = __builtin_amdgcn_mfma_f32_16x16x32_bf16(Bt[n][k], At[m][k], acc[ai][bj][m][n], 0, 0, 0); __builtin_amdgcn_s_setprio(0); } while (0)
#define PG8_WAIT_V(n) asm volatile("s_waitcnt vmcnt(" #n ")" ::: "memory")
#define PG8_WAIT_L(n) asm volatile("s_waitcnt lgkmcnt(" #n ")" ::: "memory")
#define PG8_BAR __builtin_amdgcn_s_barrier()
#define PG8_SCHED __builtin_amdgcn_sched_barrier(0)
    Unit cur, nxt; int ui = 0;
    if (!S.next(0, cur)) return;
    f32x4 acc[2][2][4][2];
#pragma unroll
    for (int a = 0; a < 2; ++a)
#pragma unroll
        for (int b = 0; b < 2; ++b)
#pragma unroll
            for (int m = 0; m < 4; ++m)
#pragma unroll
                for (int n = 0; n < 2; ++n) acc[a][b][m][n] = (f32x4){0.f, 0.f, 0.f, 0.f};
    bf16x8 At[4][2], B0[2][2], B1[2][2];
    const char* cA = (const char*)g.A + (size_t)cur.pm * tstep; const char* cB = (const char*)g.Bt + (size_t)cur.pn * tstep;
    S.a_ready(cur);
    if constexpr (SP2) {
        PG8_STAGE(PG8_SB(0, 0), cB, voffB); PG8_STAGE(PG8_SB(0, 1), cB + hstep, voffB); PG8_STAGE(PG8_SA(0, 0), cA, voffA); PG8_STAGE(PG8_SA(0, 1), cA + hstep, voffA);
        if (wr == 1) PG8_BAR;
        PG8_WAIT_V(2); PG8_BAR;
        PG8_STAGE(PG8_SB(1, 0), cB + kstep, voffB); PG8_STAGE(PG8_SA(1, 0), cA + kstep, voffA); PG8_STAGE(PG8_SB(1, 1), cB + hstep + kstep, voffB);
        PG8_WAIT_V(6); PG8_BAR;
    } else {
        PG8_STAGE(PG8_SB(0, 0), cB, voffB); PG8_STAGE(PG8_SA(0, 0), cA, voffA); PG8_STAGE(PG8_SB(0, 1), cB + hstep, voffB); PG8_STAGE(PG8_SA(0, 1), cA + hstep, voffA);
        if (wr == 1) PG8_BAR;
        PG8_WAIT_V(4); PG8_BAR;
        PG8_STAGE(PG8_SB(1, 0), cB + kstep, voffB); PG8_STAGE(PG8_SA(1, 0), cA + kstep, voffA); PG8_STAGE(PG8_SB(1, 1), cB + hstep + kstep, voffB);
        PG8_WAIT_V(6); PG8_BAR;
    }
    for (;;) {
        const bool has_next = S.next(ui + 1, nxt);
        const char* nA = has_next ? (const char*)g.A + (size_t)nxt.pm * tstep : cA; const char* nB = has_next ? (const char*)g.Bt + (size_t)nxt.pn * tstep : cB;
        for (int t = 0; t < nt; t += 2) {
            const bool last = (t == nt - 2);
            const char* a1 = cA + (size_t)(t + 1) * kstep;
            const char* a2 = last ? nA : cA + (size_t)(t + 2) * kstep; const char* b2 = last ? nB : cB + (size_t)(t + 2) * kstep;
            const char* a3 = a2 + kstep; const char* b3 = b2 + kstep;
            if (last && has_next) S.a_ready(nxt);
            if constexpr (SP2) {
            PG8_LDB(B0, 0, 0); PG8_LDB(B1, 0, 1); PG8_SCHED; PG8_LDA(At, 0, 0); PG8_STAGE(PG8_SA(1, 1), a1 + hstep, voffA);
            PG8_WAIT_V(8); PG8_WAIT_L(0); PG8_BAR; PG8_MMA(0, 0, At, B0); PG8_MMA(0, 1, At, B1); PG8_BAR; PG8_SCHED;
            PG8_LDA(At, 0, 1); PG8_STAGE(PG8_SB(0, 0), b2, voffB); PG8_STAGE(PG8_SB(0, 1), b2 + hstep, voffB); PG8_STAGE(PG8_SA(0, 0), a2, voffA);
            PG8_WAIT_V(8); PG8_WAIT_L(0); PG8_BAR; PG8_MMA(1, 0, At, B0); PG8_MMA(1, 1, At, B1); PG8_BAR; PG8_SCHED;
            PG8_LDB(B0, 1, 0); PG8_LDB(B1, 1, 1); PG8_SCHED; PG8_LDA(At, 1, 0); PG8_STAGE(PG8_SA(0, 1), a2 + hstep, voffA);
            PG8_WAIT_V(8); PG8_WAIT_L(0); PG8_BAR; PG8_MMA(0, 0, At, B0); PG8_MMA(0, 1, At, B1); PG8_BAR; PG8_SCHED;
            PG8_LDA(At, 1, 1); PG8_STAGE(PG8_SB(1, 0), b3, voffB); PG8_STAGE(PG8_SB(1, 1), b3 + hstep, voffB); PG8_STAGE(PG8_SA(1, 0), a3, voffA);
            PG8_WAIT_V(8); PG8_WAIT_L(0); PG8_BAR; PG8_MMA(1, 0, At, B0); PG8_MMA(1, 1, At, B1); PG8_BAR; PG8_SCHED;
            } else {
            PG8_LDB(B0, 0, 0); PG8_SCHED; PG8_LDA(At, 0, 0); PG8_STAGE(PG8_SA(1, 1), a1 + hstep, voffA);
            PG8_WAIT_L(8); PG8_BAR; PG8_WAIT_L(0); PG8_MMA(0, 0, At, B0); PG8_BAR; PG8_SCHED;
            PG8_LDB(B1, 0, 1); PG8_STAGE(PG8_SB(0, 0), b2, voffB);
            PG8_BAR; PG8_WAIT_L(0); PG8_MMA(0, 1, At, B1); PG8_BAR;
            PG8_LDA(At, 0, 1); PG8_STAGE(PG8_SA(0, 0), a2, voffA);
            PG8_BAR; PG8_WAIT_L(0); PG8_MMA(1, 0, At, B0); PG8_BAR; PG8_SCHED;
            PG8_STAGE(PG8_SB(0, 1), b2 + hstep, voffB);
            PG8_WAIT_V(6); PG8_BAR; PG8_MMA(1, 1, At, B1); PG8_BAR;
            PG8_LDB(B0, 1, 0); PG8_SCHED; PG8_LDA(At, 1, 0); PG8_STAGE(PG8_SA(0, 1), a2 + hstep, voffA);
            PG8_WAIT_L(8); PG8_BAR; PG8_WAIT_L(0); PG8_MMA(0, 0, At, B0); PG8_BAR; PG8_SCHED;
            PG8_LDB(B1, 1, 1); PG8_STAGE(PG8_SB(1, 0), b3, voffB);
            PG8_BAR; PG8_WAIT_L(0); PG8_MMA(0, 1, At, B1); PG8_BAR;
            PG8_LDA(At, 1, 1); PG8_STAGE(PG8_SA(1, 0), a3, voffA);
            PG8_BAR; PG8_WAIT_L(0); PG8_MMA(1, 0, At, B0); PG8_BAR; PG8_SCHED;
            PG8_STAGE(PG8_SB(1, 1), b3 + hstep, voffB);
            PG8_WAIT_V(6); PG8_BAR; PG8_MMA(1, 1, At, B1); PG8_BAR;
            }
        }
        if constexpr (ALIGN_EPI) { if (wr == 0) PG8_BAR; }
        if constexpr (!Epi::AFTER_DRAIN) { E(acc, cur, wr, wc, fr, fq); S.done(cur); }
        if (!has_next) break;
#pragma unroll
        for (int a = 0; a < 2; ++a)
#pragma unroll
            for (int b = 0; b < 2; ++b)
#pragma unroll
                for (int m = 0; m < 4; ++m)
#pragma unroll
                    for (int n = 0; n < 2; ++n) acc[a][b][m][n] = (f32x4){0.f, 0.f, 0.f, 0.f};
        cur = nxt; cA = nA; cB = nB; ++ui;
        if constexpr (ALIGN_EPI) { if (wr == 1) PG8_BAR; }
    }
    PG8_WAIT_V(0);
    if constexpr (!ALIGN_EPI) { if (wr == 0) PG8_BAR; }
    PG8_BAR;
    if constexpr (Epi::AFTER_DRAIN) { E.fused(acc, cur, wr, wc, fr, fq, lds, wid, lane); S.done(cur); }
#undef PG8_SA
#undef PG8_SB
#undef PG8_STAGE
#undef PG8_LDA
#undef PG8_LDB
#undef PG8_MMA
#undef PG8_WAIT_V
#undef PG8_WAIT_L
#undef PG8_BAR
#undef PG8_SCHED
}
}

typedef unsigned short bf16_t;
typedef short bf16x8 __attribute__((ext_vector_type(8)));
typedef float f32x4 __attribute__((ext_vector_type(4)));
typedef float f32x2 __attribute__((ext_vector_type(2)));
typedef float f32x16 __attribute__((ext_vector_type(16)));
typedef unsigned u32x4 __attribute__((ext_vector_type(4)));
typedef unsigned u32x2 __attribute__((ext_vector_type(2)));
typedef __bf16 bf16x2_t __attribute__((ext_vector_type(2)));
#define LAS __attribute__((address_space(3)))

constexpr int S = 16384, D = 1024, DFF = 4096, NL = 2, MEML = 256;
constexpr int INCOLS = 4768;
constexpr float EPS = 1e-6f;
constexpr float LOG2E = 1.4426950408889634f;
constexpr float QS_SCALE = 0.125f * LOG2E;
constexpr float QM_SCALE = 0.08838834764831845f * LOG2E;
constexpr float QMLA_SCALE = 0.10206207261596575f * LOG2E;

constexpr size_t W_IN = 0;
constexpr size_t W_G = W_IN + (size_t)1792 * 1024;
constexpr size_t W_UQ = W_G + (size_t)3072 * 1024;
constexpr size_t W_UKV = W_UQ + (size_t)768 * 256;
constexpr size_t W_MEM = W_UKV + (size_t)1024 * 128;
constexpr size_t W_O = W_MEM + (size_t)1024 * 1024;
constexpr size_t W_OUT = W_O + (size_t)3 * 1024 * 512;
constexpr size_t W_UP = W_OUT + (size_t)1024 * 1024;
constexpr size_t W_DOWN = W_UP + (size_t)4096 * 1024;
constexpr size_t W_LAYER_ELEMS = W_DOWN + (size_t)1024 * 4096;
constexpr size_t MiB = 1u << 20;
constexpr size_t W_LAYER_BYTES = 34 * MiB;
static_assert(W_LAYER_ELEMS * 2 <= W_LAYER_BYTES, "weights");
constexpr size_t WS_W = 0;
constexpr size_t WS_XB = 68 * MiB;
constexpr size_t WS_SMALL = 100 * MiB;
constexpr size_t WS_RS = WS_SMALL;
constexpr size_t WS_RSTDM = WS_RS + 9 * (size_t)S * 4;
constexpr size_t WS_BIAS = WS_RSTDM + 1024;
constexpr size_t WS_ROPE = WS_BIAS + 4096;
constexpr size_t WS_MEMB = WS_ROPE + (size_t)S * 16 * 8;
constexpr size_t WS_KMEM = WS_MEMB + (size_t)256 * 1024 * 2;
constexpr size_t WS_VMEM = WS_KMEM + (size_t)256 * 512 * 2;
constexpr size_t WS_PTAB = WS_VMEM + (size_t)256 * 512 * 2;
constexpr size_t WS_BG = WS_PTAB + 64;
constexpr size_t WS_SINK = WS_BG + 2 * 3072 * 4;
constexpr size_t WS_FN = WS_SINK + 64;
constexpr size_t WS_BAR = WS_FN + 4096;
static_assert(WS_BAR + 16384 <= 104 * MiB, "small region");
constexpr size_t WS_H = 104 * MiB;
constexpr size_t WS_QMLA = 104 * MiB;
constexpr size_t WS_KMLA = 128 * MiB;
constexpr size_t WS_VMLA = 152 * MiB;
constexpr size_t WS_QS = 168 * MiB;
constexpr size_t WS_KS = 184 * MiB;
constexpr size_t WS_VS = 188 * MiB;
constexpr size_t WS_QM = 192 * MiB;
constexpr size_t WS_CQ = 208 * MiB;
constexpr size_t WS_CKV = 216 * MiB;
constexpr size_t WS_OMLA = 220 * MiB;
constexpr size_t WS_T = 104 * MiB;
constexpr size_t WS_YB = 136 * MiB;
static_assert(WS_OMLA + (size_t)S * 512 * 2 <= 256 * MiB, "ws");

struct Args {
    const float* in[21];
    float* out; unsigned char* ws;
};
enum { I_X = 0, I_MEM, I_RELB, I_ATTN_NORM, I_MEM_NORM, I_W_IN, I_B_GATE, I_QNORM, I_W_UQ, I_KVNORM, I_W_UKV, I_SINKS, I_W_MEMKV, I_WO_MLA, I_WO_SWA, I_WO_MEM, I_W_OUT, I_MLP_NORM, I_W_UP, I_W_DOWN, I_FNORM };

__device__ __forceinline__ unsigned cvtpk(float lo, float hi) { f32x2 v = {lo, hi}; bf16x2_t b = __builtin_convertvector(v, bf16x2_t); return __builtin_bit_cast(unsigned, b); }
__device__ __forceinline__ float bf_lo(unsigned u) { return __uint_as_float(u << 16); }
__device__ __forceinline__ float bf_hi(unsigned u) { return __uint_as_float(u & 0xffff0000u); }
__device__ __forceinline__ float wave_sum(float v) {
#pragma unroll
    for (int o = 1; o < 64; o <<= 1) v += __shfl_xor(v, o);
    return v;
}

enum { M_WIN = 0, M_MEM, M_UQ, M_UKV, M_GATE, M_Z, M_RES, M_UP };
struct Epi {
    static constexpr bool PERM = true, AFTER_DRAIN = false;
    int mode, br, layer; unsigned char* ws;
    __device__ __forceinline__ void store8(bf16_t* dst, const f32x4& a, const f32x4& b) const {
        u32x4 w; w.x = cvtpk(a[0], a[1]); w.y = cvtpk(a[2], a[3]); w.z = cvtpk(b[0], b[1]); w.w = cvtpk(b[2], b[3]);
        *(u32x4*)dst = w;
    }
    __device__ __forceinline__ float sq8(const f32x4& a0, const f32x4& a1) const { return (a0[0]*a0[0] + a0[1]*a0[1]) + (a0[2]*a0[2] + a0[3]*a0[3]) + (a1[0]*a1[0] + a1[1]*a1[1]) + (a1[2]*a1[2] + a1[3]*a1[3]); }
    __device__ __forceinline__ void operator()(const f32x4 (&acc)[2][2][4][2], const pg8::Unit& u, int wr, int wc, int fr_in, int fq_in) const {
        int fr = fr_in, fq = fq_in; asm volatile("" : "+v"(fr), "+v"(fq));
        const int pn = u.pn;
        float* RS = (float*)(ws + WS_RS);
        const float* rs_in = RS + (size_t)(4 * layer) * S; float inv_k = 1.0f / 1024.0f;
        if (mode == M_MEM) rs_in = (const float*)(ws + WS_RSTDM);
        if (mode == M_UQ) { rs_in = RS + (size_t)(4 * layer + 1) * S; inv_k = 1.0f / 256.0f; }
        if (mode == M_UKV) { rs_in = RS + (size_t)(4 * layer + 2) * S; inv_k = 1.0f / 128.0f; }
        if (mode == M_UP) rs_in = RS + (size_t)(4 * layer + 3) * S;
        float* rs_out = RS + (size_t)(4 * layer + 1) * S;
        if (mode == M_WIN && pn == 1) rs_out = RS + (size_t)(4 * layer + 2) * S;
        if (mode == M_RES) rs_out = RS + (size_t)(4 * layer + 3 + br) * S;
        const float* resid = nullptr; float* X = nullptr;
        if (mode == M_RES) { X = *(float* const*)(ws + WS_PTAB + 8); resid = (layer == 0 && br == 0) ? *(const float* const*)(ws + WS_PTAB) : X; }
#pragma unroll
        for (int ai = 0; ai < 2; ++ai)
#pragma unroll
            for (int m = 0; m < 4; ++m) {
                const int row = u.pm * 256 + ai * 128 + wr * 64 + m * 16 + fr;
                float sc = 1.f;
                if (mode == M_MEM) sc = rs_in[row];
                else if (mode != M_Z && mode != M_RES) sc = __builtin_amdgcn_rsqf(rs_in[row] * inv_k + EPS);
                if (mode == M_UQ) sc *= QMLA_SCALE;
                float ss = 0.f;
#pragma unroll
                for (int bj = 0; bj < 2; ++bj) {
                    const int ct = bj * 128 + wc * 32 + 8 * fq;
                    f32x4 a0 = acc[ai][bj][m][0] * sc, a1 = acc[ai][bj][m][1] * sc;
                    switch (mode) {
                    case M_WIN: {
                        if (pn == 0) { store8((bf16_t*)(ws + WS_CQ) + (size_t)row * 256 + ct, a0, a1); ss += sq8(a0, a1); }
                        else if (pn == 1) {
                            if (bj == 0) { store8((bf16_t*)(ws + WS_CKV) + (size_t)row * 128 + ct, a0, a1); ss += sq8(a0, a1); }
                            else if (wc == 0) {
                                const f32x2* cs = (const f32x2*)(ws + WS_ROPE) + (size_t)row * 16 + 4 * fq;
                                f32x4 o1, o2;
#pragma unroll
                                for (int e = 0; e < 4; ++e) { const f32x2 c = cs[e]; o1[e] = a0[e] * c.x - a1[e] * c.y; o2[e] = a1[e] * c.x + a0[e] * c.y; }
                                u32x2 w1, w2; w1.x = cvtpk(o1[0], o1[1]); w1.y = cvtpk(o1[2], o1[3]); w2.x = cvtpk(o2[0], o2[1]); w2.y = cvtpk(o2[2], o2[3]);
                                bf16_t* kr = (bf16_t*)(ws + WS_KMLA) + (size_t)row * 768 + 64 + 4 * fq;
#pragma unroll
                                for (int hh = 0; hh < 8; ++hh) { *(u32x2*)(kr + hh * 96) = w1; *(u32x2*)(kr + hh * 96 + 16) = w2; }
                            }
                        }
                        else if (pn < 4) { store8((bf16_t*)(ws + WS_QS) + (size_t)row * 512 + (pn - 2) * 256 + ct, a0 * QS_SCALE, a1 * QS_SCALE); }
                        else if (pn == 4) { if (bj == 0) store8((bf16_t*)(ws + WS_KS) + (size_t)row * 128 + ct, a0, a1); else store8((bf16_t*)(ws + WS_VS) + (size_t)row * 128 + ct - 128, a0, a1); }
                        else { store8((bf16_t*)(ws + WS_QM) + (size_t)row * 512 + (pn - 5) * 256 + ct, a0 * QM_SCALE, a1 * QM_SCALE); }
                    } break;
                    case M_MEM: {
                        if (pn < 2) store8((bf16_t*)(ws + WS_KMEM) + (size_t)row * 512 + pn * 256 + ct, a0, a1);
                        else store8((bf16_t*)(ws + WS_VMEM) + (size_t)row * 512 + (pn - 2) * 256 + ct, a0, a1);
                    } break;
                    case M_UQ: {
                        if (pn < 2) { const int c = pn * 256 + ct; store8((bf16_t*)(ws + WS_QMLA) + (size_t)row * 768 + (c >> 6) * 96 + (c & 63), a0, a1); }
                        else {
                            const int head = 4 * bj + wc;
                            const f32x2* cs = (const f32x2*)(ws + WS_ROPE) + (size_t)row * 16 + 4 * fq;
                            f32x4 o1, o2;
#pragma unroll
                            for (int e = 0; e < 4; ++e) { const f32x2 c = cs[e]; o1[e] = a0[e] * c.x - a1[e] * c.y; o2[e] = a1[e] * c.x + a0[e] * c.y; }
                            u32x2 w1, w2; w1.x = cvtpk(o1[0], o1[1]); w1.y = cvtpk(o1[2], o1[3]); w2.x = cvtpk(o2[0], o2[1]); w2.y = cvtpk(o2[2], o2[3]);
                            bf16_t* qrp = (bf16_t*)(ws + WS_QMLA) + (size_t)row * 768 + head * 96 + 64 + 4 * fq;
                            *(u32x2*)qrp = w1; *(u32x2*)(qrp + 16) = w2;
                        }
                    } break;
                    case M_UKV: {
                        if (pn < 2) { const int c = pn * 256 + ct; store8((bf16_t*)(ws + WS_KMLA) + (size_t)row * 768 + (c >> 6) * 96 + (c & 63), a0, a1); }
                        else store8((bf16_t*)(ws + WS_VMLA) + (size_t)row * 512 + (pn - 2) * 256 + ct, a0, a1);
                    } break;
                    case M_GATE: {
                        const int c = pn * 256 + ct;
                        const float* bg = (const float*)(ws + WS_BG) + layer * 3072 + br * 1024 + c;
                        const f32x4 b0 = *(const f32x4*)bg, b1 = *(const f32x4*)(bg + 4);
                        f32x4 g0, g1;
#pragma unroll
                        for (int e = 0; e < 4; ++e) { g0[e] = __builtin_amdgcn_rcpf(1.f + __builtin_amdgcn_exp2f(-(a0[e] + b0[e]) * LOG2E)); g1[e] = __builtin_amdgcn_rcpf(1.f + __builtin_amdgcn_exp2f(-(a1[e] + b1[e]) * LOG2E)); }
                        store8((bf16_t*)(ws + WS_T) + (size_t)row * 1024 + c, g0, g1);
                    } break;
                    case M_Z: {
                        const int c = pn * 256 + ct;
                        const u32x4 t = *(const u32x4*)((bf16_t*)(ws + WS_T) + (size_t)row * 1024 + c);
                        bf16_t* yp = (bf16_t*)(ws + WS_YB) + (size_t)row * 1024 + c;
                        f32x4 y0 = {0.f, 0.f, 0.f, 0.f}, y1 = {0.f, 0.f, 0.f, 0.f};
                        if (br > 0) { const u32x4 yo = *(const u32x4*)yp;
                            y0 = (f32x4){bf_lo(yo.x), bf_hi(yo.x), bf_lo(yo.y), bf_hi(yo.y)}; y1 = (f32x4){bf_lo(yo.z), bf_hi(yo.z), bf_lo(yo.w), bf_hi(yo.w)}; }
                        y0 += a0 * (f32x4){bf_lo(t.x), bf_hi(t.x), bf_lo(t.y), bf_hi(t.y)};
                        y1 += a1 * (f32x4){bf_lo(t.z), bf_hi(t.z), bf_lo(t.w), bf_hi(t.w)};
                        store8(yp, y0, y1);
                    } break;
                    case M_RES: {
                        const int c = pn * 256 + ct;
                        const f32x4 x0 = *(const f32x4*)(resid + (size_t)row * 1024 + c) + a0, x1 = *(const f32x4*)(resid + (size_t)row * 1024 + c + 4) + a1;
                        *(f32x4*)(X + (size_t)row * 1024 + c) = x0; *(f32x4*)(X + (size_t)row * 1024 + c + 4) = x1;
                        store8((bf16_t*)(ws + WS_XB) + (size_t)row * 1024 + c, x0, x1);
                        ss += sq8(x0, x1);
                    } break;
                    default: {
                        f32x4 r0, r1;
#pragma unroll
                        for (int e = 0; e < 4; ++e) { const float v0 = fmaxf(a0[e], 0.f), v1 = fmaxf(a1[e], 0.f); r0[e] = v0 * v0; r1[e] = v1 * v1; }
                        store8((bf16_t*)(ws + WS_H) + (size_t)row * 4096 + pn * 256 + ct, r0, r1);
                    } break;
                    }
                }
                if (mode == M_RES || (mode == M_WIN && pn < 2)) {
                    ss += __shfl_xor(ss, 16); ss += __shfl_xor(ss, 32);
                    if (fq == 0) atomicAdd(rs_out + row, ss);
                }
            }
    }
};

__device__ __forceinline__ int crow(int i, int h) { return (i & 3) + 8 * (i >> 2) + 4 * h; }
#define MFMA32(a, b, c) __builtin_amdgcn_mfma_f32_32x32x16_bf16((a), (b), (c), 0, 0, 0)

template <int DQK, int DV, int MODE>
__device__ __forceinline__ void attn_unit(LAS unsigned char* lds, const bf16_t* Q, int qpitch, const bf16_t* K, int kpitch, const bf16_t* V, int vpitch,
                                          bf16_t* O, int opitch, int q0, int t_begin, int t_end, const float* biasrow, float sink_l2, int tid) {
    constexpr int KSTR = (DQK + 8) * 2, VSTR = 144, KBUF = 64 * KSTR, VBUF = DV * VSTR;
    constexpr int NKC = DQK / 8, NKCH = 64 * NKC, KIT = (NKCH + 511) / 512, VIT = DV / 64, NC = DQK / 16, NDB = DV / 32;
    constexpr int OFF_K = 0, OFF_V = 2 * KBUF, OFF_BIAS = 2 * KBUF + 2 * VBUF;
    static_assert(OFF_BIAS + 512 <= 131072, "attention lds");
    const int lane = tid & 63, w = __builtin_amdgcn_readfirstlane(tid >> 6), r = lane & 31, h = lane >> 5;
    const int R0 = q0 + 32 * w;
    LAS float* biasl = (LAS float*)(lds + OFF_BIAS);
    if (MODE == 1) { if (tid < 128) biasl[tid] = biasrow[tid]; }
    bf16x8 qr[NC];
#pragma unroll
    for (int c = 0; c < NC; ++c) qr[c] = *(const bf16x8*)(Q + (size_t)(R0 + r) * qpitch + 16 * c + 8 * h);
    u32x4 kst[KIT], vst[VIT];
    const int vpos = (lane & ~15) | (((lane >> 2) & 1) << 3) | (((lane >> 3) & 1) << 2) | (lane & 3);
#define ATT_LOAD(t) do { \
        _Pragma("unroll") for (int i_ = 0; i_ < KIT; ++i_) { const int c_ = tid + 512 * i_; if (c_ < NKCH) { const int row_ = c_ / NKC, col_ = c_ % NKC; \
            kst[i_] = *(const u32x4*)(K + (size_t)(64 * (t) + row_) * kpitch + col_ * 8); } } \
        _Pragma("unroll") for (int i_ = 0; i_ < VIT; ++i_) vst[i_] = *(const u32x4*)(V + (size_t)(64 * (t) + lane) * vpitch + (w + 8 * i_) * 8); } while (0)
#define ATT_STORE(buf) do { \
        _Pragma("unroll") for (int i_ = 0; i_ < KIT; ++i_) { const int c_ = tid + 512 * i_; if (c_ < NKCH) { const int row_ = c_ / NKC, col_ = c_ % NKC; \
            *(LAS u32x4*)(lds + OFF_K + (buf) * KBUF + row_ * KSTR + col_ * 16) = kst[i_]; } } \
        _Pragma("unroll") for (int i_ = 0; i_ < VIT; ++i_) { LAS unsigned short* vd_ = (LAS unsigned short*)(lds + OFF_V + (buf) * VBUF + ((w + 8 * i_) * 8) * VSTR + vpos * 2); \
            const u32x4 v_ = vst[i_]; \
            vd_[0 * (VSTR / 2)] = (unsigned short)(v_.x & 0xffffu); vd_[1 * (VSTR / 2)] = (unsigned short)(v_.x >> 16); \
            vd_[2 * (VSTR / 2)] = (unsigned short)(v_.y & 0xffffu); vd_[3 * (VSTR / 2)] = (unsigned short)(v_.y >> 16); \
            vd_[4 * (VSTR / 2)] = (unsigned short)(v_.z & 0xffffu); vd_[5 * (VSTR / 2)] = (unsigned short)(v_.z >> 16); \
            vd_[6 * (VSTR / 2)] = (unsigned short)(v_.w & 0xffffu); vd_[7 * (VSTR / 2)] = (unsigned short)(v_.w >> 16); } } while (0)

    float mrun = (MODE == 1) ? sink_l2 : -INFINITY;
    float lrun = (MODE == 1 && h == 0) ? 1.f : 0.f;
    f32x16 o[NDB];
#pragma unroll
    for (int db = 0; db < NDB; ++db)
#pragma unroll
        for (int i = 0; i < 16; ++i) o[db][i] = 0.f;

    ATT_LOAD(t_begin);
    ATT_STORE(0);
    __syncthreads();
    for (int t = t_begin; t < t_end; ++t) {
        const int buf = (t - t_begin) & 1;
        const bool more = (t + 1 < t_end);
        if (more) ATT_LOAD(t + 1);
        bool skip = false;
        if (MODE == 0) skip = (64 * t > R0 + 31);
        if (MODE == 1) skip = (64 * t > R0 + 31) || (64 * t + 63 < R0 - 127);
        if (!skip) {
            f32x16 p0, p1;
#pragma unroll
            for (int i = 0; i < 16; ++i) { p0[i] = 0.f; p1[i] = 0.f; }
            const LAS unsigned char* kp = lds + OFF_K + buf * KBUF + r * KSTR + h * 16;
#pragma unroll
            for (int c = 0; c < NC; ++c) {
                const bf16x8 k0 = *(const LAS bf16x8*)(kp + c * 32);
                const bf16x8 k1 = *(const LAS bf16x8*)(kp + 32 * KSTR + c * 32);
                p0 = MFMA32(k0, qr[c], p0); p1 = MFMA32(k1, qr[c], p1);
            }
            const int qa = R0 + r;
            if (MODE == 0) {
                if (64 * t + 63 > R0) {
#pragma unroll
                    for (int i = 0; i < 16; ++i) { const int kv = 64 * t + crow(i, h); if (kv > qa) p0[i] = -INFINITY; if (kv + 32 > qa) p1[i] = -INFINITY; }
                }
            }
            if (MODE == 1) {
#pragma unroll
                for (int i = 0; i < 16; ++i) { const int d0 = qa - (64 * t + crow(i, h)), d1 = d0 - 32;
                    const float b0 = biasl[d0 & 127], b1 = biasl[d1 & 127];
                    p0[i] = (d0 >= 0 && d0 < 128) ? p0[i] + b0 : -INFINITY; p1[i] = (d1 >= 0 && d1 < 128) ? p1[i] + b1 : -INFINITY; }
            }
            float mx = fmaxf(p0[0], p1[0]);
#pragma unroll
            for (int i = 1; i < 16; ++i) mx = fmaxf(mx, fmaxf(p0[i], p1[i]));
            mx = fmaxf(mx, __shfl_xor(mx, 32));
            const float mnew = fmaxf(mrun, mx);
            const float alpha = __builtin_amdgcn_exp2f(mrun - mnew);
            mrun = mnew;
            float ls = 0.f;
#pragma unroll
            for (int i = 0; i < 16; ++i) { p0[i] = __builtin_amdgcn_exp2f(p0[i] - mnew); p1[i] = __builtin_amdgcn_exp2f(p1[i] - mnew); ls += p0[i] + p1[i]; }
            lrun = lrun * alpha + ls;
#pragma unroll
            for (int db = 0; db < NDB; ++db)
#pragma unroll
                for (int i = 0; i < 16; ++i) o[db][i] *= alpha;
            bf16x8 pa[4];
#pragma unroll
            for (int s = 0; s < 4; ++s) {
                u32x4 pk;
                if (s < 2) { pk.x = cvtpk(p0[8 * s + 0], p0[8 * s + 1]); pk.y = cvtpk(p0[8 * s + 2], p0[8 * s + 3]); pk.z = cvtpk(p0[8 * s + 4], p0[8 * s + 5]); pk.w = cvtpk(p0[8 * s + 6], p0[8 * s + 7]); }
                else { const int s2 = s - 2; pk.x = cvtpk(p1[8 * s2 + 0], p1[8 * s2 + 1]); pk.y = cvtpk(p1[8 * s2 + 2], p1[8 * s2 + 3]); pk.z = cvtpk(p1[8 * s2 + 4], p1[8 * s2 + 5]); pk.w = cvtpk(p1[8 * s2 + 6], p1[8 * s2 + 7]); }
                pa[s] = __builtin_bit_cast(bf16x8, pk);
            }
            const LAS unsigned char* vp = lds + OFF_V + buf * VBUF + r * VSTR + h * 16;
#pragma unroll
            for (int db = 0; db < NDB; ++db)
#pragma unroll
                for (int s = 0; s < 4; ++s) {
                    const bf16x8 vf = *(const LAS bf16x8*)(vp + db * 32 * VSTR + s * 32);
                    o[db] = MFMA32(vf, pa[s], o[db]);
                }
        }
        if (more) ATT_STORE(buf ^ 1);
        __syncthreads();
    }
    lrun += __shfl_xor(lrun, 32);
    const float inv = 1.f / lrun;
    bf16_t* orow = O + (size_t)(R0 + r) * opitch;
#pragma unroll
    for (int db = 0; db < NDB; ++db)
#pragma unroll
        for (int g = 0; g < 4; ++g) {
            u32x2 wv; wv.x = cvtpk(o[db][4 * g + 0] * inv, o[db][4 * g + 1] * inv); wv.y = cvtpk(o[db][4 * g + 2] * inv, o[db][4 * g + 3] * inv);
            *(u32x2*)(orow + 32 * db + 8 * g + 4 * h) = wv;
        }
#undef ATT_LOAD
#undef ATT_STORE
}

__device__ __forceinline__ int map_col(int kind, int off, int n) {
    switch (kind) {
    case 1: {
        if (n < 256) return n;
        if (n < 512) { const int j = n - 256; if (j < 128) return 256 + j; if (j < 160) { const int p = j - 128; return 384 + 16 * ((p >> 2) & 1) + 4 * (p >> 3) + (p & 3); } return -1; }
        if (n < 1024) return 416 + (n - 512);
        if (n < 1280) return 928 + (n - 1024);
        return 1184 + (n - 1280);
    }
    case 2: {
        if (n < 512) return (n >> 6) * 96 + (n & 63);
        const int j = n - 512, hd = j >> 5, p = j & 31; return hd * 96 + 64 + 16 * ((p >> 2) & 1) + 4 * (p >> 3) + (p & 3);
    }
    case 3: {
        if (n < 512) return (n >> 6) * 128 + (n & 63);
        const int j = n - 512; return (j >> 6) * 128 + 64 + (j & 63);
    }
    default: return off + n;
    }
}
__device__ __forceinline__ void conv_matrix(const float* W, int K, int Nsrc, const float* gain, bf16_t* WT, int Ndst, int kind, int off, LAS float* scr, int gw, int ngw, int lane) {
    const int nblk = Ndst / 64, nitems = (K / 64) * nblk;
    const int kq = lane >> 4, n4 = lane & 15;
    for (int it = gw; it < nitems; it += ngw) {
        const int kb = it / nblk, nb = it % nblk, k0 = 64 * kb, n0 = 64 * nb;
        const int src = map_col(kind, off, n0 + 4 * n4);
        f32x4 v[16];
#pragma unroll
        for (int i = 0; i < 16; ++i) { v[i] = (f32x4){0.f, 0.f, 0.f, 0.f}; if (src >= 0) v[i] = *(const f32x4*)(W + (size_t)(k0 + 4 * i + kq) * Nsrc + src); }
        if (gain) {
#pragma unroll
            for (int i = 0; i < 16; ++i) v[i] = v[i] * gain[k0 + 4 * i + kq];
        }
#pragma unroll
        for (int i = 0; i < 16; ++i) { LAS float* d = scr + (4 * i + kq) * 65 + 4 * n4; d[0] = v[i][0]; d[1] = v[i][1]; d[2] = v[i][2]; d[3] = v[i][3]; }
        asm volatile("s_waitcnt lgkmcnt(0)" ::: "memory");
        const int c = lane & 7;
#pragma unroll
        for (int j = 0; j < 8; ++j) { const int n = (lane >> 3) + 8 * j; const LAS float* sp = scr + (8 * c) * 65 + n;
            u32x4 o; o.x = cvtpk(sp[0 * 65], sp[1 * 65]); o.y = cvtpk(sp[2 * 65], sp[3 * 65]); o.z = cvtpk(sp[4 * 65], sp[5 * 65]); o.w = cvtpk(sp[6 * 65], sp[7 * 65]);
            *(u32x4*)(WT + (size_t)(n0 + n) * K + k0 + 8 * c) = o; }
        asm volatile("s_waitcnt lgkmcnt(0)" ::: "memory");
    }
}
__device__ __forceinline__ float row_to_bf16(const float* xrow, bf16_t* orow, int lane) {
    const f32x4* xr = (const f32x4*)xrow + lane;
    f32x4 v[4]; float s = 0.f;
#pragma unroll
    for (int j = 0; j < 4; ++j) { v[j] = xr[64 * j]; s += (v[j][0] * v[j][0] + v[j][1] * v[j][1]) + (v[j][2] * v[j][2] + v[j][3] * v[j][3]); }
    u32x2* o8 = (u32x2*)orow + lane;
#pragma unroll
    for (int j = 0; j < 4; ++j) { u32x2 wv; wv.x = cvtpk(v[j][0], v[j][1]); wv.y = cvtpk(v[j][2], v[j][3]); o8[64 * j] = wv; }
    return wave_sum(s);
}
__device__ __forceinline__ float rope_inv(int i) {
    const float t[16] = {1.000000000e+00f, 5.623413324e-01f, 3.162277639e-01f, 1.778279394e-01f, 1.000000015e-01f, 5.623412877e-02f, 3.162277862e-02f, 1.778279431e-02f,
                         9.999999776e-03f, 5.623413250e-03f, 3.162277862e-03f, 1.778279431e-03f, 1.000000047e-03f, 5.623413017e-04f, 3.162277862e-04f, 1.778279402e-04f};
    float r = t[0];
#pragma unroll
    for (int k = 1; k < 16; ++k) r = (i == k) ? t[k] : r;
    return r;
}

#define XB_TMO      128
#define XB_XCNT(j)  (256  + 64 * (j))
#define XB_XSUB(j)  (1280 + 64 * (j))
#define XB_XGEN(j)  (2304 + 64 * (j))
#define XB_TOP      3328
#define XB_TOPGEN   3392
#define XCD_BAR_WORDS 3456
#define XB_SPIN_CAP (1u << 18)

__device__ __forceinline__ unsigned xb_ld(unsigned* p)              { return __hip_atomic_load(p, __ATOMIC_RELAXED, __HIP_MEMORY_SCOPE_AGENT); }
__device__ __forceinline__ unsigned xb_add(unsigned* p, unsigned v) { return __hip_atomic_fetch_add(p, v, __ATOMIC_RELAXED, __HIP_MEMORY_SCOPE_AGENT); }
__device__ __forceinline__ unsigned xb_xcc_id() { return (unsigned)__builtin_amdgcn_s_getreg((3 << 11) | 20) & 0xFu; }
#define XB_SPIN(cond, bar) do { unsigned _sp = 0; while (cond) { __builtin_amdgcn_s_sleep(1); \
    if ((++_sp & 255u) == 0u) { if (xb_ld(&(bar)[XB_TMO])) break; if (_sp > XB_SPIN_CAP) { atomicAdd(&(bar)[XB_TMO], 1u); break; } } } } while (0)

struct XcdBarrier {
    unsigned* bar; unsigned x;
    volatile LAS unsigned* st;
};

__device__ __forceinline__ XcdBarrier xcd_barrier_post(unsigned* bar, volatile LAS unsigned* st) {
    XcdBarrier b; b.bar = bar; b.x = xb_xcc_id(); b.st = st;
    if (threadIdx.x == 0) (void)xb_add(&bar[XB_XCNT(b.x)], 1u);
    return b;
}
__device__ __forceinline__ void xcd_barrier_complete(unsigned* bar, unsigned x, unsigned& nloc, unsigned& nx) {
    const unsigned G = gridDim.x * gridDim.y * gridDim.z;
    unsigned sum, cnt, mine, sp = 0u;
    for (;;) {
        sum = 0u; cnt = 0u; mine = 0u;
#pragma unroll
        for (unsigned j = 0; j < 16; ++j) { const unsigned c = xb_ld(&bar[XB_XCNT(j)]); sum += c; cnt += (c > 0u) ? 1u : 0u; mine = (j == x) ? c : mine; }
        if (sum == G) break;
        __builtin_amdgcn_s_sleep(1);
        if ((++sp & 255u) == 0u) { if (xb_ld(&bar[XB_TMO])) break; if (sp > XB_SPIN_CAP) { atomicAdd(&bar[XB_TMO], 1u); break; } }
    }
    nloc = mine > 0u ? mine : 1u; nx = cnt > 0u ? cnt : 1u;
}

__device__ __forceinline__ void xcd_barrier(const XcdBarrier& b) {
    asm volatile("s_waitcnt vmcnt(0)" ::: "memory");
    __syncthreads();
    if (threadIdx.x == 0) {
        unsigned* bar = b.bar;
        __builtin_amdgcn_s_waitcnt(0);
        unsigned nloc = b.st[0], nx = b.st[1];
        if (nloc == 0u) { xcd_barrier_complete(bar, b.x, nloc, nx); b.st[0] = nloc; b.st[1] = nx; }
        const unsigned old = xb_add(&bar[XB_XSUB(b.x)], 1u);
        const unsigned gen = old / nloc;
        if (old + 1u == (gen + 1u) * nloc) {
            __builtin_amdgcn_fence(__ATOMIC_RELEASE, "agent");
            asm volatile("s_waitcnt vmcnt(0)" ::: "memory");
            const unsigned og = xb_add(&bar[XB_TOP], 1u);
            const unsigned tg = og / nx;
            if (og + 1u == (tg + 1u) * nx) xb_add(&bar[XB_TOPGEN], 1u);
            else XB_SPIN(xb_ld(&bar[XB_TOPGEN]) == tg, bar);
            __builtin_amdgcn_fence(__ATOMIC_ACQUIRE, "agent");
            xb_add(&bar[XB_XGEN(b.x)], 1u);
            asm volatile("s_waitcnt vmcnt(0)" ::: "memory");
        } else {
            XB_SPIN(xb_ld(&bar[XB_XGEN(b.x)]) == gen, bar);
            __builtin_amdgcn_fence(__ATOMIC_ACQUIRE, "agent");
            asm volatile("s_waitcnt vmcnt(0)" ::: "memory");
        }
    }
    __syncthreads();
}

constexpr int LDS_BYTES = 147456;
__global__ void __launch_bounds__(512, 2) fwd_mega(Args a) {
    extern __shared__ __attribute__((aligned(16))) unsigned char lds_raw[];
    LAS unsigned char* lds = (LAS unsigned char*)lds_raw;
    cg::grid_group grid = cg::this_grid();
    const int tid = threadIdx.x, lane = tid & 63, wave = __builtin_amdgcn_readfirstlane(tid >> 6);
    const int G = gridDim.x, bid = blockIdx.x;
    unsigned char* ws = a.ws;

    {
        bf16_t* XB = (bf16_t*)(ws + WS_XB);
        float* RS = (float*)(ws + WS_RS);
        LAS float* scr = (LAS float*)(lds + wave * 16896);
        const int gw = bid * 8 + wave, ngw = G * 8;
        for (int l = 0; l < NL; ++l) {
            bf16_t* WL = (bf16_t*)(ws + WS_W + (size_t)l * W_LAYER_BYTES);
            const float* an = a.in[I_ATTN_NORM] + l * D;
            conv_matrix(a.in[I_W_IN] + (size_t)l * D * INCOLS, D, INCOLS, an, WL + W_IN, 1792, 1, 0, scr, gw, ngw, lane);
            conv_matrix(a.in[I_W_IN] + (size_t)l * D * INCOLS, D, INCOLS, an, WL + W_G, 3072, 0, 1696, scr, gw, ngw, lane);
            conv_matrix(a.in[I_W_UQ] + (size_t)l * 256 * 768, 256, 768, a.in[I_QNORM] + l * 256, WL + W_UQ, 768, 2, 0, scr, gw, ngw, lane);
            conv_matrix(a.in[I_W_UKV] + (size_t)l * 128 * 1024, 128, 1024, a.in[I_KVNORM] + l * 128, WL + W_UKV, 1024, 3, 0, scr, gw, ngw, lane);
            conv_matrix(a.in[I_W_MEMKV] + (size_t)l * D * 1024, D, 1024, a.in[I_MEM_NORM] + l * D, WL + W_MEM, 1024, 0, 0, scr, gw, ngw, lane);
            conv_matrix(a.in[I_WO_MLA] + (size_t)l * 512 * D, 512, D, nullptr, WL + W_O, 1024, 0, 0, scr, gw, ngw, lane);
            conv_matrix(a.in[I_WO_SWA] + (size_t)l * 512 * D, 512, D, nullptr, WL + W_O + (size_t)1024 * 512, 1024, 0, 0, scr, gw, ngw, lane);
            conv_matrix(a.in[I_WO_MEM] + (size_t)l * 512 * D, 512, D, nullptr, WL + W_O + (size_t)2 * 1024 * 512, 1024, 0, 0, scr, gw, ngw, lane);
            conv_matrix(a.in[I_W_OUT] + (size_t)l * D * D, D, D, nullptr, WL + W_OUT, 1024, 0, 0, scr, gw, ngw, lane);
            conv_matrix(a.in[I_W_UP] + (size_t)l * D * DFF, D, DFF, a.in[I_MLP_NORM] + l * D, WL + W_UP, 4096, 0, 0, scr, gw, ngw, lane);
            conv_matrix(a.in[I_W_DOWN] + (size_t)l * DFF * D, DFF, D, nullptr, WL + W_DOWN, 1024, 0, 0, scr, gw, ngw, lane);
        }
        for (int m = gw; m < S; m += ngw) { const float ss = row_to_bf16(a.in[I_X] + (size_t)m * D, XB + (size_t)m * D, lane); if (lane == 0) RS[m] = ss; }
        { bf16_t* MEMB = (bf16_t*)(ws + WS_MEMB); float* RSTDM = (float*)(ws + WS_RSTDM);
          for (int m = gw; m < MEML; m += ngw) { const float ss = row_to_bf16(a.in[I_MEM] + (size_t)m * D, MEMB + (size_t)m * D, lane); if (lane == 0) RSTDM[m] = 1.0f / sqrtf(ss * (1.0f / D) + EPS); } }
        const int gt = bid * 512 + tid, ngt = G * 512;
        for (int i = gt; i < 8 * S; i += ngt) RS[S + i] = 0.f;
        { f32x2* ROPE = (f32x2*)(ws + WS_ROPE);
          for (int i = gt; i < S * 16; i += ngt) {
            const int pos = i >> 4, fi = i & 15;
            const float ang = (float)pos * rope_inv(fi);
            const double rev = (double)ang * 0.15915494309189535;
            const float fr = (float)(rev - __builtin_rint(rev));
            f32x2 cs; cs.x = __builtin_amdgcn_cosf(fr); cs.y = __builtin_amdgcn_sinf(fr);
            ROPE[i] = cs;
          } }
        { float* BIAS = (float*)(ws + WS_BIAS);
          for (int i = gt; i < 8 * 128; i += ngt) {
            const int hh = i >> 7, n = i & 127;
            int bucket = n;
            if (n >= 16) { const float lg = __builtin_amdgcn_logf((float)n * 0.0625f) * (16.0f / 3.0f); bucket = 16 + (int)lg; if (bucket > 31) bucket = 31; }
            BIAS[i] = a.in[I_RELB][bucket * 8 + hh] * LOG2E;
          } }
        { float* BG = (float*)(ws + WS_BG); float* SK = (float*)(ws + WS_SINK); float* FN = (float*)(ws + WS_FN);
          for (int i = gt; i < 2 * 3072; i += ngt) BG[i] = a.in[I_B_GATE][i];
          for (int i = gt; i < 16; i += ngt) SK[i] = a.in[I_SINKS][i] * LOG2E;
          for (int i = gt; i < 1024; i += ngt) FN[i] = a.in[I_FNORM][i];
          for (int i = gt; i < 4096; i += ngt) ((unsigned*)(ws + WS_BAR))[i] = 0u;
          if (gt == 0) { unsigned long long* pt = (unsigned long long*)(ws + WS_PTAB); pt[0] = (unsigned long long)(uintptr_t)a.in[I_X]; pt[1] = (unsigned long long)(uintptr_t)a.out; } }
    }
    if (tid < 2) ((volatile LAS unsigned*)(lds + 143360))[tid] = 0u;
    grid.sync();
    const XcdBarrier xbar = xcd_barrier_post((unsigned*)(ws + WS_BAR), (volatile LAS unsigned*)(lds + 143360));

    constexpr int NSTEPS = 14 * NL;
    for (int step = 0; step < NSTEPS; ++step) {
        bool do_sync = true;
        const int l = step / 14, k = step % 14;
        if (k == 4) {
            int tidv = threadIdx.x; asm volatile("" : "+v"(tidv));
            bf16_t* QMLA = (bf16_t*)(ws + WS_QMLA); bf16_t* KMLA = (bf16_t*)(ws + WS_KMLA); bf16_t* VMLA = (bf16_t*)(ws + WS_VMLA); bf16_t* OMLA = (bf16_t*)(ws + WS_OMLA);
            for (int u = bid; u < 256; u += G) {
                const int hh = u & 7, j = u >> 3;
                for (int kk = 0; kk < 2; ++kk) {
                    const int qb = kk == 0 ? 63 - j : j;
                    attn_unit<96, 64, 0>(lds, QMLA + hh * 96, 768, KMLA + hh * 96, 768, VMLA + hh * 64, 512, OMLA + hh * 64, 512, 256 * qb, 0, 4 * (qb + 1), nullptr, 0.f, tidv);
                }
            }
            bf16_t* QS = (bf16_t*)(ws + WS_QS); bf16_t* KS = (bf16_t*)(ws + WS_KS); bf16_t* VS = (bf16_t*)(ws + WS_VS);
            const float* BIAS = (const float*)(ws + WS_BIAS); const float* SK = (const float*)(ws + WS_SINK);
            for (int u = bid; u < 512; u += G) {
                const int hh = u >> 6, qb = u & 63, g = hh >> 2;
                const int tb = 4 * qb - 2 < 0 ? 0 : 4 * qb - 2;
                attn_unit<64, 64, 1>(lds, QS + hh * 64, 512, KS + g * 64, 128, VS + g * 64, 128, QS + hh * 64, 512, 256 * qb, tb, 4 * qb + 4, BIAS + hh * 128, SK[l * 8 + hh], tidv);
            }
            bf16_t* QM = (bf16_t*)(ws + WS_QM); bf16_t* KMEM = (bf16_t*)(ws + WS_KMEM); bf16_t* VMEM = (bf16_t*)(ws + WS_VMEM);
            for (int u = bid; u < 256; u += G) {
                const int hh = u >> 6, qb = u & 63;
                attn_unit<128, 128, 2>(lds, QM + hh * 128, 512, KMEM + hh * 128, 512, VMEM + hh * 128, 512, QM + hh * 128, 512, 256 * qb, 0, 4, nullptr, 0.f, tidv);
            }
        } else {
            const bf16_t* WL = (const bf16_t*)(ws + WS_W + (size_t)l * W_LAYER_BYTES);
            const bf16_t* XB = (const bf16_t*)(ws + WS_XB);
            pg8::Gemm g{}; Epi E{}; int cid = bid;
            E.ws = ws; E.layer = l;
            switch (k) {
            case 0: g = pg8::Gemm{XB, WL + W_IN, S, 1792, 1024}; E.mode = M_WIN; do_sync = false; break;
            case 1: g = pg8::Gemm{(const bf16_t*)(ws + WS_MEMB), WL + W_MEM, MEML, 1024, 1024}; E.mode = M_MEM; cid = G - 1 - bid; break;
            case 2: g = pg8::Gemm{(const bf16_t*)(ws + WS_CQ), WL + W_UQ, S, 768, 256}; E.mode = M_UQ; do_sync = false; break;
            case 3: g = pg8::Gemm{(const bf16_t*)(ws + WS_CKV), WL + W_UKV, S, 1024, 128}; E.mode = M_UKV; cid = G - 1 - bid; break;
            case 5: case 7: case 9: { const int br = (k - 5) >> 1; g = pg8::Gemm{XB, WL + W_G + (size_t)br * 1024 * 1024, S, 1024, 1024}; E.mode = M_GATE; E.br = br; do_sync = false; } break;
            case 6: case 8: case 10: { const int br = (k - 6) >> 1; const bf16_t* Ab = (const bf16_t*)(ws + (br == 0 ? WS_OMLA : (br == 1 ? WS_QS : WS_QM)));
                    g = pg8::Gemm{Ab, WL + W_O + (size_t)br * 1024 * 512, S, 1024, 512}; E.mode = M_Z; E.br = br; do_sync = (k == 10); } break;
            case 11: g = pg8::Gemm{(const bf16_t*)(ws + WS_YB), WL + W_OUT, S, 1024, 1024}; E.mode = M_RES; E.br = 0; break;
            case 12: g = pg8::Gemm{XB, WL + W_UP, S, 4096, 1024}; E.mode = M_UP; break;
            default: g = pg8::Gemm{(const bf16_t*)(ws + WS_H), WL + W_DOWN, S, 1024, 4096}; E.mode = M_RES; E.br = 1; break;
            }
            pg8::StaticOrder SO; SO.init(g.M, g.N, G, cid);
            pg8::gemm_phase<Epi, pg8::StaticOrder, true, true>(lds, g, SO, E);
        }
        if (do_sync) xcd_barrier(xbar);
    }
    {
        const int gw = bid * 8 + wave, ngw = G * 8;
        float* X = *(float* const*)(ws + WS_PTAB + 8);
        const float* rsf = (const float*)(ws + WS_RS) + (size_t)(4 * NL) * S;
        const f32x4* gn = (const f32x4*)(ws + WS_FN) + lane;
        for (int m = gw; m < S; m += ngw) {
            f32x4* xr = (f32x4*)(X + (size_t)m * D) + lane;
            const float rstd = 1.0f / sqrtf(rsf[m] * (1.0f / D) + EPS);
#pragma unroll
            for (int j = 0; j < 4; ++j) { f32x4 v = xr[64 * j]; v = v * rstd * gn[64 * j]; xr[64 * j] = v; }
        }
    }
}

extern "C" void kernel_launch(void* const* d_in, const int* in_sizes, int n_in, void* d_out, int out_size, void* d_ws, size_t ws_size, hipStream_t stream) {
    static int grid = 0;
    if (grid == 0) {
        int dev = 0, cus = 0, per_cu = 0;
        (void)hipGetDevice(&dev);
        (void)hipDeviceGetAttribute(&cus, hipDeviceAttributeMultiprocessorCount, dev);
        (void)hipFuncSetAttribute((const void*)fwd_mega, hipFuncAttributeMaxDynamicSharedMemorySize, LDS_BYTES);
        (void)hipOccupancyMaxActiveBlocksPerMultiprocessor(&per_cu, (const void*)fwd_mega, 512, LDS_BYTES);
        if (per_cu < 1) per_cu = 1;
        grid = cus * per_cu;
        if (grid <= 0) grid = 256;
    }
    Args a{};
    for (int i = 0; i < 21; ++i) a.in[i] = (const float*)d_in[i];
    a.out = (float*)d_out; a.ws = (unsigned char*)d_ws;
    void* args[] = {&a};
    hipError_t e = hipLaunchCooperativeKernel((void*)fwd_mega, dim3(grid), dim3(512), args, LDS_BYTES, stream);
    if (e != hipSuccess) fprintf(stderr, "cooperative launch failed: %s (grid %d)\n", hipGetErrorString(e), grid);
}
```

```cpp
#include <hip/hip_runtime.h>
#include <hip/hip_cooperative_groups.h>
#include <cstdio>
#include <cstdint>
namespace cg = cooperative_groups;
namespace pg8 {
#define PG8_LAS __attribute__((address_space(3)))
typedef unsigned short bf16_t;
typedef short bf16x8 __attribute__((ext_vector_type(8)));
typedef float f32x4 __attribute__((ext_vector_type(4)));
typedef unsigned u32x4 __attribute__((ext_vector_type(4)));
constexpr int BM = 256, BK = 64, HALF = 128, HTB = HALF * BK * 2  , STAGE_BYTES = 8 * HTB, NXCD = 8, WGM = 8;

__host__ __device__ __forceinline__ int lds_byte(int r, int c) { const int st = (r >> 4) * 2 + (c >> 5), rr = r & 15, cc = c & 31, ob = rr * 64 + cc * 2; return st * 1024 + (ob ^ (((ob >> 9) & 1) << 5)); }
__host__ __device__ __forceinline__ void stage_rc(int b, int& R, int& C) { const int st = b / 1024, sb = b % 1024, swz = sb ^ (((sb >> 9) & 1) << 5); R = (st >> 1) * 16 + swz / 64; C = (st & 1) * 32 + (swz % 64) / 2; }
__host__ __device__ __forceinline__ int perm32(int rho) { const int n = rho >> 4, i = rho & 15; return 8 * (i >> 2) + 4 * n + (i & 3); }

struct Unit { int pm, pn; };
struct Gemm { const bf16_t* A; const bf16_t* Bt; int M, N, K; };

struct StaticOrder {
    int nM, nN, nwg, G, c;
    __host__ __device__ void init(int M, int N, int G_, int c_) { nM = M / BM; nN = N / BM; nwg = nM * nN; G = G_; c = c_; }
    __host__ __device__ bool next(int i, Unit& u) const {
        const long L = (long)i * G + c; if (L >= nwg) return false;
        int wgid = (int)L; { const int q = nwg / NXCD, r = nwg % NXCD, xcd = wgid % NXCD, off = wgid / NXCD; wgid = (xcd < r ? xcd * (q + 1) : r * (q + 1) + (xcd - r) * q) + off; }
        const int nig = WGM * nN, gid = wgid / nig, fm = gid * WGM, gsz = (nM - fm) < WGM ? (nM - fm) : WGM;
        u.pm = fm + ((wgid % nig) % gsz); u.pn = (wgid % nig) / gsz; return true;
    }
    __device__ __forceinline__ void a_ready(const Unit&) const {}
    __device__ __forceinline__ void done(const Unit&) const {}
};

__device__ __forceinline__ unsigned cvt_pk_bf16(float lo, float hi) { unsigned r; asm volatile("v_cvt_pk_bf16_f32 %0, %1, %2" : "=v"(r) : "v"(lo), "v"(hi)); return r; }
typedef float f32x2 __attribute__((ext_vector_type(2)));
template <class Epi, class Sched, bool ALIGN_EPI = false, bool SP2 = false>
__device__ __forceinline__ void gemm_phase(PG8_LAS unsigned char* lds, const Gemm g, const Sched& S, const Epi& E) {
    int tid_o = threadIdx.x; asm volatile("" : "+v"(tid_o));
    const int tid = tid_o, wid = __builtin_amdgcn_readfirstlane(tid >> 6), lane = tid & 63, wr = wid >> 2, wc = wid & 3, fr = lane & 15, fq = lane >> 4;
    const int K = g.K, nt = K / BK;
    unsigned voffA[2], voffB[2];
#pragma unroll
    for (int i = 0; i < 2; ++i) { int R, C; stage_rc(tid * 16 + i * 8192, R, C); const int Rb = Epi::PERM ? ((R & ~31) + perm32(R & 31)) : R;
        voffA[i] = (unsigned)(R * K + C) * 2u; voffB[i] = (unsigned)(Rb * K + C) * 2u; }
    const size_t kstep = (size_t)(BK * 2);
    const size_t hstep = (size_t)HALF * K * 2;
    const size_t tstep = 2 * hstep;
    const unsigned ldsw = (unsigned)wid * 1024u;
    const int aoff = lds_byte(wr * 64 + fr, fq * 8), boff = lds_byte(wc * 32 + fr, fq * 8);
#define PG8_SA(b, h) (((b) * 2 + (h)) * HTB)
#define PG8_SB(b, h) ((4 + (b) * 2 + (h)) * HTB)
#define PG8_STAGE(bufoff, gbase, voff) do { _Pragma("unroll") for (int _i = 0; _i < 2; ++_i) \
        __builtin_amdgcn_global_load_lds((const unsigned*)((const char*)(gbase) + (voff)[_i]), (PG8_LAS unsigned*)(lds + (bufoff) + ldsw + _i * 8192), 16, 0, 0); } while (0)
#define PG8_LDA(dst, b, h) do { _Pragma("unroll") for (int m = 0; m < 4; ++m) _Pragma("unroll") for (int k = 0; k < 2; ++k) dst[m][k] = *(const PG8_LAS bf16x8*)(lds + PG8_SA(b, h) + aoff + m * 2048 + k * 1024); } while (0)
#define PG8_LDB(dst, b, h) do { _Pragma("unroll") for (int n = 0; n < 2; ++n) _Pragma("unroll") for (int k = 0; k < 2; ++k) dst[n][k] = *(const PG8_LAS bf16x8*)(lds + PG8_SB(b, h) + boff + n * 2048 + k * 1024); } while (0)
#define PG8_MMA(ai, bj, At, Bt) do { __builtin_amdgcn_s_setprio(1); _Pragma("unroll") for (int m = 0; m < 4; ++m) _Pragma("unroll") for (int n = 0; n < 2; ++n) _Pragma("unroll") for (int k = 0; k < 2; ++k) \
        acc[ai][bj][m][n] = __builtin_amdgcn_mfma_f32_16x16x32_bf16(Bt[n][k], At[m][k], acc[ai][bj][m][n], 0, 0, 0); __builtin_amdgcn_s_setprio(0); } while (0)
#define PG8_WAIT_V(n) asm volatile("s_waitcnt vmcnt(" #n ")" ::: "memory")
#define PG8_WAIT_L(n) asm volatile("s_waitcnt lgkmcnt(" #n ")" ::: "memory")
#define PG8_BAR __builtin_amdgcn_s_barrier()
#define PG8_SCHED __builtin_amdgcn_sched_barrier(0)
    Unit cur, nxt; int ui = 0;
    if (!S.next(0, cur)) return;
    f32x4 acc[2][2][4][2];
#pragma unroll
    for (int a = 0; a < 2; ++a)
#pragma unroll
        for (int b = 0; b < 2; ++b)
#pragma unroll
            for (int m = 0; m < 4; ++m)
#pragma unroll
                for (int n = 0; n < 2; ++n) acc[a][b][m][n] = (f32x4){0.f, 0.f, 0.f, 0.f};
    bf16x8 At[4][2], B0[2][2], B1[2][2];
    const char* cA = (const char*)g.A + (size_t)cur.pm * tstep; const char* cB = (const char*)g.Bt + (size_t)cur.pn * tstep;
    S.a_ready(cur);
    if constexpr (SP2) {
        PG8_STAGE(PG8_SB(0, 0), cB, voffB); PG8_STAGE(PG8_SB(0, 1), cB + hstep, voffB); PG8_STAGE(PG8_SA(0, 0), cA, voffA); PG8_STAGE(PG8_SA(0, 1), cA + hstep, voffA);
        if (wr == 1) PG8_BAR;
        PG8_WAIT_V(2); PG8_BAR;
        PG8_STAGE(PG8_SB(1, 0), cB + kstep, voffB); PG8_STAGE(PG8_SA(1, 0), cA + kstep, voffA); PG8_STAGE(PG8_SB(1, 1), cB + hstep + kstep, voffB);
        PG8_WAIT_V(6); PG8_BAR;
    } else {
        PG8_STAGE(PG8_SB(0, 0), cB, voffB); PG8_STAGE(PG8_SA(0, 0), cA, voffA); PG8_STAGE(PG8_SB(0, 1), cB + hstep, voffB); PG8_STAGE(PG8_SA(0, 1), cA + hstep, voffA);
        if (wr == 1) PG8_BAR;
        PG8_WAIT_V(4); PG8_BAR;
        PG8_STAGE(PG8_SB(1, 0), cB + kstep, voffB); PG8_STAGE(PG8_SA(1, 0), cA + kstep, voffA); PG8_STAGE(PG8_SB(1, 1), cB + hstep + kstep, voffB);
        PG8_WAIT_V(6); PG8_BAR;
    }
    for (;;) {
        const bool has_next = S.next(ui + 1, nxt);
        const char* nA = has_next ? (const char*)g.A + (size_t)nxt.pm * tstep : cA; const char* nB = has_next ? (const char*)g.Bt + (size_t)nxt.pn * tstep : cB;
        for (int t = 0; t < nt; t += 2) {
            const bool last = (t == nt - 2);
            const char* a1 = cA + (size_t)(t + 1) * kstep;
            const char* a2 = last ? nA : cA + (size_t)(t + 2) * kstep; const char* b2 = last ? nB : cB + (size_t)(t + 2) * kstep;
            const char* a3 = a2 + kstep; const char* b3 = b2 + kstep;
            if (last && has_next) S.a_ready(nxt);
            if constexpr (SP2) {
            PG8_LDB(B0, 0, 0); PG8_LDB(B1, 0, 1); PG8_SCHED; PG8_LDA(At, 0, 0); PG8_STAGE(PG8_SA(1, 1), a1 + hstep, voffA);
            PG8_WAIT_V(8); PG8_WAIT_L(0); PG8_BAR; PG8_MMA(0, 0, At, B0); PG8_MMA(0, 1, At, B1); PG8_BAR; PG8_SCHED;
            PG8_LDA(At, 0, 1); PG8_STAGE(PG8_SB(0, 0), b2, voffB); PG8_STAGE(PG8_SB(0, 1), b2 + hstep, voffB); PG8_STAGE(PG8_SA(0, 0), a2, voffA);
            PG8_WAIT_V(8); PG8_WAIT_L(0); PG8_BAR; PG8_MMA(1, 0, At, B0); PG8_MMA(1, 1, At, B1); PG8_BAR; PG8_SCHED;
            PG8_LDB(B0, 1, 0); PG8_LDB(B1, 1, 1); PG8_SCHED; PG8_LDA(At, 1, 0); PG8_STAGE(PG8_SA(0, 1), a2 + hstep, voffA);
            PG8_WAIT_V(8); PG8_WAIT_L(0); PG8_BAR; PG8_MMA(0, 0, At, B0); PG8_MMA(0, 1, At, B1); PG8_BAR; PG8_SCHED;
            PG8_LDA(At, 1, 1); PG8_STAGE(PG8_SB(1, 0), b3, voffB); PG8_STAGE(PG8_SB(1, 1), b3 + hstep, voffB); PG8_STAGE(PG8_SA(1, 0), a3, voffA);
            PG8_WAIT_V(8); PG8_WAIT_L(0); PG8_BAR; PG8_MMA(1, 0, At, B0); PG8_MMA(1, 1, At, B1); PG8_BAR; PG8_SCHED;
            } else {
            PG8_LDB(B0, 0, 0); PG8_SCHED; PG8_LDA(At, 0, 0); PG8_STAGE(PG8_SA(1, 1), a1 + hstep, voffA);
            PG8_WAIT_L(8); PG8_BAR; PG8_WAIT_L(0); PG8_MMA(0, 0, At, B0); PG8_BAR; PG8_SCHED;
            PG8_LDB(B1, 0, 1); PG8_STAGE(PG8_SB(0, 0), b2, voffB);
            PG8_BAR; PG8_WAIT_L(0); PG8_MMA(0, 1, At, B1); PG8_BAR;
            PG8_LDA(At, 0, 1); PG8_STAGE(PG8_SA(0, 0), a2, voffA);
            PG8_BAR; PG8_WAIT_L(0); PG8_MMA(1, 0, At, B0); PG8_BAR; PG8_SCHED;
            PG8_STAGE(PG8_SB(0, 1), b2 + hstep, voffB);
            PG8_WAIT_V(6); PG8_BAR; PG8_MMA(1, 1, At, B1); PG8_BAR;
            PG8_LDB(B0, 1, 0); PG8_SCHED; PG8_LDA(At, 1, 0); PG8_STAGE(PG8_SA(0, 1), a2 + hstep, voffA);
            PG8_WAIT_L(8); PG8_BAR; PG8_WAIT_L(0); PG8_MMA(0, 0, At, B0); PG8_BAR; PG8_SCHED;
            PG8_LDB(B1, 1, 1); PG8_STAGE(PG8_SB(1, 0), b3, voffB);
            PG8_BAR; PG8_WAIT_L(0); PG8_MMA(0, 1, At, B1); PG8_BAR;
            PG8_LDA(At, 1, 1); PG8_STAGE(PG8_SA(1, 0), a3, voffA);
            PG8_BAR; PG8_WAIT_L(0); PG8_MMA(1, 0, At, B0); PG8_BAR; PG8_SCHED;
            PG8_STAGE(PG8_SB(1, 1), b3 + hstep, voffB);
            PG8_WAIT_V(6); PG8_BAR; PG8_MMA(1, 1, At, B1); PG8_BAR;
            }
        }
        if constexpr (ALIGN_EPI) { if (wr == 0) PG8_BAR; }
        if constexpr (!Epi::AFTER_DRAIN) { E(acc, cur, wr, wc, fr, fq); S.done(cur); }
        if (!has_next) break;
#pragma unroll
        for (int a = 0; a < 2; ++a)
#pragma unroll
            for (int b = 0; b < 2; ++b)
#pragma unroll
                for (int m = 0; m < 4; ++m)
#pragma unroll
                    for (int n = 0; n < 2; ++n) acc[a][b][m][n] = (f32x4){0.f, 0.f, 0.f, 0.f};
        cur = nxt; cA = nA; cB = nB; ++ui;
        if constexpr (ALIGN_EPI) { if (wr == 1) PG8_BAR; }
    }
    PG8_WAIT_V(0);
    if constexpr (!ALIGN_EPI) { if (wr == 0) PG8_BAR; }
    PG8_BAR;
    if constexpr (Epi::AFTER_DRAIN) { E.fused(acc, cur, wr, wc, fr, fq, lds, wid, lane); S.done(cur); }
#undef PG8_SA
#undef PG8_SB
#undef PG8_STAGE
#undef PG8_LDA
#undef PG8_LDB
#undef PG8_MMA
#undef PG8_WAIT_V
#undef PG8_WAIT_L
#undef PG8_BAR
#undef PG8_SCHED
}
}

typedef unsigned short bf16_t;
typedef short bf16x8 __attribute__((ext_vector_type(8)));
typedef float f32x4 __attribute__((ext_vector_type(4)));
typedef float f32x2 __attribute__((ext_vector_type(2)));
typedef float f32x16 __attribute__((ext_vector_type(16)));
typedef unsigned u32x4 __attribute__((ext_vector_type(4)));
typedef unsigned u32x2 __attribute__((ext_vector_type(2)));
typedef __bf16 bf16x2_t __attribute__((ext_vector_type(2)));
#define LAS __attribute__((address_space(3)))

constexpr int S = 16384, D = 1024, DFF = 4096, NL = 2, MEML = 256;
constexpr int INCOLS = 4768;
constexpr float EPS = 1e-6f;
constexpr float LOG2E = 1.4426950408889634f;
constexpr float QS_SCALE = 0.125f * LOG2E;
constexpr float QM_SCALE = 0.08838834764831845f * LOG2E;
constexpr float QMLA_SCALE = 0.10206207261596575f * LOG2E;

constexpr size_t W_IN = 0;
constexpr size_t W_G = W_IN + (size_t)1792 * 1024;
constexpr size_t W_UQ = W_G + (size_t)3072 * 1024;
constexpr size_t W_UKV = W_UQ + (size_t)768 * 256;
constexpr size_t W_MEM = W_UKV + (size_t)1024 * 128;
constexpr size_t W_O = W_MEM + (size_t)1024 * 1024;
constexpr size_t W_OUT = W_O + (size_t)3 * 1024 * 512;
constexpr size_t W_UP = W_OUT + (size_t)1024 * 1024;
constexpr size_t W_DOWN = W_UP + (size_t)4096 * 1024;
constexpr size_t W_LAYER_ELEMS = W_DOWN + (size_t)1024 * 4096;
constexpr size_t MiB = 1u << 20;
constexpr size_t W_LAYER_BYTES = 34 * MiB;
static_assert(W_LAYER_ELEMS * 2 <= W_LAYER_BYTES, "weights");
constexpr size_t WS_W = 0;
constexpr size_t WS_XB = 68 * MiB;
constexpr size_t WS_SMALL = 100 * MiB;
constexpr size_t WS_RS = WS_SMALL;
constexpr size_t WS_RSTDM = WS_RS + 9 * (size_t)S * 4;
constexpr size_t WS_BIAS = WS_RSTDM + 1024;
constexpr size_t WS_ROPE = WS_BIAS + 4096;
constexpr size_t WS_MEMB = WS_ROPE + (size_t)S * 16 * 8;
constexpr size_t WS_KMEM = WS_MEMB + (size_t)256 * 1024 * 2;
constexpr size_t WS_VMEM = WS_KMEM + (size_t)256 * 512 * 2;
constexpr size_t WS_PTAB = WS_VMEM + (size_t)256 * 512 * 2;
constexpr size_t WS_BG = WS_PTAB + 64;
constexpr size_t WS_SINK = WS_BG + 2 * 3072 * 4;
constexpr size_t WS_FN = WS_SINK + 64;
constexpr size_t WS_BAR = WS_FN + 4096;
static_assert(WS_BAR + 16384 <= 104 * MiB, "small region");
constexpr size_t WS_H = 104 * MiB;
constexpr size_t WS_QMLA = 104 * MiB;
constexpr size_t WS_KMLA = 128 * MiB;
constexpr size_t WS_VMLA = 152 * MiB;
constexpr size_t WS_QS = 168 * MiB;
constexpr size_t WS_KS = 184 * MiB;
constexpr size_t WS_VS = 188 * MiB;
constexpr size_t WS_QM = 192 * MiB;
constexpr size_t WS_CQ = 208 * MiB;
constexpr size_t WS_CKV = 216 * MiB;
constexpr size_t WS_OMLA = 220 * MiB;
constexpr size_t WS_T = 104 * MiB;
constexpr size_t WS_YB = 136 * MiB;
static_assert(WS_OMLA + (size_t)S * 512 * 2 <= 256 * MiB, "ws");

struct Args {
    const float* in[21];
    float* out; unsigned char* ws;
};
enum { I_X = 0, I_MEM, I_RELB, I_ATTN_NORM, I_MEM_NORM, I_W_IN, I_B_GATE, I_QNORM, I_W_UQ, I_KVNORM, I_W_UKV, I_SINKS, I_W_MEMKV, I_WO_MLA, I_WO_SWA, I_WO_MEM, I_W_OUT, I_MLP_NORM, I_W_UP, I_W_DOWN, I_FNORM };

__device__ __forceinline__ unsigned cvtpk(float lo, float hi) { f32x2 v = {lo, hi}; bf16x2_t b = __builtin_convertvector(v, bf16x2_t); return __builtin_bit_cast(unsigned, b); }
__device__ __forceinline__ float bf_lo(unsigned u) { return __uint_as_float(u << 16); }
__device__ __forceinline__ float bf_hi(unsigned u) { return __uint_as_float(u & 0xffff0000u); }
__device__ __forceinline__ float wave_sum(float v) {
#pragma unroll
    for (int o = 1; o < 64; o <<= 1) v += __shfl_xor(v, o);
    return v;
}

enum { M_WIN = 0, M_MEM, M_UQ, M_UKV, M_GATE, M_Z, M_RES, M_UP };
struct Epi {
    static constexpr bool PERM = true, AFTER_DRAIN = false;
    int mode, br, layer; unsigned char* ws;
    __device__ __forceinline__ void store8(bf16_t* dst, const f32x4& a, const f32x4& b) const {
        u32x4 w; w.x = cvtpk(a[0], a[1]); w.y = cvtpk(a[2], a[3]); w.z = cvtpk(b[0], b[1]); w.w = cvtpk(b[2], b[3]);
        *(u32x4*)dst = w;
    }
    __device__ __forceinline__ float sq8(const f32x4& a0, const f32x4& a1) const { return (a0[0]*a0[0] + a0[1]*a0[1]) + (a0[2]*a0[2] + a0[3]*a0[3]) + (a1[0]*a1[0] + a1[1]*a1[1]) + (a1[2]*a1[2] + a1[3]*a1[3]); }
    __device__ __forceinline__ void operator()(const f32x4 (&acc)[2][2][4][2], const pg8::Unit& u, int wr, int wc, int fr_in, int fq_in) const {
        int fr = fr_in, fq = fq_in; asm volatile("" : "+v"(fr), "+v"(fq));
        const int pn = u.pn;
        float* RS = (float*)(ws + WS_RS);
        const float* rs_in = RS + (size_t)(4 * layer) * S; float inv_k = 1.0f / 1024.0f;
        if (mode == M_MEM) rs_in = (const float*)(ws + WS_RSTDM);
        if (mode == M_UQ) { rs_in = RS + (size_t)(4 * layer + 1) * S; inv_k = 1.0f / 256.0f; }
        if (mode == M_UKV) { rs_in = RS + (size_t)(4 * layer + 2) * S; inv_k = 1.0f / 128.0f; }
        if (mode == M_UP) rs_in = RS + (size_t)(4 * layer + 3) * S;
        float* rs_out = RS + (size_t)(4 * layer + 1) * S;
        if (mode == M_WIN && pn == 1) rs_out = RS + (size_t)(4 * layer + 2) * S;
        if (mode == M_RES) rs_out = RS + (size_t)(4 * layer + 3 + br) * S;
        const float* resid = nullptr; float* X = nullptr;
        if (mode == M_RES) { X = *(float* const*)(ws + WS_PTAB + 8); resid = (layer == 0 && br == 0) ? *(const float* const*)(ws + WS_PTAB) : X; }
#pragma unroll
        for (int ai = 0; ai < 2; ++ai)
#pragma unroll
            for (int m = 0; m < 4; ++m) {
                const int row = u.pm * 256 + ai * 128 + wr * 64 + m * 16 + fr;
                float sc = 1.f;
                if (mode == M_MEM) sc = rs_in[row];
                else if (mode != M_Z && mode != M_RES) sc = __builtin_amdgcn_rsqf(rs_in[row] * inv_k + EPS);
                if (mode == M_UQ) sc *= QMLA_SCALE;
                float ss = 0.f;
#pragma unroll
                for (int bj = 0; bj < 2; ++bj) {
                    const int ct = bj * 128 + wc * 32 + 8 * fq;
                    f32x4 a0 = acc[ai][bj][m][0] * sc, a1 = acc[ai][bj][m][1] * sc;
                    switch (mode) {
                    case M_WIN: {
                        if (pn == 0) { store8((bf16_t*)(ws + WS_CQ) + (size_t)row * 256 + ct, a0, a1); ss += sq8(a0, a1); }
                        else if (pn == 1) {
                            if (bj == 0) { store8((bf16_t*)(ws + WS_CKV) + (size_t)row * 128 + ct, a0, a1); ss += sq8(a0, a1); }
                            else if (wc == 0) {
                                const f32x2* cs = (const f32x2*)(ws + WS_ROPE) + (size_t)row * 16 + 4 * fq;
                                f32x4 o1, o2;
#pragma unroll
                                for (int e = 0; e < 4; ++e) { const f32x2 c = cs[e]; o1[e] = a0[e] * c.x - a1[e] * c.y; o2[e] = a1[e] * c.x + a0[e] * c.y; }
                                u32x2 w1, w2; w1.x = cvtpk(o1[0], o1[1]); w1.y = cvtpk(o1[2], o1[3]); w2.x = cvtpk(o2[0], o2[1]); w2.y = cvtpk(o2[2], o2[3]);
                                bf16_t* kr = (bf16_t*)(ws + WS_KMLA) + (size_t)row * 768 + 64 + 4 * fq;
#pragma unroll
                                for (int hh = 0; hh < 8; ++hh) { *(u32x2*)(kr + hh * 96) = w1; *(u32x2*)(kr + hh * 96 + 16) = w2; }
                            }
                        }
                        else if (pn < 4) { store8((bf16_t*)(ws + WS_QS) + (size_t)row * 512 + (pn - 2) * 256 + ct, a0 * QS_SCALE, a1 * QS_SCALE); }
                        else if (pn == 4) { if (bj == 0) store8((bf16_t*)(ws + WS_KS) + (size_t)row * 128 + ct, a0, a1); else store8((bf16_t*)(ws + WS_VS) + (size_t)row * 128 + ct - 128, a0, a1); }
                        else { store8((bf16_t*)(ws + WS_QM) + (size_t)row * 512 + (pn - 5) * 256 + ct, a0 * QM_SCALE, a1 * QM_SCALE); }
                    } break;
                    case M_MEM: {
                        if (pn < 2) store8((bf16_t*)(ws + WS_KMEM) + (size_t)row * 512 + pn * 256 + ct, a0, a1);
                        else store8((bf16_t*)(ws + WS_VMEM) + (size_t)row * 512 + (pn - 2) * 256 + ct, a0, a1);
                    } break;
                    case M_UQ: {
                        if (pn < 2) { const int c = pn * 256 + ct; store8((bf16_t*)(ws + WS_QMLA) + (size_t)row * 768 + (c >> 6) * 96 + (c & 63), a0, a1); }
                        else {
                            const int head = 4 * bj + wc;
                            const f32x2* cs = (const f32x2*)(ws + WS_ROPE) + (size_t)row * 16 + 4 * fq;
                            f32x4 o1, o2;
#pragma unroll
                            for (int e = 0; e < 4; ++e) { const f32x2 c = cs[e]; o1[e] = a0[e] * c.x - a1[e] * c.y; o2[e] = a1[e] * c.x + a0[e] * c.y; }
                            u32x2 w1, w2; w1.x = cvtpk(o1[0], o1[1]); w1.y = cvtpk(o1[2], o1[3]); w2.x = cvtpk(o2[0], o2[1]); w2.y = cvtpk(o2[2], o2[3]);
                            bf16_t* qrp = (bf16_t*)(ws + WS_QMLA) + (size_t)row * 768 + head * 96 + 64 + 4 * fq;
                            *(u32x2*)qrp = w1; *(u32x2*)(qrp + 16) = w2;
                        }
                    } break;
                    case M_UKV: {
                        if (pn < 2) { const int c = pn * 256 + ct; store8((bf16_t*)(ws + WS_KMLA) + (size_t)row * 768 + (c >> 6) * 96 + (c & 63), a0, a1); }
                        else store8((bf16_t*)(ws + WS_VMLA) + (size_t)row * 512 + (pn - 2) * 256 + ct, a0, a1);
                    } break;
                    case M_GATE: {
                        const int c = pn * 256 + ct;
                        const float* bg = (const float*)(ws + WS_BG) + layer * 3072 + br * 1024 + c;
                        const f32x4 b0 = *(const f32x4*)bg, b1 = *(const f32x4*)(bg + 4);
                        f32x4 g0, g1;
#pragma unroll
                        for (int e = 0; e < 4; ++e) { g0[e] = __builtin_amdgcn_rcpf(1.f + __builtin_amdgcn_exp2f(-(a0[e] + b0[e]) * LOG2E)); g1[e] = __builtin_amdgcn_rcpf(1.f + __builtin_amdgcn_exp2f(-(a1[e] + b1[e]) * LOG2E)); }
                        store8((bf16_t*)(ws + WS_T) + (size_t)row * 1024 + c, g0, g1);
                    } break;
                    case M_Z: {
                        const int c = pn * 256 + ct;
                        const u32x4 t = *(const u32x4*)((bf16_t*)(ws + WS_T) + (size_t)row * 1024 + c);
                        bf16_t* yp = (bf16_t*)(ws + WS_YB) + (size_t)row * 1024 + c;
                        f32x4 y0 = {0.f, 0.f, 0.f, 0.f}, y1 = {0.f, 0.f, 0.f, 0.f};
                        if (br > 0) { const u32x4 yo = *(const u32x4*)yp;
                            y0 = (f32x4){bf_lo(yo.x), bf_hi(yo.x), bf_lo(yo.y), bf_hi(yo.y)}; y1 = (f32x4){bf_lo(yo.z), bf_hi(yo.z), bf_lo(yo.w), bf_hi(yo.w)}; }
                        y0 += a0 * (f32x4){bf_lo(t.x), bf_hi(t.x), bf_lo(t.y), bf_hi(t.y)};
                        y1 += a1 * (f32x4){bf_lo(t.z), bf_hi(t.z), bf_lo(t.w), bf_hi(t.w)};
                        store8(yp, y0, y1);
                    } break;
                    case M_RES: {
                        const int c = pn * 256 + ct;
                        const f32x4 x0 = *(const f32x4*)(resid + (size_t)row * 1024 + c) + a0, x1 = *(const f32x4*)(resid + (size_t)row * 1024 + c + 4) + a1;
                        *(f32x4*)(X + (size_t)row * 1024 + c) = x0; *(f32x4*)(X + (size_t)row * 1024 + c + 4) = x1;
                        store8((bf16_t*)(ws + WS_XB) + (size_t)row * 1024 + c, x0, x1);
                        ss += sq8(x0, x1);
                    } break;
                    default: {
                        f32x4 r0, r1;
#pragma unroll
                        for (int e = 0; e < 4; ++e) { const float v0 = fmaxf(a0[e], 0.f), v1 = fmaxf(a1[e], 0.f); r0[e] = v0 * v0; r1[e] = v1 * v1; }
                        store8((bf16_t*)(ws + WS_H) + (size_t)row * 4096 + pn * 256 + ct, r0, r1);
                    } break;
                    }
                }
                if (mode == M_RES || (mode == M_WIN && pn < 2)) {
                    ss += __shfl_xor(ss, 16); ss += __shfl_xor(ss, 32);
                    if (fq == 0) atomicAdd(rs_out + row, ss);
                }
            }
    }
};

__device__ __forceinline__ int crow(int i, int h) { return (i & 3) + 8 * (i >> 2) + 4 * h; }
#define MFMA32(a, b, c) __builtin_amdgcn_mfma_f32_32x32x16_bf16((a), (b), (c), 0, 0, 0)

template <int DQK, int DV, int MODE>
__device__ __forceinline__ void attn_unit(LAS unsigned char* lds, const bf16_t* Q, int qpitch, const bf16_t* K, int kpitch, const bf16_t* V, int vpitch,
                                          bf16_t* O, int opitch, int q0, int t_begin, int t_end, const float* biasrow, float sink_l2, int tid) {
    constexpr int KSTR = (DQK + 8) * 2, VSTR = 144, KBUF = 64 * KSTR, VBUF = DV * VSTR;
    constexpr int NKC = DQK / 8, NKCH = 64 * NKC, KIT = (NKCH + 511) / 512, VIT = DV / 64, NC = DQK / 16, NDB = DV / 32;
    constexpr int OFF_K = 0, OFF_V = 2 * KBUF, OFF_BIAS = 2 * KBUF + 2 * VBUF;
    static_assert(OFF_BIAS + 512 <= 131072, "attention lds");
    const int lane = tid & 63, w = __builtin_amdgcn_readfirstlane(tid >> 6), r = lane & 31, h = lane >> 5;
    const int R0 = q0 + 32 * w;
    LAS float* biasl = (LAS float*)(lds + OFF_BIAS);
    if (MODE == 1) { if (tid < 128) biasl[tid] = biasrow[tid]; }
    bf16x8 qr[NC];
#pragma unroll
    for (int c = 0; c < NC; ++c) qr[c] = *(const bf16x8*)(Q + (size_t)(R0 + r) * qpitch + 16 * c + 8 * h);
    u32x4 kst[KIT], vst[VIT];
    const int vpos = (lane & ~15) | (((lane >> 2) & 1) << 3) | (((lane >> 3) & 1) << 2) | (lane & 3);
#define ATT_LOAD(t) do { \
        _Pragma("unroll") for (int i_ = 0; i_ < KIT; ++i_) { const int c_ = tid + 512 * i_; if (c_ < NKCH) { const int row_ = c_ / NKC, col_ = c_ % NKC; \
            kst[i_] = *(const u32x4*)(K + (size_t)(64 * (t) + row_) * kpitch + col_ * 8); } } \
        _Pragma("unroll") for (int i_ = 0; i_ < VIT; ++i_) vst[i_] = *(const u32x4*)(V + (size_t)(64 * (t) + lane) * vpitch + (w + 8 * i_) * 8); } while (0)
#define ATT_STORE(buf) do { \
        _Pragma("unroll") for (int i_ = 0; i_ < KIT; ++i_) { const int c_ = tid + 512 * i_; if (c_ < NKCH) { const int row_ = c_ / NKC, col_ = c_ % NKC; \
            *(LAS u32x4*)(lds + OFF_K + (buf) * KBUF + row_ * KSTR + col_ * 16) = kst[i_]; } } \
        _Pragma("unroll") for (int i_ = 0; i_ < VIT; ++i_) { LAS unsigned short* vd_ = (LAS unsigned short*)(lds + OFF_V + (buf) * VBUF + ((w + 8 * i_) * 8) * VSTR + vpos * 2); \
            const u32x4 v_ = vst[i_]; \
            vd_[0 * (VSTR / 2)] = (unsigned short)(v_.x & 0xffffu); vd_[1 * (VSTR / 2)] = (unsigned short)(v_.x >> 16); \
            vd_[2 * (VSTR / 2)] = (unsigned short)(v_.y & 0xffffu); vd_[3 * (VSTR / 2)] = (unsigned short)(v_.y >> 16); \
            vd_[4 * (VSTR / 2)] = (unsigned short)(v_.z & 0xffffu); vd_[5 * (VSTR / 2)] = (unsigned short)(v_.z >> 16); \
            vd_[6 * (VSTR / 2)] = (unsigned short)(v_.w & 0xffffu); vd_[7 * (VSTR / 2)] = (unsigned short)(v_.w >> 16); } } while (0)

    float mrun = (MODE == 1) ? sink_l2 : -INFINITY;
    float lrun = (MODE == 1 && h == 0) ? 1.f : 0.f;
    f32x16 o[NDB];
#pragma unroll
    for (int db = 0; db < NDB; ++db)
#pragma unroll
        for (int i = 0; i < 16; ++i) o[db][i] = 0.f;

    ATT_LOAD(t_begin);
    ATT_STORE(0);
    __syncthreads();
    for (int t = t_begin; t < t_end; ++t) {
        const int buf = (t - t_begin) & 1;
        const bool more = (t + 1 < t_end);
        if (more) ATT_LOAD(t + 1);
        bool skip = false;
        if (MODE == 0) skip = (64 * t > R0 + 31);
        if (MODE == 1) skip = (64 * t > R0 + 31) || (64 * t + 63 < R0 - 127);
        if (!skip) {
            f32x16 p0, p1;
#pragma unroll
            for (int i = 0; i < 16; ++i) { p0[i] = 0.f; p1[i] = 0.f; }
            const LAS unsigned char* kp = lds + OFF_K + buf * KBUF + r * KSTR + h * 16;
#pragma unroll
            for (int c = 0; c < NC; ++c) {
                const bf16x8 k0 = *(const LAS bf16x8*)(kp + c * 32);
                const bf16x8 k1 = *(const LAS bf16x8*)(kp + 32 * KSTR + c * 32);
                p0 = MFMA32(k0, qr[c], p0); p1 = MFMA32(k1, qr[c], p1);
            }
            const int qa = R0 + r;
            if (MODE == 0) {
                if (64 * t + 63 > R0) {
#pragma unroll
                    for (int i = 0; i < 16; ++i) { const int kv = 64 * t + crow(i, h); if (kv > qa) p0[i] = -INFINITY; if (kv + 32 > qa) p1[i] = -INFINITY; }
                }
            }
            if (MODE == 1) {
#pragma unroll
                for (int i = 0; i < 16; ++i) { const int d0 = qa - (64 * t + crow(i, h)), d1 = d0 - 32;
                    const float b0 = biasl[d0 & 127], b1 = biasl[d1 & 127];
                    p0[i] = (d0 >= 0 && d0 < 128) ? p0[i] + b0 : -INFINITY; p1[i] = (d1 >= 0 && d1 < 128) ? p1[i] + b1 : -INFINITY; }
            }
            float mx = fmaxf(p0[0], p1[0]);
#pragma unroll
            for (int i = 1; i < 16; ++i) mx = fmaxf(mx, fmaxf(p0[i], p1[i]));
            mx = fmaxf(mx, __shfl_xor(mx, 32));
            const float mnew = fmaxf(mrun, mx);
            const float alpha = __builtin_amdgcn_exp2f(mrun - mnew);
            mrun = mnew;
            float ls = 0.f;
#pragma unroll
            for (int i = 0; i < 16; ++i) { p0[i] = __builtin_amdgcn_exp2f(p0[i] - mnew); p1[i] = __builtin_amdgcn_exp2f(p1[i] - mnew); ls += p0[i] + p1[i]; }
            lrun = lrun * alpha + ls;
#pragma unroll
            for (int db = 0; db < NDB; ++db)
#pragma unroll
                for (int i = 0; i < 16; ++i) o[db][i] *= alpha;
            bf16x8 pa[4];
#pragma unroll
            for (int s = 0; s < 4; ++s) {
                u32x4 pk;
                if (s < 2) { pk.x = cvtpk(p0[8 * s + 0], p0[8 * s + 1]); pk.y = cvtpk(p0[8 * s + 2], p0[8 * s + 3]); pk.z = cvtpk(p0[8 * s + 4], p0[8 * s + 5]); pk.w = cvtpk(p0[8 * s + 6], p0[8 * s + 7]); }
                else { const int s2 = s - 2; pk.x = cvtpk(p1[8 * s2 + 0], p1[8 * s2 + 1]); pk.y = cvtpk(p1[8 * s2 + 2], p1[8 * s2 + 3]); pk.z = cvtpk(p1[8 * s2 + 4], p1[8 * s2 + 5]); pk.w = cvtpk(p1[8 * s2 + 6], p1[8 * s2 + 7]); }
                pa[s] = __builtin_bit_cast(bf16x8, pk);
            }
            const LAS unsigned char* vp = lds + OFF_V + buf * VBUF + r * VSTR + h * 16;
#pragma unroll
            for (int db = 0; db < NDB; ++db)
#pragma unroll
                for (int s = 0; s < 4; ++s) {
                    const bf16x8 vf = *(const LAS bf16x8*)(vp + db * 32 * VSTR + s * 32);
                    o[db] = MFMA32(vf, pa[s], o[db]);
                }
        }
        if (more) ATT_STORE(buf ^ 1);
        __syncthreads();
    }
    lrun += __shfl_xor(lrun, 32);
    const float inv = 1.f / lrun;
    bf16_t* orow = O + (size_t)(R0 + r) * opitch;
#pragma unroll
    for (int db = 0; db < NDB; ++db)
#pragma unroll
        for (int g = 0; g < 4; ++g) {
            u32x2 wv; wv.x = cvtpk(o[db][4 * g + 0] * inv, o[db][4 * g + 1] * inv); wv.y = cvtpk(o[db][4 * g + 2] * inv, o[db][4 * g + 3] * inv);
            *(u32x2*)(orow + 32 * db + 8 * g + 4 * h) = wv;
        }
#undef ATT_LOAD
#undef ATT_STORE
}

constexpr float ATT_THR = 8.0f;
__device__ __forceinline__ float max3f(float a, float b, float c) { return __builtin_fmaxf(__builtin_fmaxf(a, b), c); }
template <int DQK>
__device__ __forceinline__ void att_qk(f32x16& s0, f32x16& s1, const LAS unsigned char* kp, const bf16x8 (&qr)[DQK / 16], const f32x16& negm) {
    constexpr int NC = DQK / 16, KSTR = (DQK + 8) * 2;
#pragma unroll
    for (int c = 0; c < NC; ++c) {
        const bf16x8 k0 = *(const LAS bf16x8*)(kp + c * 32);
        const bf16x8 k1 = *(const LAS bf16x8*)(kp + 32 * KSTR + c * 32);
        if (c == 0) { s0 = MFMA32(k0, qr[0], negm); s1 = MFMA32(k1, qr[0], negm); }
        else { s0 = MFMA32(k0, qr[c], s0); s1 = MFMA32(k1, qr[c], s1); }
    }
}
template <int MODE>
__device__ __forceinline__ void att_pre(f32x16& s0, f32x16& s1, f32x16 (&o)[2], f32x16& negm, float& mhat, float& lrun, bool& first, int t, int R0, int qa, int h, const LAS float* biasl) {
    if (MODE == 0) {
        if (64 * t + 63 > R0) {
#pragma unroll
            for (int i = 0; i < 16; ++i) { const int kv = 64 * t + crow(i, h); if (kv > qa) s0[i] = -INFINITY; if (kv + 32 > qa) s1[i] = -INFINITY; }
        }
    }
    if (MODE == 1) {
#pragma unroll
        for (int i = 0; i < 16; ++i) { const int d0 = qa - (64 * t + crow(i, h)), d1 = d0 - 32;
            const float b0 = biasl[d0 & 127], b1 = biasl[d1 & 127];
            s0[i] = (d0 >= 0 && d0 < 128) ? s0[i] + b0 : -INFINITY; s1[i] = (d1 >= 0 && d1 < 128) ? s1[i] + b1 : -INFINITY; }
    }
    float a = max3f(s0[0], s0[1], s1[0]), b = max3f(s0[2], s0[3], s1[1]); a = max3f(a, s1[2], s1[3]);
#pragma unroll
    for (int i = 4; i < 16; i += 4) { a = max3f(a, s0[i], s0[i + 1]); b = max3f(b, s0[i + 2], s0[i + 3]); a = max3f(a, s1[i], s1[i + 1]); b = max3f(b, s1[i + 2], s1[i + 3]); }
    float rm = __builtin_fmaxf(a, b);
    { auto rr = __builtin_amdgcn_permlane32_swap(__float_as_uint(rm), __float_as_uint(rm), false, false); rm = __builtin_fmaxf(__uint_as_float(rr[0]), __uint_as_float(rr[1])); }
    if (first || __any(rm > ATT_THR)) {
        const float dl = first ? rm : __builtin_fmaxf(rm, 0.f);
        mhat += dl;
#pragma unroll
        for (int i = 0; i < 16; ++i) { s0[i] -= dl; s1[i] -= dl; }
#pragma unroll
        for (int i = 0; i < 16; ++i) negm[i] = -mhat;
        if (!first) { const float f = __builtin_amdgcn_exp2f(-dl); lrun *= f;
#pragma unroll
            for (int i = 0; i < 16; ++i) { o[0][i] *= f; o[1][i] *= f; } }
        first = false;
    }
}
__device__ __forceinline__ void att_post(f32x16& s0, f32x16& s1, float& lrun, bf16x8 (&pa)[4]) {
    float ls = 0.f;
#pragma unroll
    for (int i = 0; i < 16; ++i) { s0[i] = __builtin_amdgcn_exp2f(s0[i]); s1[i] = __builtin_amdgcn_exp2f(s1[i]); ls += s0[i] + s1[i]; }
    lrun += ls;
#pragma unroll
    for (int s = 0; s < 2; ++s) {
        u32x4 pk; pk.x = cvtpk(s0[8 * s + 0], s0[8 * s + 1]); pk.y = cvtpk(s0[8 * s + 2], s0[8 * s + 3]); pk.z = cvtpk(s0[8 * s + 4], s0[8 * s + 5]); pk.w = cvtpk(s0[8 * s + 6], s0[8 * s + 7]);
        pa[s] = __builtin_bit_cast(bf16x8, pk);
        u32x4 pq; pq.x = cvtpk(s1[8 * s + 0], s1[8 * s + 1]); pq.y = cvtpk(s1[8 * s + 2], s1[8 * s + 3]); pq.z = cvtpk(s1[8 * s + 4], s1[8 * s + 5]); pq.w = cvtpk(s1[8 * s + 6], s1[8 * s + 7]);
        pa[2 + s] = __builtin_bit_cast(bf16x8, pq);
    }
}
__device__ __forceinline__ void att_pv(f32x16 (&o)[2], const bf16x8 (&pa)[4], const LAS unsigned char* vp) {
#pragma unroll
    for (int db = 0; db < 2; ++db)
#pragma unroll
        for (int s = 0; s < 4; ++s) {
            const bf16x8 vf = *(const LAS bf16x8*)(vp + db * 32 * 144 + s * 32);
            o[db] = MFMA32(vf, pa[s], o[db]);
        }
}
template <int DQK, int C_LO, int C_HI>
__device__ __forceinline__ void att_qk_part(f32x16& s0, f32x16& s1, const LAS unsigned char* kp, const bf16x8 (&qr)[DQK / 16], const f32x16& negm) {
    constexpr int KSTR = (DQK + 8) * 2;
#pragma unroll
    for (int c = C_LO; c < C_HI; ++c) {
        const bf16x8 k0 = *(const LAS bf16x8*)(kp + c * 32);
        const bf16x8 k1 = *(const LAS bf16x8*)(kp + 32 * KSTR + c * 32);
        if (c == 0) { s0 = MFMA32(k0, qr[0], negm); s1 = MFMA32(k1, qr[0], negm); }
        else { s0 = MFMA32(k0, qr[c], s0); s1 = MFMA32(k1, qr[c], s1); }
    }
}
__device__ __forceinline__ void att_post_half(f32x16& s, float& lrun, bf16x8& pa0, bf16x8& pa1) {
    float ls = 0.f;
#pragma unroll
    for (int i = 0; i < 16; ++i) { s[i] = __builtin_amdgcn_exp2f(s[i]); ls += s[i]; }
    lrun += ls;
    u32x4 pk; pk.x = cvtpk(s[0], s[1]); pk.y = cvtpk(s[2], s[3]); pk.z = cvtpk(s[4], s[5]); pk.w = cvtpk(s[6], s[7]);
    pa0 = __builtin_bit_cast(bf16x8, pk);
    u32x4 pq; pq.x = cvtpk(s[8], s[9]); pq.y = cvtpk(s[10], s[11]); pq.z = cvtpk(s[12], s[13]); pq.w = cvtpk(s[14], s[15]);
    pa1 = __builtin_bit_cast(bf16x8, pq);
}
template <int S_LO>
__device__ __forceinline__ void att_pv_half(f32x16 (&o)[2], const bf16x8& pa0, const bf16x8& pa1, const LAS unsigned char* vp) {
#pragma unroll
    for (int db = 0; db < 2; ++db) {
        const bf16x8 v0 = *(const LAS bf16x8*)(vp + db * 32 * 144 + S_LO * 32);
        const bf16x8 v1 = *(const LAS bf16x8*)(vp + db * 32 * 144 + (S_LO + 1) * 32);
        o[db] = MFMA32(v0, pa0, o[db]); o[db] = MFMA32(v1, pa1, o[db]);
    }
}
template <int DQK, int MODE>
__device__ __forceinline__ void attn_unit_pipe(LAS unsigned char* lds, const bf16_t* Q, int qpitch, const bf16_t* K, int kpitch, const bf16_t* V, int vpitch,
                                               bf16_t* O, int opitch, int q0, int t_begin, int t_end, const float* biasrow, float sink_l2, int tid_in) {
    int tid = tid_in; asm volatile("" : "+v"(tid));
    constexpr int DV = 64, KSTR = (DQK + 8) * 2, VSTR = 144, KBUF = 64 * KSTR, VBUF = DV * VSTR;
    constexpr int NKC = DQK / 8, NKCH = 64 * NKC, KIT = (NKCH + 511) / 512, NC = DQK / 16;
    constexpr int OFF_K = 0, OFF_V = 2 * KBUF, OFF_BIAS = 2 * KBUF + 2 * VBUF;
    const int lane = tid & 63, w = __builtin_amdgcn_readfirstlane(tid >> 6), r = lane & 31, h = lane >> 5;
    const int R0 = q0 + 32 * w, qa = R0 + r;
    LAS float* biasl = (LAS float*)(lds + OFF_BIAS);
    if (MODE == 1) { if (tid < 128) biasl[tid] = biasrow[tid]; }
    bf16x8 qr[NC];
#pragma unroll
    for (int c = 0; c < NC; ++c) qr[c] = *(const bf16x8*)(Q + (size_t)(R0 + r) * qpitch + 16 * c + 8 * h);
    u32x4 kst[KIT], vst;
    const int vpos = (lane & ~15) | (((lane >> 2) & 1) << 3) | (((lane >> 3) & 1) << 2) | (lane & 3);
#define ATP_LOADK(t) do { \
        _Pragma("unroll") for (int i_ = 0; i_ < KIT; ++i_) { const int c_ = tid + 512 * i_; if (c_ < NKCH) { const int row_ = c_ / NKC, col_ = c_ % NKC; \
            kst[i_] = *(const u32x4*)(K + (size_t)(64 * (t) + row_) * kpitch + col_ * 8); } } } while (0)
#define ATP_LOADV(t) do { vst = *(const u32x4*)(V + (size_t)(64 * (t) + lane) * vpitch + w * 8); } while (0)
#define ATP_STOREK(buf) do { \
        _Pragma("unroll") for (int i_ = 0; i_ < KIT; ++i_) { const int c_ = tid + 512 * i_; if (c_ < NKCH) { const int row_ = c_ / NKC, col_ = c_ % NKC; \
            *(LAS u32x4*)(lds + OFF_K + (buf) * KBUF + row_ * KSTR + col_ * 16) = kst[i_]; } } } while (0)
#define ATP_STOREV(buf) do { LAS unsigned short* vd_ = (LAS unsigned short*)(lds + OFF_V + (buf) * VBUF + (w * 8) * VSTR + vpos * 2); \
            vd_[0 * (VSTR / 2)] = (unsigned short)(vst.x & 0xffffu); vd_[1 * (VSTR / 2)] = (unsigned short)(vst.x >> 16); \
            vd_[2 * (VSTR / 2)] = (unsigned short)(vst.y & 0xffffu); vd_[3 * (VSTR / 2)] = (unsigned short)(vst.y >> 16); \
            vd_[4 * (VSTR / 2)] = (unsigned short)(vst.z & 0xffffu); vd_[5 * (VSTR / 2)] = (unsigned short)(vst.z >> 16); \
            vd_[6 * (VSTR / 2)] = (unsigned short)(vst.w & 0xffffu); vd_[7 * (VSTR / 2)] = (unsigned short)(vst.w >> 16); } while (0)
#define ATP_SKIP(t) ((MODE == 0) ? (64 * (t) > R0 + 31) : ((MODE == 1) ? ((64 * (t) > R0 + 31) || (64 * (t) + 63 < R0 - 127)) : false))

    float mhat = (MODE == 1) ? sink_l2 : 0.f;
    float lrun = (MODE == 1 && h == 0) ? 1.f : 0.f;
    bool first = (MODE != 1);
    f32x16 o[2], negm, sA0, sA1, sB0, sB1; bf16x8 pa[4];
#pragma unroll
    for (int i = 0; i < 16; ++i) { o[0][i] = 0.f; o[1][i] = 0.f; negm[i] = -mhat; sA0[i] = 0.f; sA1[i] = 0.f; sB0[i] = 0.f; sB1[i] = 0.f; }
    const LAS unsigned char* kbase = lds + OFF_K + r * KSTR + h * 16;
    const LAS unsigned char* vbase = lds + OFF_V + r * VSTR + h * 16;

    ATP_LOADK(t_begin); ATP_LOADV(t_begin); ATP_STOREK(0); ATP_STOREV(0);
    if (t_begin + 1 < t_end) { ATP_LOADK(t_begin + 1); ATP_STOREK(1); }
    __syncthreads();
    if (!ATP_SKIP(t_begin)) att_qk<DQK>(sA0, sA1, kbase, qr, negm);
    __syncthreads();
#define ATP_ITER_FAST(C0, C1, N0, N1, T) do { \
        const int t_ = (T); const int sc_ = (t_ - t_begin) & 1; \
        ATP_LOADK(t_ + 2); ATP_LOADV(t_ + 1); \
        const LAS unsigned char* kpn_ = kbase + (sc_ ^ 1) * KBUF; const LAS unsigned char* vpc_ = vbase + sc_ * VBUF; \
        att_pre<2>(C0, C1, o, negm, mhat, lrun, first, t_, R0, qa, h, biasl); \
        __builtin_amdgcn_sched_barrier(0); \
        att_qk_part<DQK, 0, NC>(N0, N1, kpn_, qr, negm); att_post_half(C0, lrun, pa[0], pa[1]); \
        __builtin_amdgcn_sched_barrier(0); \
        att_pv_half<0>(o, pa[0], pa[1], vpc_); att_post_half(C1, lrun, pa[2], pa[3]); \
        __builtin_amdgcn_sched_barrier(0); \
        att_pv_half<2>(o, pa[2], pa[3], vpc_); \
        ATP_STOREK(sc_); ATP_STOREV(sc_ ^ 1); \
        __syncthreads(); } while (0)
#define ATP_ITER_GEN(C0, C1, N0, N1, T) do { \
        const int t_ = (T); const bool m1_ = (t_ + 1 < t_end), m2_ = (t_ + 2 < t_end); \
        if (m2_) ATP_LOADK(t_ + 2); if (m1_) ATP_LOADV(t_ + 1); \
        const bool sk_ = ATP_SKIP(t_), skn_ = !m1_ || ATP_SKIP(t_ + 1); \
        const int sc_ = (t_ - t_begin) & 1; \
        const LAS unsigned char* kpn_ = kbase + (sc_ ^ 1) * KBUF; const LAS unsigned char* vpc_ = vbase + sc_ * VBUF; \
        if (!sk_) att_pre<MODE>(C0, C1, o, negm, mhat, lrun, first, t_, R0, qa, h, biasl); \
        if (!skn_) att_qk<DQK>(N0, N1, kpn_, qr, negm); \
        if (!sk_) { att_post(C0, C1, lrun, pa); att_pv(o, pa, vpc_); } \
        if (m2_) ATP_STOREK(sc_); if (m1_) ATP_STOREV(sc_ ^ 1); \
        __syncthreads(); } while (0)
    int t = t_begin;
    if (MODE == 0) {
        const int n_fast = (q0 >> 6) - 1;
        for (; t + 1 < n_fast; t += 2) { ATP_ITER_FAST(sA0, sA1, sB0, sB1, t); ATP_ITER_FAST(sB0, sB1, sA0, sA1, t + 1); }
    }
    for (; t < t_end; ++t) { ATP_ITER_GEN(sA0, sA1, sB0, sB1, t); sA0 = sB0; sA1 = sB1; }

    { auto rr = __builtin_amdgcn_permlane32_swap(__float_as_uint(lrun), __float_as_uint(lrun), false, false); lrun = __uint_as_float(rr[0]) + __uint_as_float(rr[1]); }
    const float inv = 1.f / lrun;
    bf16_t* orow = O + (size_t)(R0 + r) * opitch;
#pragma unroll
    for (int db = 0; db < 2; ++db)
#pragma unroll
        for (int g = 0; g < 4; ++g) {
            u32x2 wv; wv.x = cvtpk(o[db][4 * g + 0] * inv, o[db][4 * g + 1] * inv); wv.y = cvtpk(o[db][4 * g + 2] * inv, o[db][4 * g + 3] * inv);
            *(u32x2*)(orow + 32 * db + 8 * g + 4 * h) = wv;
        }
#undef ATP_LOADK
#undef ATP_LOADV
#undef ATP_STOREK
#undef ATP_STOREV
#undef ATP_SKIP
#undef ATP_ITER_FAST
#undef ATP_ITER_GEN
}

__device__ __forceinline__ int map_col(int kind, int off, int n) {
    switch (kind) {
    case 1: {
        if (n < 256) return n;
        if (n < 512) { const int j = n - 256; if (j < 128) return 256 + j; if (j < 160) { const int p = j - 128; return 384 + 16 * ((p >> 2) & 1) + 4 * (p >> 3) + (p & 3); } return -1; }
        if (n < 1024) return 416 + (n - 512);
        if (n < 1280) return 928 + (n - 1024);
        return 1184 + (n - 1280);
    }
    case 2: {
        if (n < 512) return (n >> 6) * 96 + (n & 63);
        const int j = n - 512, hd = j >> 5, p = j & 31; return hd * 96 + 64 + 16 * ((p >> 2) & 1) + 4 * (p >> 3) + (p & 3);
    }
    case 3: {
        if (n < 512) return (n >> 6) * 128 + (n & 63);
        const int j = n - 512; return (j >> 6) * 128 + 64 + (j & 63);
    }
    default: return off + n;
    }
}
__device__ __forceinline__ void conv_matrix(const float* W, int K, int Nsrc, const float* gain, bf16_t* WT, int Ndst, int kind, int off, LAS float* scr, int gw, int ngw, int lane) {
    const int nblk = Ndst / 64, nitems = (K / 64) * nblk;
    const int kq = lane >> 4, n4 = lane & 15;
    for (int it = gw; it < nitems; it += ngw) {
        const int kb = it / nblk, nb = it % nblk, k0 = 64 * kb, n0 = 64 * nb;
        const int src = map_col(kind, off, n0 + 4 * n4);
        f32x4 v[16];
#pragma unroll
        for (int i = 0; i < 16; ++i) { v[i] = (f32x4){0.f, 0.f, 0.f, 0.f}; if (src >= 0) v[i] = *(const f32x4*)(W + (size_t)(k0 + 4 * i + kq) * Nsrc + src); }
        if (gain) {
#pragma unroll
            for (int i = 0; i < 16; ++i) v[i] = v[i] * gain[k0 + 4 * i + kq];
        }
#pragma unroll
        for (int i = 0; i < 16; ++i) { LAS float* d = scr + (4 * i + kq) * 65 + 4 * n4; d[0] = v[i][0]; d[1] = v[i][1]; d[2] = v[i][2]; d[3] = v[i][3]; }
        asm volatile("s_waitcnt lgkmcnt(0)" ::: "memory");
        const int c = lane & 7;
#pragma unroll
        for (int j = 0; j < 8; ++j) { const int n = (lane >> 3) + 8 * j; const LAS float* sp = scr + (8 * c) * 65 + n;
            u32x4 o; o.x = cvtpk(sp[0 * 65], sp[1 * 65]); o.y = cvtpk(sp[2 * 65], sp[3 * 65]); o.z = cvtpk(sp[4 * 65], sp[5 * 65]); o.w = cvtpk(sp[6 * 65], sp[7 * 65]);
            *(u32x4*)(WT + (size_t)(n0 + n) * K + k0 + 8 * c) = o; }
        asm volatile("s_waitcnt lgkmcnt(0)" ::: "memory");
    }
}
__device__ __forceinline__ float row_to_bf16(const float* xrow, bf16_t* orow, int lane) {
    const f32x4* xr = (const f32x4*)xrow + lane;
    f32x4 v[4]; float s = 0.f;
#pragma unroll
    for (int j = 0; j < 4; ++j) { v[j] = xr[64 * j]; s += (v[j][0] * v[j][0] + v[j][1] * v[j][1]) + (v[j][2] * v[j][2] + v[j][3] * v[j][3]); }
    u32x2* o8 = (u32x2*)orow + lane;
#pragma unroll
    for (int j = 0; j < 4; ++j) { u32x2 wv; wv.x = cvtpk(v[j][0], v[j][1]); wv.y = cvtpk(v[j][2], v[j][3]); o8[64 * j] = wv; }
    return wave_sum(s);
}
__device__ __forceinline__ float rope_inv(int i) {
    const float t[16] = {1.000000000e+00f, 5.623413324e-01f, 3.162277639e-01f, 1.778279394e-01f, 1.000000015e-01f, 5.623412877e-02f, 3.162277862e-02f, 1.778279431e-02f,
                         9.999999776e-03f, 5.623413250e-03f, 3.162277862e-03f, 1.778279431e-03f, 1.000000047e-03f, 5.623413017e-04f, 3.162277862e-04f, 1.778279402e-04f};
    float r = t[0];
#pragma unroll
    for (int k = 1; k < 16; ++k) r = (i == k) ? t[k] : r;
    return r;
}

#define XB_TMO      128
#define XB_XCNT(j)  (256  + 64 * (j))
#define XB_XSUB(j)  (1280 + 64 * (j))
#define XB_XGEN(j)  (2304 + 64 * (j))
#define XB_TOP      3328
#define XB_TOPGEN   3392
#define XCD_BAR_WORDS 3456
#define XB_SPIN_CAP (1u << 18)

__device__ __forceinline__ unsigned xb_ld(unsigned* p)              { return __hip_atomic_load(p, __ATOMIC_RELAXED, __HIP_MEMORY_SCOPE_AGENT); }
__device__ __forceinline__ unsigned xb_add(unsigned* p, unsigned v) { return __hip_atomic_fetch_add(p, v, __ATOMIC_RELAXED, __HIP_MEMORY_SCOPE_AGENT); }
__device__ __forceinline__ unsigned xb_xcc_id() { return (unsigned)__builtin_amdgcn_s_getreg((3 << 11) | 20) & 0xFu; }
#define XB_SPIN(cond, bar) do { unsigned _sp = 0; while (cond) { __builtin_amdgcn_s_sleep(1); \
    if ((++_sp & 255u) == 0u) { if (xb_ld(&(bar)[XB_TMO])) break; if (_sp > XB_SPIN_CAP) { atomicAdd(&(bar)[XB_TMO], 1u); break; } } } } while (0)

struct XcdBarrier {
    unsigned* bar; unsigned x;
    volatile LAS unsigned* st;
};

__device__ __forceinline__ XcdBarrier xcd_barrier_post(unsigned* bar, volatile LAS unsigned* st) {
    XcdBarrier b; b.bar = bar; b.x = xb_xcc_id(); b.st = st;
    if (threadIdx.x == 0) (void)xb_add(&bar[XB_XCNT(b.x)], 1u);
    return b;
}
__device__ __forceinline__ void xcd_barrier_complete(unsigned* bar, unsigned x, unsigned& nloc, unsigned& nx) {
    const unsigned G = gridDim.x * gridDim.y * gridDim.z;
    unsigned sum, cnt, mine, sp = 0u;
    for (;;) {
        sum = 0u; cnt = 0u; mine = 0u;
#pragma unroll
        for (unsigned j = 0; j < 16; ++j) { const unsigned c = xb_ld(&bar[XB_XCNT(j)]); sum += c; cnt += (c > 0u) ? 1u : 0u; mine = (j == x) ? c : mine; }
        if (sum == G) break;
        __builtin_amdgcn_s_sleep(1);
        if ((++sp & 255u) == 0u) { if (xb_ld(&bar[XB_TMO])) break; if (sp > XB_SPIN_CAP) { atomicAdd(&bar[XB_TMO], 1u); break; } }
    }
    nloc = mine > 0u ? mine : 1u; nx = cnt > 0u ? cnt : 1u;
}

__device__ __forceinline__ void xcd_barrier(const XcdBarrier& b) {
    asm volatile("s_waitcnt vmcnt(0)" ::: "memory");
    __syncthreads();
    if (threadIdx.x == 0) {
        unsigned* bar = b.bar;
        __builtin_amdgcn_s_waitcnt(0);
        unsigned nloc = b.st[0], nx = b.st[1];
        if (nloc == 0u) { xcd_barrier_complete(bar, b.x, nloc, nx); b.st[0] = nloc; b.st[1] = nx; }
        const unsigned old = xb_add(&bar[XB_XSUB(b.x)], 1u);
        const unsigned gen = old / nloc;
        if (old + 1u == (gen + 1u) * nloc) {
            __builtin_amdgcn_fence(__ATOMIC_RELEASE, "agent");
            asm volatile("s_waitcnt vmcnt(0)" ::: "memory");
            const unsigned og = xb_add(&bar[XB_TOP], 1u);
            const unsigned tg = og / nx;
            if (og + 1u == (tg + 1u) * nx) xb_add(&bar[XB_TOPGEN], 1u);
            else XB_SPIN(xb_ld(&bar[XB_TOPGEN]) == tg, bar);
            __builtin_amdgcn_fence(__ATOMIC_ACQUIRE, "agent");
            xb_add(&bar[XB_XGEN(b.x)], 1u);
            asm volatile("s_waitcnt vmcnt(0)" ::: "memory");
        } else {
            XB_SPIN(xb_ld(&bar[XB_XGEN(b.x)]) == gen, bar);
            __builtin_amdgcn_fence(__ATOMIC_ACQUIRE, "agent");
            asm volatile("s_waitcnt vmcnt(0)" ::: "memory");
        }
    }
    __syncthreads();
}

constexpr int LDS_BYTES = 147456;
__global__ void __launch_bounds__(512, 2) fwd_mega(Args a) {
    extern __shared__ __attribute__((aligned(16))) unsigned char lds_raw[];
    LAS unsigned char* lds = (LAS unsigned char*)lds_raw;
    cg::grid_group grid = cg::this_grid();
    const int tid = threadIdx.x, lane = tid & 63, wave = __builtin_amdgcn_readfirstlane(tid >> 6);
    const int G = gridDim.x, bid = blockIdx.x;
    unsigned char* ws_k = a.ws;

    {
        unsigned char* ws = ws_k;
        bf16_t* XB = (bf16_t*)(ws + WS_XB);
        float* RS = (float*)(ws + WS_RS);
        LAS float* scr = (LAS float*)(lds + wave * 16896);
        const int gw = bid * 8 + wave, ngw = G * 8;
        for (int l = 0; l < NL; ++l) {
            bf16_t* WL = (bf16_t*)(ws + WS_W + (size_t)l * W_LAYER_BYTES);
            const float* an = a.in[I_ATTN_NORM] + l * D;
            conv_matrix(a.in[I_W_IN] + (size_t)l * D * INCOLS, D, INCOLS, an, WL + W_IN, 1792, 1, 0, scr, gw, ngw, lane);
            conv_matrix(a.in[I_W_IN] + (size_t)l * D * INCOLS, D, INCOLS, an, WL + W_G, 3072, 0, 1696, scr, gw, ngw, lane);
            conv_matrix(a.in[I_W_UQ] + (size_t)l * 256 * 768, 256, 768, a.in[I_QNORM] + l * 256, WL + W_UQ, 768, 2, 0, scr, gw, ngw, lane);
            conv_matrix(a.in[I_W_UKV] + (size_t)l * 128 * 1024, 128, 1024, a.in[I_KVNORM] + l * 128, WL + W_UKV, 1024, 3, 0, scr, gw, ngw, lane);
            conv_matrix(a.in[I_W_MEMKV] + (size_t)l * D * 1024, D, 1024, a.in[I_MEM_NORM] + l * D, WL + W_MEM, 1024, 0, 0, scr, gw, ngw, lane);
            conv_matrix(a.in[I_WO_MLA] + (size_t)l * 512 * D, 512, D, nullptr, WL + W_O, 1024, 0, 0, scr, gw, ngw, lane);
            conv_matrix(a.in[I_WO_SWA] + (size_t)l * 512 * D, 512, D, nullptr, WL + W_O + (size_t)1024 * 512, 1024, 0, 0, scr, gw, ngw, lane);
            conv_matrix(a.in[I_WO_MEM] + (size_t)l * 512 * D, 512, D, nullptr, WL + W_O + (size_t)2 * 1024 * 512, 1024, 0, 0, scr, gw, ngw, lane);
            conv_matrix(a.in[I_W_OUT] + (size_t)l * D * D, D, D, nullptr, WL + W_OUT, 1024, 0, 0, scr, gw, ngw, lane);
            conv_matrix(a.in[I_W_UP] + (size_t)l * D * DFF, D, DFF, a.in[I_MLP_NORM] + l * D, WL + W_UP, 4096, 0, 0, scr, gw, ngw, lane);
            conv_matrix(a.in[I_W_DOWN] + (size_t)l * DFF * D, DFF, D, nullptr, WL + W_DOWN, 1024, 0, 0, scr, gw, ngw, lane);
        }
        for (int m = gw; m < S; m += ngw) { const float ss = row_to_bf16(a.in[I_X] + (size_t)m * D, XB + (size_t)m * D, lane); if (lane == 0) RS[m] = ss; }
        { bf16_t* MEMB = (bf16_t*)(ws + WS_MEMB); float* RSTDM = (float*)(ws + WS_RSTDM);
          for (int m = gw; m < MEML; m += ngw) { const float ss = row_to_bf16(a.in[I_MEM] + (size_t)m * D, MEMB + (size_t)m * D, lane); if (lane == 0) RSTDM[m] = 1.0f / sqrtf(ss * (1.0f / D) + EPS); } }
        const int gt = bid * 512 + tid, ngt = G * 512;
        for (int i = gt; i < 8 * S; i += ngt) RS[S + i] = 0.f;
        { f32x2* ROPE = (f32x2*)(ws + WS_ROPE);
          for (int i = gt; i < S * 16; i += ngt) {
            const int pos = i >> 4, fi = i & 15;
            const float ang = (float)pos * rope_inv(fi);
            const double rev = (double)ang * 0.15915494309189535;
            const float fr = (float)(rev - __builtin_rint(rev));
            f32x2 cs; cs.x = __builtin_amdgcn_cosf(fr); cs.y = __builtin_amdgcn_sinf(fr);
            ROPE[i] = cs;
          } }
        { float* BIAS = (float*)(ws + WS_BIAS);
          for (int i = gt; i < 8 * 128; i += ngt) {
            const int hh = i >> 7, n = i & 127;
            int bucket = n;
            if (n >= 16) { const float lg = __builtin_amdgcn_logf((float)n * 0.0625f) * (16.0f / 3.0f); bucket = 16 + (int)lg; if (bucket > 31) bucket = 31; }
            BIAS[i] = a.in[I_RELB][bucket * 8 + hh] * LOG2E;
          } }
        { float* BG = (float*)(ws + WS_BG); float* SK = (float*)(ws + WS_SINK); float* FN = (float*)(ws + WS_FN);
          for (int i = gt; i < 2 * 3072; i += ngt) BG[i] = a.in[I_B_GATE][i];
          for (int i = gt; i < 16; i += ngt) SK[i] = a.in[I_SINKS][i] * LOG2E;
          for (int i = gt; i < 1024; i += ngt) FN[i] = a.in[I_FNORM][i];
          for (int i = gt; i < 4096; i += ngt) ((unsigned*)(ws + WS_BAR))[i] = 0u;
          if (gt == 0) { unsigned long long* pt = (unsigned long long*)(ws + WS_PTAB); pt[0] = (unsigned long long)(uintptr_t)a.in[I_X]; pt[1] = (unsigned long long)(uintptr_t)a.out; } }
    }
    if (tid < 2) ((volatile LAS unsigned*)(lds + 143360))[tid] = 0u;
    grid.sync();
    const XcdBarrier xbar = xcd_barrier_post((unsigned*)(ws_k + WS_BAR), (volatile LAS unsigned*)(lds + 143360));

    constexpr int NSTEPS = 14 * NL;
    for (int step = 0; step < NSTEPS; ++step) {
        bool do_sync = true;
        const int l = step / 14, k = step % 14;
        unsigned char* ws = ws_k; asm volatile("" : "+s"(ws));
        if (k == 4) {
            int tidv = threadIdx.x; asm volatile("" : "+v"(tidv));
            bf16_t* QMLA = (bf16_t*)(ws + WS_QMLA); bf16_t* KMLA = (bf16_t*)(ws + WS_KMLA); bf16_t* VMLA = (bf16_t*)(ws + WS_VMLA); bf16_t* OMLA = (bf16_t*)(ws + WS_OMLA);
            for (int u = bid; u < 256; u += G) {
                const int hh = u & 7, j = u >> 3;
                for (int kk = 0; kk < 2; ++kk) {
                    const int qb = kk == 0 ? 63 - j : j;
                    attn_unit_pipe<96, 0>(lds, QMLA + hh * 96, 768, KMLA + hh * 96, 768, VMLA + hh * 64, 512, OMLA + hh * 64, 512, 256 * qb, 0, 4 * (qb + 1), nullptr, 0.f, tidv);
                }
            }
            tidv = threadIdx.x; asm volatile("" : "+v"(tidv));
            bf16_t* QS = (bf16_t*)(ws + WS_QS); bf16_t* KS = (bf16_t*)(ws + WS_KS); bf16_t* VS = (bf16_t*)(ws + WS_VS);
            const float* BIAS = (const float*)(ws + WS_BIAS); const float* SK = (const float*)(ws + WS_SINK);
            for (int u = bid; u < 512; u += G) {
                const int hh = u >> 6, qb = u & 63, g = hh >> 2;
                const int tb = 4 * qb - 2 < 0 ? 0 : 4 * qb - 2;
                attn_unit<64, 64, 1>(lds, QS + hh * 64, 512, KS + g * 64, 128, VS + g * 64, 128, QS + hh * 64, 512, 256 * qb, tb, 4 * qb + 4, BIAS + hh * 128, SK[l * 8 + hh], tidv);
            }
            tidv = threadIdx.x; asm volatile("" : "+v"(tidv));
            bf16_t* QM = (bf16_t*)(ws + WS_QM); bf16_t* KMEM = (bf16_t*)(ws + WS_KMEM); bf16_t* VMEM = (bf16_t*)(ws + WS_VMEM);
            for (int u = bid; u < 256; u += G) {
                const int hh = u >> 6, qb = u & 63;
                attn_unit<128, 128, 2>(lds, QM + hh * 128, 512, KMEM + hh * 128, 512, VMEM + hh * 128, 512, QM + hh * 128, 512, 256 * qb, 0, 4, nullptr, 0.f, tidv);
            }
        } else {
            const bf16_t* WL = (const bf16_t*)(ws + WS_W + (size_t)l * W_LAYER_BYTES);
            const bf16_t* XB = (const bf16_t*)(ws + WS_XB);
            pg8::Gemm g{}; Epi E{}; int cid = bid;
            E.ws = ws; E.layer = l;
            switch (k) {
            case 0: g = pg8::Gemm{XB, WL + W_IN, S, 1792, 1024}; E.mode = M_WIN; do_sync = false; break;
            case 1: g = pg8::Gemm{(const bf16_t*)(ws + WS_MEMB), WL + W_MEM, MEML, 1024, 1024}; E.mode = M_MEM; cid = G - 1 - bid; break;
            case 2: g = pg8::Gemm{(const bf16_t*)(ws + WS_CQ), WL + W_UQ, S, 768, 256}; E.mode = M_UQ; do_sync = false; break;
            case 3: g = pg8::Gemm{(const bf16_t*)(ws + WS_CKV), WL + W_UKV, S, 1024, 128}; E.mode = M_UKV; cid = G - 1 - bid; break;
            case 5: case 7: case 9: { const int br = (k - 5) >> 1; g = pg8::Gemm{XB, WL + W_G + (size_t)br * 1024 * 1024, S, 1024, 1024}; E.mode = M_GATE; E.br = br; do_sync = false; } break;
            case 6: case 8: case 10: { const int br = (k - 6) >> 1; const bf16_t* Ab = (const bf16_t*)(ws + (br == 0 ? WS_OMLA : (br == 1 ? WS_QS : WS_QM)));
                    g = pg8::Gemm{Ab, WL + W_O + (size_t)br * 1024 * 512, S, 1024, 512}; E.mode = M_Z; E.br = br; do_sync = (k == 10); } break;
            case 11: g = pg8::Gemm{(const bf16_t*)(ws + WS_YB), WL + W_OUT, S, 1024, 1024}; E.mode = M_RES; E.br = 0; break;
            case 12: g = pg8::Gemm{XB, WL + W_UP, S, 4096, 1024}; E.mode = M_UP; break;
            default: g = pg8::Gemm{(const bf16_t*)(ws + WS_H), WL + W_DOWN, S, 1024, 4096}; E.mode = M_RES; E.br = 1; break;
            }
            pg8::StaticOrder SO; SO.init(g.M, g.N, G, cid);
            pg8::gemm_phase<Epi, pg8::StaticOrder, true, true>(lds, g, SO, E);
        }
        if (do_sync) xcd_barrier(xbar);
    }
    {
        unsigned char* ws = ws_k;
        int tidf = threadIdx.x; asm volatile("" : "+v"(tidf));
        const int lane = tidf & 63, wave = __builtin_amdgcn_readfirstlane(tidf >> 6);
        const int gw = bid * 8 + wave, ngw = G * 8;
        float* X = *(float* const*)(ws + WS_PTAB + 8);
        const float* rsf = (const float*)(ws + WS_RS) + (size_t)(4 * NL) * S;
        const f32x4* gn = (const f32x4*)(ws + WS_FN) + lane;
        for (int m = gw; m < S; m += ngw) {
            f32x4* xr = (f32x4*)(X + (size_t)m * D) + lane;
            const float rstd = 1.0f / sqrtf(rsf[m] * (1.0f / D) + EPS);
#pragma unroll
            for (int j = 0; j < 4; ++j) { f32x4 v = xr[64 * j]; v = v * rstd * gn[64 * j]; xr[64 * j] = v; }
        }
    }
}

extern "C" void kernel_launch(void* const* d_in, const int* in_sizes, int n_in, void* d_out, int out_size, void* d_ws, size_t ws_size, hipStream_t stream) {
    static int grid = 0;
    if (grid == 0) {
        int dev = 0, cus = 0, per_cu = 0;
        (void)hipGetDevice(&dev);
        (void)hipDeviceGetAttribute(&cus, hipDeviceAttributeMultiprocessorCount, dev);
        (void)hipFuncSetAttribute((const void*)fwd_mega, hipFuncAttributeMaxDynamicSharedMemorySize, LDS_BYTES);
        (void)hipOccupancyMaxActiveBlocksPerMultiprocessor(&per_cu, (const void*)fwd_mega, 512, LDS_BYTES);
        if (per_cu < 1) per_cu = 1;
        grid = cus * per_cu;
        if (grid <= 0) grid = 256;
    }
    Args a{};
    for (int i = 0; i < 21; ++i) a.in[i] = (const float*)d_in[i];
    a.out = (float*)d_out; a.ws = (unsigned char*)d_ws;
    void* args[] = {&a};
    hipError_t e = hipLaunchCooperativeKernel((void*)fwd_mega, dim3(grid), dim3(512), args, LDS_BYTES, stream);
    if (e != hipSuccess) fprintf(stderr, "cooperative launch failed: %s (grid %d)\n", hipGetErrorString(e), grid);
}
```

```cpp
#include <hip/hip_runtime.h>
#include <hip/hip_cooperative_groups.h>
#include <cstdio>
#include <cstdint>
namespace cg = cooperative_groups;
namespace pg8 {
#define PG8_LAS __attribute__((address_space(3)))
typedef unsigned short bf16_t;
typedef short bf16x8 __attribute__((ext_vector_type(8)));
typedef float f32x4 __attribute__((ext_vector_type(4)));
typedef unsigned u32x4 __attribute__((ext_vector_type(4)));
constexpr int BM = 256, BK = 64, HALF = 128, HTB = HALF * BK * 2  , STAGE_BYTES = 8 * HTB, NXCD = 8, WGM = 8;

__host__ __device__ __forceinline__ int lds_byte(int r, int c) { const int st = (r >> 4) * 2 + (c >> 5), rr = r & 15, cc = c & 31, ob = rr * 64 + cc * 2; return st * 1024 + (ob ^ (((ob >> 9) & 1) << 5)); }
__host__ __device__ __forceinline__ void stage_rc(int b, int& R, int& C) { const int st = b / 1024, sb = b % 1024, swz = sb ^ (((sb >> 9) & 1) << 5); R = (st >> 1) * 16 + swz / 64; C = (st & 1) * 32 + (swz % 64) / 2; }
__host__ __device__ __forceinline__ int perm32(int rho) { const int n = rho >> 4, i = rho & 15; return 8 * (i >> 2) + 4 * n + (i & 3); }

struct Unit { int pm, pn; };
struct Gemm { const bf16_t* A; const bf16_t* Bt; int M, N, K; };

struct StaticOrder {
    int nM, nN, nwg, G, c;
    __host__ __device__ void init(int M, int N, int G_, int c_) { nM = M / BM; nN = N / BM; nwg = nM * nN; G = G_; c = c_; }
    __host__ __device__ bool next(int i, Unit& u) const {
        const long L = (long)i * G + c; if (L >= nwg) return false;
        int wgid = (int)L; { const int q = nwg / NXCD, r = nwg % NXCD, xcd = wgid % NXCD, off = wgid / NXCD; wgid = (xcd < r ? xcd * (q + 1) : r * (q + 1) + (xcd - r) * q) + off; }
        const int nig = WGM * nN, gid = wgid / nig, fm = gid * WGM, gsz = (nM - fm) < WGM ? (nM - fm) : WGM;
        u.pm = fm + ((wgid % nig) % gsz); u.pn = (wgid % nig) / gsz; return true;
    }
    __device__ __forceinline__ void a_ready(const Unit&) const {}
    __device__ __forceinline__ void done(const Unit&) const {}
};

__device__ __forceinline__ unsigned cvt_pk_bf16(float lo, float hi) { unsigned r; asm volatile("v_cvt_pk_bf16_f32 %0, %1, %2" : "=v"(r) : "v"(lo), "v"(hi)); return r; }
typedef float f32x2 __attribute__((ext_vector_type(2)));
template <class Epi, class Sched, bool ALIGN_EPI = false, bool SP2 = false>
__device__ __forceinline__ void gemm_phase(PG8_LAS unsigned char* lds, const Gemm g, const Sched& S, const Epi& E) {
    int tid_o = threadIdx.x; asm volatile("" : "+v"(tid_o));
    const int tid = tid_o, wid = __builtin_amdgcn_readfirstlane(tid >> 6), lane = tid & 63, wr = wid >> 2, wc = wid & 3, fr = lane & 15, fq = lane >> 4;
    const int K = g.K, nt = K / BK;
    unsigned voffA[2], voffB[2];
#pragma unroll
    for (int i = 0; i < 2; ++i) { int R, C; stage_rc(tid * 16 + i * 8192, R, C); const int Rb = Epi::PERM ? ((R & ~31) + perm32(R & 31)) : R;
        voffA[i] = (unsigned)(R * K + C) * 2u; voffB[i] = (unsigned)(Rb * K + C) * 2u; }
    const size_t kstep = (size_t)(BK * 2);
    const size_t hstep = (size_t)HALF * K * 2;
    const size_t tstep = 2 * hstep;
    const unsigned ldsw = (unsigned)wid * 1024u;
    const int aoff = lds_byte(wr * 64 + fr, fq * 8), boff = lds_byte(wc * 32 + fr, fq * 8);
#define PG8_SA(b, h) (((b) * 2 + (h)) * HTB)
#define PG8_SB(b, h) ((4 + (b) * 2 + (h)) * HTB)
#define PG8_STAGE(bufoff, gbase, voff) do { _Pragma("unroll") for (int _i = 0; _i < 2; ++_i) \
        __builtin_amdgcn_global_load_lds((const unsigned*)((const char*)(gbase) + (voff)[_i]), (PG8_LAS unsigned*)(lds + (bufoff) + ldsw + _i * 8192), 16, 0, 0); } while (0)
#define PG8_LDA(dst, b, h) do { _Pragma("unroll") for (int m = 0; m < 4; ++m) _Pragma("unroll") for (int k = 0; k < 2; ++k) dst[m][k] = *(const PG8_LAS bf16x8*)(lds + PG8_SA(b, h) + aoff + m * 2048 + k * 1024); } while (0)
#define PG8_LDB(dst, b, h) do { _Pragma("unroll") for (int n = 0; n < 2; ++n) _Pragma("unroll") for (int k = 0; k < 2; ++k) dst[n][k] = *(const PG8_LAS bf16x8*)(lds + PG8_SB(b, h) + boff + n * 2048 + k * 1024); } while (0)
#define PG8_MMA(ai, bj, At, Bt) do { __builtin_amdgcn_s_setprio(1); _Pragma("unroll") for (int m = 0; m < 4; ++m) _Pragma("unroll") for (int n = 0; n < 2; ++n) _Pragma("unroll") for (int k = 0; k < 2; ++k) \
        acc[ai][bj][m][n] = __builtin_amdgcn_mfma_f32_16x16x32_bf16(Bt[n][k], At[m][k], acc[ai][bj][m][n], 0, 0, 0); __builtin_amdgcn_s_setprio(0); } while (0)
#define PG8_WAIT_V(n) asm volatile("s_waitcnt vmcnt(" #n ")" ::: "memory")
#define PG8_WAIT_L(n) asm volatile("s_waitcnt lgkmcnt(" #n ")" ::: "memory")
#define PG8_BAR __builtin_amdgcn_s_barrier()
#define PG8_SCHED __builtin_amdgcn_sched_barrier(0)
    Unit cur, nxt; int ui = 0;
    if (!S.next(0, cur)) return;
    f32x4 acc[2][2][4][2];
#pragma unroll
    for (int a = 0; a < 2; ++a)
#pragma unroll
        for (int b = 0; b < 2; ++b)
#pragma unroll
            for (int m = 0; m < 4; ++m)
#pragma unroll
                for (int n = 0; n < 2; ++n) acc[a][b][m][n] = (f32x4){0.f, 0.f, 0.f, 0.f};
    bf16x8 At[4][2], B0[2][2], B1[2][2];
    const char* cA = (const char*)g.A + (size_t)cur.pm * tstep; const char* cB = (const char*)g.Bt + (size_t)cur.pn * tstep;
    S.a_ready(cur);
    if constexpr (SP2) {
        PG8_STAGE(PG8_SB(0, 0), cB, voffB); PG8_STAGE(PG8_SB(0, 1), cB + hstep, voffB); PG8_STAGE(PG8_SA(0, 0), cA, voffA); PG8_STAGE(PG8_SA(0, 1), cA + hstep, voffA);
        if (wr == 1) PG8_BAR;
        PG8_WAIT_V(2); PG8_BAR;
        PG8_STAGE(PG8_SB(1, 0), cB + kstep, voffB); PG8_STAGE(PG8_SA(1, 0), cA + kstep, voffA); PG8_STAGE(PG8_SB(1, 1), cB + hstep + kstep, voffB);
        PG8_WAIT_V(6); PG8_BAR;
    } else {
        PG8_STAGE(PG8_SB(0, 0), cB, voffB); PG8_STAGE(PG8_SA(0, 0), cA, voffA); PG8_STAGE(PG8_SB(0, 1), cB + hstep, voffB); PG8_STAGE(PG8_SA(0, 1), cA + hstep, voffA);
        if (wr == 1) PG8_BAR;
        PG8_WAIT_V(4); PG8_BAR;
        PG8_STAGE(PG8_SB(1, 0), cB + kstep, voffB); PG8_STAGE(PG8_SA(1, 0), cA + kstep, voffA); PG8_STAGE(PG8_SB(1, 1), cB + hstep + kstep, voffB);
        PG8_WAIT_V(6); PG8_BAR;
    }
    for (;;) {
        const bool has_next = S.next(ui + 1, nxt);
        const char* nA = has_next ? (const char*)g.A + (size_t)nxt.pm * tstep : cA; const char* nB = has_next ? (const char*)g.Bt + (size_t)nxt.pn * tstep : cB;
        for (int t = 0; t < nt; t += 2) {
            const bool last = (t == nt - 2);
            const char* a1 = cA + (size_t)(t + 1) * kstep;
            const char* a2 = last ? nA : cA + (size_t)(t + 2) * kstep; const char* b2 = last ? nB : cB + (size_t)(t + 2) * kstep;
            const char* a3 = a2 + kstep; const char* b3 = b2 + kstep;
            if (last && has_next) S.a_ready(nxt);
            if constexpr (SP2) {
            PG8_LDB(B0, 0, 0); PG8_LDB(B1, 0, 1); PG8_SCHED; PG8_LDA(At, 0, 0); PG8_STAGE(PG8_SA(1, 1), a1 + hstep, voffA);
            PG8_WAIT_V(8); PG8_WAIT_L(0); PG8_BAR; PG8_MMA(0, 0, At, B0); PG8_MMA(0, 1, At, B1); PG8_BAR; PG8_SCHED;
            PG8_LDA(At, 0, 1); PG8_STAGE(PG8_SB(0, 0), b2, voffB); PG8_STAGE(PG8_SB(0, 1), b2 + hstep, voffB); PG8_STAGE(PG8_SA(0, 0), a2, voffA);
            PG8_WAIT_V(8); PG8_WAIT_L(0); PG8_BAR; PG8_MMA(1, 0, At, B0); PG8_MMA(1, 1, At, B1); PG8_BAR; PG8_SCHED;
            PG8_LDB(B0, 1, 0); PG8_LDB(B1, 1, 1); PG8_SCHED; PG8_LDA(At, 1, 0); PG8_STAGE(PG8_SA(0, 1), a2 + hstep, voffA);
            PG8_WAIT_V(8); PG8_WAIT_L(0); PG8_BAR; PG8_MMA(0, 0, At, B0); PG8_MMA(0, 1, At, B1); PG8_BAR; PG8_SCHED;
            PG8_LDA(At, 1, 1); PG8_STAGE(PG8_SB(1, 0), b3, voffB); PG8_STAGE(PG8_SB(1, 1), b3 + hstep, voffB); PG8_STAGE(PG8_SA(1, 0), a3, voffA);
            PG8_WAIT_V(8); PG8_WAIT_L(0); PG8_BAR; PG8_MMA(1, 0, At, B0); PG8_MMA(1, 1, At, B1); PG8_BAR; PG8_SCHED;
            } else {
            PG8_LDB(B0, 0, 0); PG8_SCHED; PG8_LDA(At, 0, 0); PG8_STAGE(PG8_SA(1, 1), a1 + hstep, voffA);
            PG8_WAIT_L(8); PG8_BAR; PG8_WAIT_L(0); PG8_MMA(0, 0, At, B0); PG8_BAR; PG8_SCHED;
            PG8_LDB(B1, 0, 1); PG8_STAGE(PG8_SB(0, 0), b2, voffB);
            PG8_BAR; PG8_WAIT_L(0); PG8_MMA(0, 1, At, B1); PG8_BAR;
            PG8_LDA(At, 0, 1); PG8_STAGE(PG8_SA(0, 0), a2, voffA);
            PG8_BAR; PG8_WAIT_L(0); PG8_MMA(1, 0, At, B0); PG8_BAR; PG8_SCHED;
            PG8_STAGE(PG8_SB(0, 1), b2 + hstep, voffB);
            PG8_WAIT_V(6); PG8_BAR; PG8_MMA(1, 1, At, B1); PG8_BAR;
            PG8_LDB(B0, 1, 0); PG8_SCHED; PG8_LDA(At, 1, 0); PG8_STAGE(PG8_SA(0, 1), a2 + hstep, voffA);
            PG8_WAIT_L(8); PG8_BAR; PG8_WAIT_L(0); PG8_MMA(0, 0, At, B0); PG8_BAR; PG8_SCHED;
            PG8_LDB(B1, 1, 1); PG8_STAGE(PG8_SB(1, 0), b3, voffB);
            PG8_BAR; PG8_WAIT_L(0); PG8_MMA(0, 1, At, B1); PG8_BAR;
            PG8_LDA(At, 1, 1); PG8_STAGE(PG8_SA(1, 0), a3, voffA);
            PG8_BAR; PG8_WAIT_L(0); PG8_MMA(1, 0, At, B0); PG8_BAR; PG8_SCHED;
            PG8_STAGE(PG8_SB(1, 1), b3 + hstep, voffB);
            PG8_WAIT_V(6); PG8_BAR; PG8_MMA(1, 1, At, B1); PG8_BAR;
            }
        }
        if constexpr (ALIGN_EPI) { if (wr == 0) PG8_BAR; }
        if constexpr (!Epi::AFTER_DRAIN) { E(acc, cur, wr, wc, fr, fq); S.done(cur); }
        if (!has_next) break;
#pragma unroll
        for (int a = 0; a < 2; ++a)
#pragma unroll
            for (int b = 0; b < 2; ++b)
#pragma unroll
                for (int m = 0; m < 4; ++m)
#pragma unroll
                    for (int n = 0; n < 2; ++n) acc[a][b][m][n] = (f32x4){0.f, 0.f, 0.f, 0.f};
        cur = nxt; cA = nA; cB = nB; ++ui;
        if constexpr (ALIGN_EPI) { if (wr == 1) PG8_BAR; }
    }
    PG8_WAIT_V(0);
    if constexpr (!ALIGN_EPI) { if (wr == 0) PG8_BAR; }
    PG8_BAR;
    if constexpr (Epi::AFTER_DRAIN) { E.fused(acc, cur, wr, wc, fr, fq, lds, wid, lane); S.done(cur); }
#undef PG8_SA
#undef PG8_SB
#undef PG8_STAGE
#undef PG8_LDA
#undef PG8_LDB
#undef PG8_MMA
#undef PG8_WAIT_V
#undef PG8_WAIT_L
#undef PG8_BAR
#undef PG8_SCHED
}
}

typedef unsigned short bf16_t;
typedef short bf16x8 __attribute__((ext_vector_type(8)));
typedef float f32x4 __attribute__((ext_vector_type(4)));
typedef float f32x2 __attribute__((ext_vector_type(2)));
typedef float f32x16 __attribute__((ext_vector_type(16)));
typedef unsigned u32x4 __attribute__((ext_vector_type(4)));
typedef unsigned u32x2 __attribute__((ext_vector_type(2)));
typedef __bf16 bf16x2_t __attribute__((ext_vector_type(2)));
#define LAS __attribute__((address_space(3)))
#define GAS __attribute__((address_space(1)))

constexpr int S = 16384, D = 1024, DFF = 4096, NL = 2, MEML = 256;
constexpr int INCOLS = 4768;
constexpr float EPS = 1e-6f;
constexpr float LOG2E = 1.4426950408889634f;
constexpr float QS_SCALE = 0.125f * LOG2E;
constexpr float QM_SCALE = 0.08838834764831845f * LOG2E;
constexpr float QMLA_SCALE = 0.10206207261596575f * LOG2E;

constexpr size_t W_IN = 0;
constexpr size_t W_G = W_IN + (size_t)1792 * 1024;
constexpr size_t W_UQ = W_G + (size_t)3072 * 1024;
constexpr size_t W_UKV = W_UQ + (size_t)768 * 256;
constexpr size_t W_MEM = W_UKV + (size_t)1024 * 128;
constexpr size_t W_O = W_MEM + (size_t)1024 * 1024;
constexpr size_t W_OUT = W_O + (size_t)3 * 1024 * 512;
constexpr size_t W_UP = W_OUT + (size_t)1024 * 1024;
constexpr size_t W_DOWN = W_UP + (size_t)4096 * 1024;
constexpr size_t W_LAYER_ELEMS = W_DOWN + (size_t)1024 * 4096;
constexpr size_t MiB = 1u << 20;
constexpr size_t W_LAYER_BYTES = 34 * MiB;
static_assert(W_LAYER_ELEMS * 2 <= W_LAYER_BYTES, "weights");
constexpr size_t WS_W = 0;
constexpr size_t WS_XB = 68 * MiB;
constexpr size_t WS_SMALL = 100 * MiB;
constexpr size_t WS_RS = WS_SMALL;
constexpr size_t WS_RSTDM = WS_RS + 9 * (size_t)S * 4;
constexpr size_t WS_BIAS = WS_RSTDM + 1024;
constexpr size_t WS_ROPE = WS_BIAS + 4096;
constexpr size_t WS_MEMB = WS_ROPE + (size_t)S * 16 * 8;
constexpr size_t WS_KMEM = WS_MEMB + (size_t)256 * 1024 * 2;
constexpr size_t WS_VMEM = WS_KMEM + (size_t)256 * 512 * 2;
constexpr size_t WS_PTAB = WS_VMEM + (size_t)256 * 512 * 2;
constexpr size_t WS_BG = WS_PTAB + 64;
constexpr size_t WS_SINK = WS_BG + 2 * 3072 * 4;
constexpr size_t WS_FN = WS_SINK + 64;
constexpr size_t WS_BAR = WS_FN + 4096;
static_assert(WS_BAR + 16384 <= 104 * MiB, "small region");
constexpr size_t WS_H = 104 * MiB;
constexpr size_t WS_QMLA = 104 * MiB;
constexpr size_t WS_KMLA = 128 * MiB;
constexpr size_t WS_VMLA = 152 * MiB;
constexpr size_t WS_QS = 168 * MiB;
constexpr size_t WS_KS = 184 * MiB;
constexpr size_t WS_VS = 188 * MiB;
constexpr size_t WS_QM = 192 * MiB;
constexpr size_t WS_CQ = 208 * MiB;
constexpr size_t WS_CKV = 216 * MiB;
constexpr size_t WS_OMLA = 220 * MiB;
constexpr size_t WS_T = 104 * MiB;
constexpr size_t WS_YB = 136 * MiB;
static_assert(WS_OMLA + (size_t)S * 512 * 2 <= 256 * MiB, "ws");

struct Args {
    const float* in[21];
    float* out; unsigned char* ws;
};
enum { I_X = 0, I_MEM, I_RELB, I_ATTN_NORM, I_MEM_NORM, I_W_IN, I_B_GATE, I_QNORM, I_W_UQ, I_KVNORM, I_W_UKV, I_SINKS, I_W_MEMKV, I_WO_MLA, I_WO_SWA, I_WO_MEM, I_W_OUT, I_MLP_NORM, I_W_UP, I_W_DOWN, I_FNORM };

__device__ __forceinline__ unsigned cvtpk(float lo, float hi) { f32x2 v = {lo, hi}; bf16x2_t b = __builtin_convertvector(v, bf16x2_t); return __builtin_bit_cast(unsigned, b); }
__device__ __forceinline__ float bf_lo(unsigned u) { return __uint_as_float(u << 16); }
__device__ __forceinline__ float bf_hi(unsigned u) { return __uint_as_float(u & 0xffff0000u); }
__device__ __forceinline__ float wave_sum(float v) {
#pragma unroll
    for (int o = 1; o < 64; o <<= 1) v += __shfl_xor(v, o);
    return v;
}

enum { M_WIN = 0, M_MEM, M_UQ, M_UKV, M_GATE, M_Z, M_RES, M_UP };
struct Epi {
    static constexpr bool PERM = true, AFTER_DRAIN = false;
    int mode, br, layer; unsigned char* ws;
    __device__ __forceinline__ void store8(GAS bf16_t* dst, const f32x4& a, const f32x4& b) const {
        u32x4 w; w.x = cvtpk(a[0], a[1]); w.y = cvtpk(a[2], a[3]); w.z = cvtpk(b[0], b[1]); w.w = cvtpk(b[2], b[3]);
        *(GAS u32x4*)dst = w;
    }
    __device__ __forceinline__ float sq8(const f32x4& a0, const f32x4& a1) const { return (a0[0]*a0[0] + a0[1]*a0[1]) + (a0[2]*a0[2] + a0[3]*a0[3]) + (a1[0]*a1[0] + a1[1]*a1[1]) + (a1[2]*a1[2] + a1[3]*a1[3]); }
    __device__ __forceinline__ void operator()(const f32x4 (&acc)[2][2][4][2], const pg8::Unit& u, int wr, int wc, int fr_in, int fq_in) const {
        int fr = fr_in, fq = fq_in; asm volatile("" : "+v"(fr), "+v"(fq));
        const int pn = u.pn;
        GAS unsigned char* wsg = (GAS unsigned char*)ws;
        GAS float* RS = (GAS float*)(wsg + WS_RS);
        const GAS float* rs_in = RS + (size_t)(4 * layer) * S; float inv_k = 1.0f / 1024.0f;
        if (mode == M_MEM) rs_in = (const GAS float*)(wsg + WS_RSTDM);
        if (mode == M_UQ) { rs_in = RS + (size_t)(4 * layer + 1) * S; inv_k = 1.0f / 256.0f; }
        if (mode == M_UKV) { rs_in = RS + (size_t)(4 * layer + 2) * S; inv_k = 1.0f / 128.0f; }
        if (mode == M_UP) rs_in = RS + (size_t)(4 * layer + 3) * S;
        GAS float* rs_out = RS + (size_t)(4 * layer + 1) * S;
        if (mode == M_WIN && pn == 1) rs_out = RS + (size_t)(4 * layer + 2) * S;
        if (mode == M_RES) rs_out = RS + (size_t)(4 * layer + 3 + br) * S;
        const GAS float* resid = nullptr; GAS float* X = nullptr;
        if (mode == M_RES) { X = (GAS float*)*(float* const GAS*)(wsg + WS_PTAB + 8); resid = (layer == 0 && br == 0) ? (const GAS float*)*(const float* const GAS*)(wsg + WS_PTAB) : X; }
#pragma unroll
        for (int ai = 0; ai < 2; ++ai)
#pragma unroll
            for (int m = 0; m < 4; ++m) {
                const int row = u.pm * 256 + ai * 128 + wr * 64 + m * 16 + fr;
                float sc = 1.f;
                if (mode == M_MEM) sc = rs_in[row];
                else if (mode != M_Z && mode != M_RES) sc = __builtin_amdgcn_rsqf(rs_in[row] * inv_k + EPS);
                if (mode == M_UQ) sc *= QMLA_SCALE;
                float ss = 0.f;
#pragma unroll
                for (int bj = 0; bj < 2; ++bj) {
                    const int ct = bj * 128 + wc * 32 + 8 * fq;
                    f32x4 a0 = acc[ai][bj][m][0] * sc, a1 = acc[ai][bj][m][1] * sc;
                    switch (mode) {
                    case M_WIN: {
                        if (pn == 0) { store8((GAS bf16_t*)(wsg + WS_CQ) + (size_t)row * 256 + ct, a0, a1); ss += sq8(a0, a1); }
                        else if (pn == 1) {
                            if (bj == 0) { store8((GAS bf16_t*)(wsg + WS_CKV) + (size_t)row * 128 + ct, a0, a1); ss += sq8(a0, a1); }
                            else if (wc == 0) {
                                const GAS f32x2* cs = (const GAS f32x2*)(wsg + WS_ROPE) + (size_t)row * 16 + 4 * fq;
                                f32x4 o1, o2;
#pragma unroll
                                for (int e = 0; e < 4; ++e) { const f32x2 c = cs[e]; o1[e] = a0[e] * c.x - a1[e] * c.y; o2[e] = a1[e] * c.x + a0[e] * c.y; }
                                u32x2 w1, w2; w1.x = cvtpk(o1[0], o1[1]); w1.y = cvtpk(o1[2], o1[3]); w2.x = cvtpk(o2[0], o2[1]); w2.y = cvtpk(o2[2], o2[3]);
                                GAS bf16_t* kr = (GAS bf16_t*)(wsg + WS_KMLA) + (size_t)row * 768 + 64 + 4 * fq;
#pragma unroll
                                for (int hh = 0; hh < 8; ++hh) { *(GAS u32x2*)(kr + hh * 96) = w1; *(GAS u32x2*)(kr + hh * 96 + 16) = w2; }
                            }
                        }
                        else if (pn < 4) { store8((GAS bf16_t*)(wsg + WS_QS) + (size_t)row * 512 + (pn - 2) * 256 + ct, a0 * QS_SCALE, a1 * QS_SCALE); }
                        else if (pn == 4) { if (bj == 0) store8((GAS bf16_t*)(wsg + WS_KS) + (size_t)row * 128 + ct, a0, a1); else store8((GAS bf16_t*)(wsg + WS_VS) + (size_t)row * 128 + ct - 128, a0, a1); }
                        else { store8((GAS bf16_t*)(wsg + WS_QM) + (size_t)row * 512 + (pn - 5) * 256 + ct, a0 * QM_SCALE, a1 * QM_SCALE); }
                    } break;
                    case M_MEM: {
                        if (pn < 2) store8((GAS bf16_t*)(wsg + WS_KMEM) + (size_t)row * 512 + pn * 256 + ct, a0, a1);
                        else store8((GAS bf16_t*)(wsg + WS_VMEM) + (size_t)row * 512 + (pn - 2) * 256 + ct, a0, a1);
                    } break;
                    case M_UQ: {
                        if (pn < 2) { const int c = pn * 256 + ct; store8((GAS bf16_t*)(wsg + WS_QMLA) + (size_t)row * 768 + (c >> 6) * 96 + (c & 63), a0, a1); }
                        else {
                            const int head = 4 * bj + wc;
                            const GAS f32x2* cs = (const GAS f32x2*)(wsg + WS_ROPE) + (size_t)row * 16 + 4 * fq;
                            f32x4 o1, o2;
#pragma unroll
                            for (int e = 0; e < 4; ++e) { const f32x2 c = cs[e]; o1[e] = a0[e] * c.x - a1[e] * c.y; o2[e] = a1[e] * c.x + a0[e] * c.y; }
                            u32x2 w1, w2; w1.x = cvtpk(o1[0], o1[1]); w1.y = cvtpk(o1[2], o1[3]); w2.x = cvtpk(o2[0], o2[1]); w2.y = cvtpk(o2[2], o2[3]);
                            GAS bf16_t* qrp = (GAS bf16_t*)(wsg + WS_QMLA) + (size_t)row * 768 + head * 96 + 64 + 4 * fq;
                            *(GAS u32x2*)qrp = w1; *(GAS u32x2*)(qrp + 16) = w2;
                        }
                    } break;
                    case M_UKV: {
                        if (pn < 2) { const int c = pn * 256 + ct; store8((GAS bf16_t*)(wsg + WS_KMLA) + (size_t)row * 768 + (c >> 6) * 96 + (c & 63), a0, a1); }
                        else {
                            GAS unsigned short* vt = (GAS unsigned short*)(wsg + WS_VMLA) + (size_t)((pn - 2) * 256 + ct) * S + row;
                            const unsigned w0 = cvtpk(a0[0], a0[1]), w1 = cvtpk(a0[2], a0[3]), w2 = cvtpk(a1[0], a1[1]), w3 = cvtpk(a1[2], a1[3]);
                            vt[0 * (size_t)S] = (unsigned short)(w0 & 0xffffu); vt[1 * (size_t)S] = (unsigned short)(w0 >> 16);
                            vt[2 * (size_t)S] = (unsigned short)(w1 & 0xffffu); vt[3 * (size_t)S] = (unsigned short)(w1 >> 16);
                            vt[4 * (size_t)S] = (unsigned short)(w2 & 0xffffu); vt[5 * (size_t)S] = (unsigned short)(w2 >> 16);
                            vt[6 * (size_t)S] = (unsigned short)(w3 & 0xffffu); vt[7 * (size_t)S] = (unsigned short)(w3 >> 16);
                        }
                    } break;
                    case M_GATE: {
                        const int c = pn * 256 + ct;
                        const GAS float* bg = (const GAS float*)(wsg + WS_BG) + layer * 3072 + br * 1024 + c;
                        const f32x4 b0 = *(const GAS f32x4*)bg, b1 = *(const GAS f32x4*)(bg + 4);
                        f32x4 g0, g1;
#pragma unroll
                        for (int e = 0; e < 4; ++e) { g0[e] = __builtin_amdgcn_rcpf(1.f + __builtin_amdgcn_exp2f(-(a0[e] + b0[e]) * LOG2E)); g1[e] = __builtin_amdgcn_rcpf(1.f + __builtin_amdgcn_exp2f(-(a1[e] + b1[e]) * LOG2E)); }
                        store8((GAS bf16_t*)(wsg + WS_T) + (size_t)row * 1024 + c, g0, g1);
                    } break;
                    case M_Z: {
                        const int c = pn * 256 + ct;
                        const u32x4 t = *(const GAS u32x4*)((GAS bf16_t*)(wsg + WS_T) + (size_t)row * 1024 + c);
                        GAS bf16_t* yp = (GAS bf16_t*)(wsg + WS_YB) + (size_t)row * 1024 + c;
                        f32x4 y0 = {0.f, 0.f, 0.f, 0.f}, y1 = {0.f, 0.f, 0.f, 0.f};
                        if (br > 0) { const u32x4 yo = *(const GAS u32x4*)yp;
                            y0 = (f32x4){bf_lo(yo.x), bf_hi(yo.x), bf_lo(yo.y), bf_hi(yo.y)}; y1 = (f32x4){bf_lo(yo.z), bf_hi(yo.z), bf_lo(yo.w), bf_hi(yo.w)}; }
                        y0 += a0 * (f32x4){bf_lo(t.x), bf_hi(t.x), bf_lo(t.y), bf_hi(t.y)};
                        y1 += a1 * (f32x4){bf_lo(t.z), bf_hi(t.z), bf_lo(t.w), bf_hi(t.w)};
                        store8(yp, y0, y1);
                    } break;
                    case M_RES: {
                        const int c = pn * 256 + ct;
                        const f32x4 x0 = *(const GAS f32x4*)(resid + (size_t)row * 1024 + c) + a0, x1 = *(const GAS f32x4*)(resid + (size_t)row * 1024 + c + 4) + a1;
                        *(GAS f32x4*)(X + (size_t)row * 1024 + c) = x0; *(GAS f32x4*)(X + (size_t)row * 1024 + c + 4) = x1;
                        store8((GAS bf16_t*)(wsg + WS_XB) + (size_t)row * 1024 + c, x0, x1);
                        ss += sq8(x0, x1);
                    } break;
                    default: {
                        f32x4 r0, r1;
#pragma unroll
                        for (int e = 0; e < 4; ++e) { const float v0 = fmaxf(a0[e], 0.f), v1 = fmaxf(a1[e], 0.f); r0[e] = v0 * v0; r1[e] = v1 * v1; }
                        store8((GAS bf16_t*)(wsg + WS_H) + (size_t)row * 4096 + pn * 256 + ct, r0, r1);
                    } break;
                    }
                }
                if (mode == M_RES || (mode == M_WIN && pn < 2)) {
                    ss += __shfl_xor(ss, 16); ss += __shfl_xor(ss, 32);
                    if (fq == 0) __hip_atomic_fetch_add(rs_out + row, ss, __ATOMIC_RELAXED, __HIP_MEMORY_SCOPE_AGENT);
                }
            }
    }
};

__device__ __forceinline__ int crow(int i, int h) { return (i & 3) + 8 * (i >> 2) + 4 * h; }
#define MFMA32(a, b, c) __builtin_amdgcn_mfma_f32_32x32x16_bf16((a), (b), (c), 0, 0, 0)

template <int DQK, int DV, int MODE>
__device__ __forceinline__ void attn_unit(LAS unsigned char* lds, const GAS bf16_t* Q, int qpitch, const GAS bf16_t* K, int kpitch, const GAS bf16_t* V, int vpitch,
                                          GAS bf16_t* O, int opitch, int q0, int t_begin, int t_end, const GAS float* biasrow, float sink_l2, int tid) {
    constexpr int KSTR = (DQK + 8) * 2, VSTR = 144, KBUF = 64 * KSTR, VBUF = DV * VSTR;
    constexpr int NKC = DQK / 8, NKCH = 64 * NKC, KIT = (NKCH + 511) / 512, VIT = DV / 64, NC = DQK / 16, NDB = DV / 32;
    constexpr int OFF_K = 0, OFF_V = 2 * KBUF, OFF_BIAS = 2 * KBUF + 2 * VBUF;
    static_assert(OFF_BIAS + 512 <= 131072, "attention lds");
    const int lane = tid & 63, w = __builtin_amdgcn_readfirstlane(tid >> 6), r = lane & 31, h = lane >> 5;
    const int R0 = q0 + 32 * w;
    LAS float* biasl = (LAS float*)(lds + OFF_BIAS);
    if (MODE == 1) { if (tid < 128) biasl[tid] = biasrow[tid]; }
    bf16x8 qr[NC];
#pragma unroll
    for (int c = 0; c < NC; ++c) qr[c] = *(const GAS bf16x8*)(Q + (size_t)(R0 + r) * qpitch + 16 * c + 8 * h);
    u32x4 kst[KIT], vst[VIT];
    const int vpos = (lane & ~15) | (((lane >> 2) & 1) << 3) | (((lane >> 3) & 1) << 2) | (lane & 3);
#define ATT_LOAD(t) do { \
        _Pragma("unroll") for (int i_ = 0; i_ < KIT; ++i_) { const int c_ = tid + 512 * i_; if (c_ < NKCH) { const int row_ = c_ / NKC, col_ = c_ % NKC; \
            kst[i_] = *(const GAS u32x4*)(K + (size_t)(64 * (t) + row_) * kpitch + col_ * 8); } } \
        _Pragma("unroll") for (int i_ = 0; i_ < VIT; ++i_) vst[i_] = *(const GAS u32x4*)(V + (size_t)(64 * (t) + lane) * vpitch + (w + 8 * i_) * 8); } while (0)
#define ATT_STORE(buf) do { \
        _Pragma("unroll") for (int i_ = 0; i_ < KIT; ++i_) { const int c_ = tid + 512 * i_; if (c_ < NKCH) { const int row_ = c_ / NKC, col_ = c_ % NKC; \
            *(LAS u32x4*)(lds + OFF_K + (buf) * KBUF + row_ * KSTR + col_ * 16) = kst[i_]; } } \
        _Pragma("unroll") for (int i_ = 0; i_ < VIT; ++i_) { LAS unsigned short* vd_ = (LAS unsigned short*)(lds + OFF_V + (buf) * VBUF + ((w + 8 * i_) * 8) * VSTR + vpos * 2); \
            const u32x4 v_ = vst[i_]; \
            vd_[0 * (VSTR / 2)] = (unsigned short)(v_.x & 0xffffu); vd_[1 * (VSTR / 2)] = (unsigned short)(v_.x >> 16); \
            vd_[2 * (VSTR / 2)] = (unsigned short)(v_.y & 0xffffu); vd_[3 * (VSTR / 2)] = (unsigned short)(v_.y >> 16); \
            vd_[4 * (VSTR / 2)] = (unsigned short)(v_.z & 0xffffu); vd_[5 * (VSTR / 2)] = (unsigned short)(v_.z >> 16); \
            vd_[6 * (VSTR / 2)] = (unsigned short)(v_.w & 0xffffu); vd_[7 * (VSTR / 2)] = (unsigned short)(v_.w >> 16); } } while (0)

    float mrun = (MODE == 1) ? sink_l2 : -INFINITY;
    float lrun = (MODE == 1 && h == 0) ? 1.f : 0.f;
    f32x16 o[NDB];
#pragma unroll
    for (int db = 0; db < NDB; ++db)
#pragma unroll
        for (int i = 0; i < 16; ++i) o[db][i] = 0.f;

    ATT_LOAD(t_begin);
    ATT_STORE(0);
    __syncthreads();
    for (int t = t_begin; t < t_end; ++t) {
        const int buf = (t - t_begin) & 1;
        const bool more = (t + 1 < t_end);
        if (more) ATT_LOAD(t + 1);
        bool skip = false;
        if (MODE == 0) skip = (64 * t > R0 + 31);
        if (MODE == 1) skip = (64 * t > R0 + 31) || (64 * t + 63 < R0 - 127);
        if (!skip) {
            f32x16 p0, p1;
#pragma unroll
            for (int i = 0; i < 16; ++i) { p0[i] = 0.f; p1[i] = 0.f; }
            const LAS unsigned char* kp = lds + OFF_K + buf * KBUF + r * KSTR + h * 16;
#pragma unroll
            for (int c = 0; c < NC; ++c) {
                const bf16x8 k0 = *(const LAS bf16x8*)(kp + c * 32);
                const bf16x8 k1 = *(const LAS bf16x8*)(kp + 32 * KSTR + c * 32);
                p0 = MFMA32(k0, qr[c], p0); p1 = MFMA32(k1, qr[c], p1);
            }
            const int qa = R0 + r;
            if (MODE == 0) {
                if (64 * t + 63 > R0) {
#pragma unroll
                    for (int i = 0; i < 16; ++i) { const int kv = 64 * t + crow(i, h); if (kv > qa) p0[i] = -INFINITY; if (kv + 32 > qa) p1[i] = -INFINITY; }
                }
            }
            if (MODE == 1) {
#pragma unroll
                for (int i = 0; i < 16; ++i) { const int d0 = qa - (64 * t + crow(i, h)), d1 = d0 - 32;
                    const float b0 = biasl[d0 & 127], b1 = biasl[d1 & 127];
                    p0[i] = (d0 >= 0 && d0 < 128) ? p0[i] + b0 : -INFINITY; p1[i] = (d1 >= 0 && d1 < 128) ? p1[i] + b1 : -INFINITY; }
            }
            float mx = fmaxf(p0[0], p1[0]);
#pragma unroll
            for (int i = 1; i < 16; ++i) mx = fmaxf(mx, fmaxf(p0[i], p1[i]));
            mx = fmaxf(mx, __shfl_xor(mx, 32));
            const float mnew = fmaxf(mrun, mx);
            const float alpha = __builtin_amdgcn_exp2f(mrun - mnew);
            mrun = mnew;
            float ls = 0.f;
#pragma unroll
            for (int i = 0; i < 16; ++i) { p0[i] = __builtin_amdgcn_exp2f(p0[i] - mnew); p1[i] = __builtin_amdgcn_exp2f(p1[i] - mnew); ls += p0[i] + p1[i]; }
            lrun = lrun * alpha + ls;
#pragma unroll
            for (int db = 0; db < NDB; ++db)
#pragma unroll
                for (int i = 0; i < 16; ++i) o[db][i] *= alpha;
            bf16x8 pa[4];
#pragma unroll
            for (int s = 0; s < 4; ++s) {
                u32x4 pk;
                if (s < 2) { pk.x = cvtpk(p0[8 * s + 0], p0[8 * s + 1]); pk.y = cvtpk(p0[8 * s + 2], p0[8 * s + 3]); pk.z = cvtpk(p0[8 * s + 4], p0[8 * s + 5]); pk.w = cvtpk(p0[8 * s + 6], p0[8 * s + 7]); }
                else { const int s2 = s - 2; pk.x = cvtpk(p1[8 * s2 + 0], p1[8 * s2 + 1]); pk.y = cvtpk(p1[8 * s2 + 2], p1[8 * s2 + 3]); pk.z = cvtpk(p1[8 * s2 + 4], p1[8 * s2 + 5]); pk.w = cvtpk(p1[8 * s2 + 6], p1[8 * s2 + 7]); }
                pa[s] = __builtin_bit_cast(bf16x8, pk);
            }
            const LAS unsigned char* vp = lds + OFF_V + buf * VBUF + r * VSTR + h * 16;
#pragma unroll
            for (int db = 0; db < NDB; ++db)
#pragma unroll
                for (int s = 0; s < 4; ++s) {
                    const bf16x8 vf = *(const LAS bf16x8*)(vp + db * 32 * VSTR + s * 32);
                    o[db] = MFMA32(vf, pa[s], o[db]);
                }
        }
        if (more) ATT_STORE(buf ^ 1);
        __syncthreads();
    }
    lrun += __shfl_xor(lrun, 32);
    const float inv = 1.f / lrun;
    GAS bf16_t* orow = O + (size_t)(R0 + r) * opitch;
#pragma unroll
    for (int db = 0; db < NDB; ++db)
#pragma unroll
        for (int g = 0; g < 4; ++g) {
            u32x2 wv; wv.x = cvtpk(o[db][4 * g + 0] * inv, o[db][4 * g + 1] * inv); wv.y = cvtpk(o[db][4 * g + 2] * inv, o[db][4 * g + 3] * inv);
            *(GAS u32x2*)(orow + 32 * db + 8 * g + 4 * h) = wv;
        }
#undef ATT_LOAD
#undef ATT_STORE
}

constexpr float ATT_THR = 8.0f;
__device__ __forceinline__ float max3f(float a, float b, float c) { return __builtin_fmaxf(__builtin_fmaxf(a, b), c); }
template <int DQK>
__device__ __forceinline__ void att_qk(f32x16& s0, f32x16& s1, const LAS unsigned char* kp, const bf16x8 (&qr)[DQK / 16]) {
    constexpr int NC = DQK / 16, KSTR = (DQK + 8) * 2;
    f32x16 z;
#pragma unroll
    for (int i = 0; i < 16; ++i) z[i] = 0.f;
#pragma unroll
    for (int c = 0; c < NC; ++c) {
        const bf16x8 k0 = *(const LAS bf16x8*)(kp + c * 32);
        const bf16x8 k1 = *(const LAS bf16x8*)(kp + 32 * KSTR + c * 32);
        if (c == 0) { s0 = MFMA32(k0, qr[0], z); s1 = MFMA32(k1, qr[0], z); }
        else { s0 = MFMA32(k0, qr[c], s0); s1 = MFMA32(k1, qr[c], s1); }
    }
}
template <int MODE>
__device__ __forceinline__ void att_pre(f32x16& s0, f32x16& s1, f32x16 (&o)[2], float& mhat, float& lrun, bool& first, int t, int R0, int qa, int h, const LAS float* biasl) {
#pragma unroll
    for (int i = 0; i < 16; ++i) { s0[i] -= mhat; s1[i] -= mhat; }
    if (MODE == 0) {
        if (64 * t + 63 > R0) {
#pragma unroll
            for (int i = 0; i < 16; ++i) { const int kv = 64 * t + crow(i, h); if (kv > qa) s0[i] = -INFINITY; if (kv + 32 > qa) s1[i] = -INFINITY; }
        }
    }
    if (MODE == 1) {
#pragma unroll
        for (int i = 0; i < 16; ++i) { const int d0 = qa - (64 * t + crow(i, h)), d1 = d0 - 32;
            const float b0 = biasl[d0 & 127], b1 = biasl[d1 & 127];
            s0[i] = (d0 >= 0 && d0 < 128) ? s0[i] + b0 : -INFINITY; s1[i] = (d1 >= 0 && d1 < 128) ? s1[i] + b1 : -INFINITY; }
    }
    float a = max3f(s0[0], s0[1], s1[0]), b = max3f(s0[2], s0[3], s1[1]); a = max3f(a, s1[2], s1[3]);
#pragma unroll
    for (int i = 4; i < 16; i += 4) { a = max3f(a, s0[i], s0[i + 1]); b = max3f(b, s0[i + 2], s0[i + 3]); a = max3f(a, s1[i], s1[i + 1]); b = max3f(b, s1[i + 2], s1[i + 3]); }
    float rm = __builtin_fmaxf(a, b);
    { auto rr = __builtin_amdgcn_permlane32_swap(__float_as_uint(rm), __float_as_uint(rm), false, false); rm = __builtin_fmaxf(__uint_as_float(rr[0]), __uint_as_float(rr[1])); }
    if (first || __any(rm > ATT_THR)) {
        const float dl = first ? rm : __builtin_fmaxf(rm, 0.f);
        mhat += dl;
#pragma unroll
        for (int i = 0; i < 16; ++i) { s0[i] -= dl; s1[i] -= dl; }
        if (!first) { const float f = __builtin_amdgcn_exp2f(-dl); lrun *= f;
#pragma unroll
            for (int i = 0; i < 16; ++i) { o[0][i] *= f; o[1][i] *= f; } }
        first = false;
    }
}
__device__ __forceinline__ void att_post_half(f32x16& s, float& lrun, bf16x8& pa0, bf16x8& pa1) {
    float ls = 0.f;
#pragma unroll
    for (int i = 0; i < 16; ++i) { s[i] = __builtin_amdgcn_exp2f(s[i]); ls += s[i]; }
    lrun += ls;
    u32x4 pk; pk.x = cvtpk(s[0], s[1]); pk.y = cvtpk(s[2], s[3]); pk.z = cvtpk(s[4], s[5]); pk.w = cvtpk(s[6], s[7]);
    pa0 = __builtin_bit_cast(bf16x8, pk);
    u32x4 pq; pq.x = cvtpk(s[8], s[9]); pq.y = cvtpk(s[10], s[11]); pq.z = cvtpk(s[12], s[13]); pq.w = cvtpk(s[14], s[15]);
    pa1 = __builtin_bit_cast(bf16x8, pq);
}
__device__ __forceinline__ void att_pv(f32x16 (&o)[2], const bf16x8 (&pa)[4], const LAS unsigned char* vp) {
#pragma unroll
    for (int db = 0; db < 2; ++db)
#pragma unroll
        for (int s = 0; s < 4; ++s) {
            const bf16x8 vf = *(const LAS bf16x8*)(vp + db * 32 * 144 + s * 32);
            o[db] = MFMA32(vf, pa[s], o[db]);
        }
}
template <int DQK, int MODE, bool VT>
__device__ __forceinline__ void attn_unit_pipe(LAS unsigned char* lds, const GAS bf16_t* Q, int qpitch, const GAS bf16_t* K, int kpitch, const GAS bf16_t* V, int vpitch,
                                               GAS bf16_t* O, int opitch, int q0, int t_begin, int t_end, const GAS float* biasrow, float sink_l2, int tid_in) {
    int tid = tid_in; asm volatile("" : "+v"(tid));
    constexpr int DV = 64, KSTR = (DQK + 8) * 2, VSTR = 144, KBUF = 64 * KSTR, VBUF = DV * VSTR;
    constexpr int NKC = DQK / 8, NKCH = 64 * NKC, KIT = (NKCH + 511) / 512, NC = DQK / 16;
    constexpr int OFF_K = 0, OFF_V = 2 * KBUF, OFF_BIAS = 2 * KBUF + 2 * VBUF;
    const int lane = tid & 63, w = __builtin_amdgcn_readfirstlane(tid >> 6), r = lane & 31, h = lane >> 5;
    const int R0 = q0 + 32 * w, qa = R0 + r;
    LAS float* biasl = (LAS float*)(lds + OFF_BIAS);
    if (MODE == 1) { if (tid < 128) biasl[tid] = biasrow[tid]; }
    bf16x8 qr[NC];
#pragma unroll
    for (int c = 0; c < NC; ++c) qr[c] = *(const GAS bf16x8*)(Q + (size_t)(R0 + r) * qpitch + 16 * c + 8 * h);
    u32x4 kstA[KIT], vstA, kstB[KIT], vstB;
    const int vpos = (lane & ~15) | (((lane >> 2) & 1) << 3) | (((lane >> 3) & 1) << 2) | (lane & 3);
#define ATP_LOADK(KST, t) do { \
        _Pragma("unroll") for (int i_ = 0; i_ < KIT; ++i_) { const int c_ = tid + 512 * i_; if (c_ < NKCH) { const int row_ = c_ / NKC, col_ = c_ % NKC; \
            KST[i_] = *(const GAS u32x4*)(K + (size_t)(64 * (t) + row_) * kpitch + col_ * 8); } } } while (0)
#define ATP_LOADV(VST, t) do { if (VT) VST = *(const GAS u32x4*)(V + (size_t)(tid >> 3) * vpitch + 64 * (t) + (tid & 7) * 8); \
        else VST = *(const GAS u32x4*)(V + (size_t)(64 * (t) + lane) * vpitch + w * 8); } while (0)
#define ATP_STOREK(KST, buf) do { \
        _Pragma("unroll") for (int i_ = 0; i_ < KIT; ++i_) { const int c_ = tid + 512 * i_; if (c_ < NKCH) { const int row_ = c_ / NKC, col_ = c_ % NKC; \
            *(LAS u32x4*)(lds + OFF_K + (buf) * KBUF + row_ * KSTR + col_ * 16) = KST[i_]; } } } while (0)
#define ATP_STOREV(VST, buf) do { if (VT) { LAS unsigned char* vt_ = lds + OFF_V + (buf) * VBUF + (tid >> 3) * VSTR + (16 * ((tid & 7) >> 1) + 4 * (tid & 1)) * 2; \
            u32x2 lo_, hi_; lo_.x = VST.x; lo_.y = VST.y; hi_.x = VST.z; hi_.y = VST.w; *(LAS u32x2*)vt_ = lo_; *(LAS u32x2*)(vt_ + 16) = hi_; } else { \
            LAS unsigned short* vd_ = (LAS unsigned short*)(lds + OFF_V + (buf) * VBUF + (w * 8) * VSTR + vpos * 2); \
            vd_[0 * (VSTR / 2)] = (unsigned short)(VST.x & 0xffffu); vd_[1 * (VSTR / 2)] = (unsigned short)(VST.x >> 16); \
            vd_[2 * (VSTR / 2)] = (unsigned short)(VST.y & 0xffffu); vd_[3 * (VSTR / 2)] = (unsigned short)(VST.y >> 16); \
            vd_[4 * (VSTR / 2)] = (unsigned short)(VST.z & 0xffffu); vd_[5 * (VSTR / 2)] = (unsigned short)(VST.z >> 16); \
            vd_[6 * (VSTR / 2)] = (unsigned short)(VST.w & 0xffffu); vd_[7 * (VSTR / 2)] = (unsigned short)(VST.w >> 16); } } while (0)
#define ATP_SKIP(t) ((MODE == 0) ? (64 * (t) > R0 + 31) : ((MODE == 1) ? ((64 * (t) > R0 + 31) || (64 * (t) + 63 < R0 - 127)) : false))

    float mhat = (MODE == 1) ? sink_l2 : 0.f;
    float lrun = (MODE == 1 && h == 0) ? 1.f : 0.f;
    bool first = (MODE != 1);
    f32x16 o[2], sA0, sA1, sB0, sB1; bf16x8 pa[4];
#pragma unroll
    for (int i = 0; i < 16; ++i) { o[0][i] = 0.f; o[1][i] = 0.f; sA0[i] = 0.f; sA1[i] = 0.f; sB0[i] = 0.f; sB1[i] = 0.f; }
    const LAS unsigned char* kbase = lds + OFF_K + r * KSTR + h * 16;
    const LAS unsigned char* vbase = lds + OFF_V + r * VSTR + h * 16;

    ATP_LOADK(kstA, t_begin); ATP_LOADV(vstA, t_begin);
    if (t_begin + 1 < t_end) ATP_LOADK(kstB, t_begin + 1);
    ATP_STOREK(kstA, 0); ATP_STOREV(vstA, 0);
    if (t_begin + 1 < t_end) ATP_STOREK(kstB, 1);
    if (t_begin + 2 < t_end) ATP_LOADK(kstA, t_begin + 2);
    if (t_begin + 1 < t_end) ATP_LOADV(vstA, t_begin + 1);
    __syncthreads();
    if (!ATP_SKIP(t_begin)) att_qk<DQK>(sA0, sA1, kbase, qr);
    __syncthreads();
#define ATP_KF(c, hf) (*(const LAS bf16x8*)(kpn_ + (hf) * 32 * KSTR + (c) * 32))
#define ATP_VF(db, s_) (*(const LAS bf16x8*)(vpc_ + (db) * 32 * 144 + (s_) * 32))
#define ATP_SB() __builtin_amdgcn_sched_barrier(0)
#define ATP_ITER_FAST(C0, C1, N0, N1, KCUR, VCUR, KNXT, VNXT, T) do { \
        const int t_ = (T); const int sc_ = (t_ - t_begin) & 1; \
        const LAS unsigned char* kpn_ = kbase + (sc_ ^ 1) * KBUF; const LAS unsigned char* vpc_ = vbase + sc_ * VBUF; \
          \
        const bf16x8 ka0_ = ATP_KF(0, 0), kb0_ = ATP_KF(0, 1), ka1_ = ATP_KF(1, 0), kb1_ = ATP_KF(1, 1), ka2_ = ATP_KF(2, 0), kb2_ = ATP_KF(2, 1); \
        ATP_LOADK(KNXT, t_ + 3); ATP_LOADV(VNXT, t_ + 2); \
        att_pre<2>(C0, C1, o, mhat, lrun, first, t_, R0, qa, h, biasl); \
        ATP_SB(); \
          \
        const bf16x8 ka3_ = ATP_KF(3, 0), kb3_ = ATP_KF(3, 1), ka4_ = ATP_KF(4, 0), kb4_ = ATP_KF(4, 1), ka5_ = ATP_KF(5, 0), kb5_ = ATP_KF(5, 1); \
        { f32x16 z_; _Pragma("unroll") for (int i_ = 0; i_ < 16; ++i_) z_[i_] = 0.f; N0 = MFMA32(ka0_, qr[0], z_); N1 = MFMA32(kb0_, qr[0], z_); } \
        N0 = MFMA32(ka1_, qr[1], N0); N1 = MFMA32(kb1_, qr[1], N1); \
        N0 = MFMA32(ka2_, qr[2], N0); N1 = MFMA32(kb2_, qr[2], N1); \
        att_post_half(C0, lrun, pa[0], pa[1]); \
        ATP_SB(); \
          \
        const bf16x8 v00_ = ATP_VF(0, 0), v01_ = ATP_VF(0, 1), v10_ = ATP_VF(1, 0), v11_ = ATP_VF(1, 1); \
        const bf16x8 v02_ = ATP_VF(0, 2), v03_ = ATP_VF(0, 3), v12_ = ATP_VF(1, 2), v13_ = ATP_VF(1, 3); \
        N0 = MFMA32(ka3_, qr[3], N0); N1 = MFMA32(kb3_, qr[3], N1); \
        N0 = MFMA32(ka4_, qr[4], N0); N1 = MFMA32(kb4_, qr[4], N1); \
        N0 = MFMA32(ka5_, qr[5], N0); N1 = MFMA32(kb5_, qr[5], N1); \
        o[0] = MFMA32(v00_, pa[0], o[0]); o[1] = MFMA32(v10_, pa[0], o[1]); \
        o[0] = MFMA32(v01_, pa[1], o[0]); o[1] = MFMA32(v11_, pa[1], o[1]); \
        att_post_half(C1, lrun, pa[2], pa[3]); \
        ATP_SB(); \
          \
        o[0] = MFMA32(v02_, pa[2], o[0]); o[1] = MFMA32(v12_, pa[2], o[1]); \
        o[0] = MFMA32(v03_, pa[3], o[0]); o[1] = MFMA32(v13_, pa[3], o[1]); \
        ATP_STOREK(KCUR, sc_); ATP_STOREV(VCUR, sc_ ^ 1); \
        ATP_SB(); asm volatile("s_waitcnt lgkmcnt(0)\n\ts_barrier" ::: "memory"); ATP_SB(); } while (0)
#define ATP_ITER_GEN(C0, C1, N0, N1, KCUR, VCUR, KNXT, VNXT, T) do { \
        const int t_ = (T); const bool m1_ = (t_ + 1 < t_end), m2_ = (t_ + 2 < t_end), m3_ = (t_ + 3 < t_end); \
        if (m3_) ATP_LOADK(KNXT, t_ + 3); if (m2_) ATP_LOADV(VNXT, t_ + 2); \
        const bool sk_ = ATP_SKIP(t_), skn_ = !m1_ || ATP_SKIP(t_ + 1); \
        const int sc_ = (t_ - t_begin) & 1; \
        const LAS unsigned char* kpn_ = kbase + (sc_ ^ 1) * KBUF; const LAS unsigned char* vpc_ = vbase + sc_ * VBUF; \
        if (!sk_) att_pre<MODE>(C0, C1, o, mhat, lrun, first, t_, R0, qa, h, biasl); \
        if (!skn_) att_qk<DQK>(N0, N1, kpn_, qr); \
        if (!sk_) { att_post_half(C0, lrun, pa[0], pa[1]); att_post_half(C1, lrun, pa[2], pa[3]); att_pv(o, pa, vpc_); } \
        if (m2_) ATP_STOREK(KCUR, sc_); if (m1_) ATP_STOREV(VCUR, sc_ ^ 1); \
        ATP_SB(); asm volatile("s_waitcnt lgkmcnt(0)\n\ts_barrier" ::: "memory"); ATP_SB(); } while (0)
    int t = t_begin;
    if (MODE == 0) {
        const int n_fast = (q0 >> 6) - 1;
        for (; t + 1 < n_fast; t += 2) { ATP_ITER_FAST(sA0, sA1, sB0, sB1, kstA, vstA, kstB, vstB, t); ATP_ITER_FAST(sB0, sB1, sA0, sA1, kstB, vstB, kstA, vstA, t + 1); }
    }
    for (; t < t_end; ++t) {
        ATP_ITER_GEN(sA0, sA1, sB0, sB1, kstA, vstA, kstB, vstB, t);
        sA0 = sB0; sA1 = sB1; vstA = vstB;
#pragma unroll
        for (int i_ = 0; i_ < KIT; ++i_) kstA[i_] = kstB[i_];
    }

    { auto rr = __builtin_amdgcn_permlane32_swap(__float_as_uint(lrun), __float_as_uint(lrun), false, false); lrun = __uint_as_float(rr[0]) + __uint_as_float(rr[1]); }
    const float inv = 1.f / lrun;
    GAS bf16_t* orow = O + (size_t)(R0 + r) * opitch;
#pragma unroll
    for (int db = 0; db < 2; ++db)
#pragma unroll
        for (int g = 0; g < 4; ++g) {
            u32x2 wv; wv.x = cvtpk(o[db][4 * g + 0] * inv, o[db][4 * g + 1] * inv); wv.y = cvtpk(o[db][4 * g + 2] * inv, o[db][4 * g + 3] * inv);
            *(GAS u32x2*)(orow + 32 * db + 8 * g + 4 * h) = wv;
        }
#undef ATP_LOADK
#undef ATP_LOADV
#undef ATP_STOREK
#undef ATP_STOREV
#undef ATP_SKIP
#undef ATP_ITER_FAST
#undef ATP_ITER_GEN
#undef ATP_KF
#undef ATP_VF
#undef ATP_SB
}

__device__ __forceinline__ int map_col(int kind, int off, int n) {
    switch (kind) {
    case 1: {
        if (n < 256) return n;
        if (n < 512) { const int j = n - 256; if (j < 128) return 256 + j; if (j < 160) { const int p = j - 128; return 384 + 16 * ((p >> 2) & 1) + 4 * (p >> 3) + (p & 3); } return -1; }
        if (n < 1024) return 416 + (n - 512);
        if (n < 1280) return 928 + (n - 1024);
        return 1184 + (n - 1280);
    }
    case 2: {
        if (n < 512) return (n >> 6) * 96 + (n & 63);
        const int j = n - 512, hd = j >> 5, p = j & 31; return hd * 96 + 64 + 16 * ((p >> 2) & 1) + 4 * (p >> 3) + (p & 3);
    }
    case 3: {
        if (n < 512) return (n >> 6) * 128 + (n & 63);
        const int j = n - 512; return (j >> 6) * 128 + 64 + (j & 63);
    }
    default: return off + n;
    }
}
__device__ __forceinline__ void conv_matrix(const float* W, int K, int Nsrc, const float* gain, bf16_t* WT, int Ndst, int kind, int off, LAS float* scr, int gw, int ngw, int lane) {
    const int nblk = Ndst / 64, nitems = (K / 64) * nblk;
    const int kq = lane >> 4, n4 = lane & 15;
    for (int it = gw; it < nitems; it += ngw) {
        const int kb = it / nblk, nb = it % nblk, k0 = 64 * kb, n0 = 64 * nb;
        const int src = map_col(kind, off, n0 + 4 * n4);
        f32x4 v[16];
#pragma unroll
        for (int i = 0; i < 16; ++i) { v[i] = (f32x4){0.f, 0.f, 0.f, 0.f}; if (src >= 0) v[i] = *(const f32x4*)(W + (size_t)(k0 + 4 * i + kq) * Nsrc + src); }
        if (gain) {
#pragma unroll
            for (int i = 0; i < 16; ++i) v[i] = v[i] * gain[k0 + 4 * i + kq];
        }
#pragma unroll
        for (int i = 0; i < 16; ++i) { LAS float* d = scr + (4 * i + kq) * 65 + 4 * n4; d[0] = v[i][0]; d[1] = v[i][1]; d[2] = v[i][2]; d[3] = v[i][3]; }
        asm volatile("s_waitcnt lgkmcnt(0)" ::: "memory");
        const int c = lane & 7;
#pragma unroll
        for (int j = 0; j < 8; ++j) { const int n = (lane >> 3) + 8 * j; const LAS float* sp = scr + (8 * c) * 65 + n;
            u32x4 o; o.x = cvtpk(sp[0 * 65], sp[1 * 65]); o.y = cvtpk(sp[2 * 65], sp[3 * 65]); o.z = cvtpk(sp[4 * 65], sp[5 * 65]); o.w = cvtpk(sp[6 * 65], sp[7 * 65]);
            *(u32x4*)(WT + (size_t)(n0 + n) * K + k0 + 8 * c) = o; }
        asm volatile("s_waitcnt lgkmcnt(0)" ::: "memory");
    }
}
__device__ __forceinline__ float row_to_bf16(const float* xrow, bf16_t* orow, int lane) {
    const f32x4* xr = (const f32x4*)xrow + lane;
    f32x4 v[4]; float s = 0.f;
#pragma unroll
    for (int j = 0; j < 4; ++j) { v[j] = xr[64 * j]; s += (v[j][0] * v[j][0] + v[j][1] * v[j][1]) + (v[j][2] * v[j][2] + v[j][3] * v[j][3]); }
    u32x2* o8 = (u32x2*)orow + lane;
#pragma unroll
    for (int j = 0; j < 4; ++j) { u32x2 wv; wv.x = cvtpk(v[j][0], v[j][1]); wv.y = cvtpk(v[j][2], v[j][3]); o8[64 * j] = wv; }
    return wave_sum(s);
}
__device__ __forceinline__ float rope_inv(int i) {
    const float t[16] = {1.000000000e+00f, 5.623413324e-01f, 3.162277639e-01f, 1.778279394e-01f, 1.000000015e-01f, 5.623412877e-02f, 3.162277862e-02f, 1.778279431e-02f,
                         9.999999776e-03f, 5.623413250e-03f, 3.162277862e-03f, 1.778279431e-03f, 1.000000047e-03f, 5.623413017e-04f, 3.162277862e-04f, 1.778279402e-04f};
    float r = t[0];
#pragma unroll
    for (int k = 1; k < 16; ++k) r = (i == k) ? t[k] : r;
    return r;
}

#define XB_TMO      128
#define XB_XCNT(j)  (256  + 64 * (j))
#define XB_XSUB(j)  (1280 + 64 * (j))
#define XB_XGEN(j)  (2304 + 64 * (j))
#define XB_TOP      3328
#define XB_TOPGEN   3392
#define XCD_BAR_WORDS 3456
#define XB_SPIN_CAP (1u << 18)

__device__ __forceinline__ unsigned xb_ld(unsigned* p)              { return __hip_atomic_load(p, __ATOMIC_RELAXED, __HIP_MEMORY_SCOPE_AGENT); }
__device__ __forceinline__ unsigned xb_add(unsigned* p, unsigned v) { return __hip_atomic_fetch_add(p, v, __ATOMIC_RELAXED, __HIP_MEMORY_SCOPE_AGENT); }
__device__ __forceinline__ unsigned xb_xcc_id() { return (unsigned)__builtin_amdgcn_s_getreg((3 << 11) | 20) & 0xFu; }
#define XB_SPIN(cond, bar) do { unsigned _sp = 0; while (cond) { __builtin_amdgcn_s_sleep(1); \
    if ((++_sp & 255u) == 0u) { if (xb_ld(&(bar)[XB_TMO])) break; if (_sp > XB_SPIN_CAP) { atomicAdd(&(bar)[XB_TMO], 1u); break; } } } } while (0)

struct XcdBarrier {
    unsigned* bar; unsigned x;
    volatile LAS unsigned* st;
};

__device__ __forceinline__ XcdBarrier xcd_barrier_post(unsigned* bar, volatile LAS unsigned* st) {
    XcdBarrier b; b.bar = bar; b.x = xb_xcc_id(); b.st = st;
    if (threadIdx.x == 0) (void)xb_add(&bar[XB_XCNT(b.x)], 1u);
    return b;
}
__device__ __forceinline__ void xcd_barrier_complete(unsigned* bar, unsigned x, unsigned& nloc, unsigned& nx) {
    const unsigned G = gridDim.x * gridDim.y * gridDim.z;
    unsigned sum, cnt, mine, sp = 0u;
    for (;;) {
        sum = 0u; cnt = 0u; mine = 0u;
#pragma unroll
        for (unsigned j = 0; j < 16; ++j) { const unsigned c = xb_ld(&bar[XB_XCNT(j)]); sum += c; cnt += (c > 0u) ? 1u : 0u; mine = (j == x) ? c : mine; }
        if (sum == G) break;
        __builtin_amdgcn_s_sleep(1);
        if ((++sp & 255u) == 0u) { if (xb_ld(&bar[XB_TMO])) break; if (sp > XB_SPIN_CAP) { atomicAdd(&bar[XB_TMO], 1u); break; } }
    }
    nloc = mine > 0u ? mine : 1u; nx = cnt > 0u ? cnt : 1u;
}

__device__ __forceinline__ void xcd_barrier(const XcdBarrier& b) {
    asm volatile("s_waitcnt vmcnt(0)" ::: "memory");
    __syncthreads();
    if (threadIdx.x == 0) {
        unsigned* bar = b.bar;
        __builtin_amdgcn_s_waitcnt(0);
        unsigned nloc = b.st[0], nx = b.st[1];
        if (nloc == 0u) { xcd_barrier_complete(bar, b.x, nloc, nx); b.st[0] = nloc; b.st[1] = nx; }
        const unsigned old = xb_add(&bar[XB_XSUB(b.x)], 1u);
        const unsigned gen = old / nloc;
        if (old + 1u == (gen + 1u) * nloc) {
            __builtin_amdgcn_fence(__ATOMIC_RELEASE, "agent");
            asm volatile("s_waitcnt vmcnt(0)" ::: "memory");
            const unsigned og = xb_add(&bar[XB_TOP], 1u);
            const unsigned tg = og / nx;
            if (og + 1u == (tg + 1u) * nx) xb_add(&bar[XB_TOPGEN], 1u);
            else XB_SPIN(xb_ld(&bar[XB_TOPGEN]) == tg, bar);
            __builtin_amdgcn_fence(__ATOMIC_ACQUIRE, "agent");
            xb_add(&bar[XB_XGEN(b.x)], 1u);
            asm volatile("s_waitcnt vmcnt(0)" ::: "memory");
        } else {
            XB_SPIN(xb_ld(&bar[XB_XGEN(b.x)]) == gen, bar);
            __builtin_amdgcn_fence(__ATOMIC_ACQUIRE, "agent");
            asm volatile("s_waitcnt vmcnt(0)" ::: "memory");
        }
    }
    __syncthreads();
}

constexpr int LDS_BYTES = 147456;
__global__ void __launch_bounds__(512, 2) fwd_mega(Args a) {
    extern __shared__ __attribute__((aligned(16))) unsigned char lds_raw[];
    LAS unsigned char* lds = (LAS unsigned char*)lds_raw;
    cg::grid_group grid = cg::this_grid();
    const int tid = threadIdx.x, lane = tid & 63, wave = __builtin_amdgcn_readfirstlane(tid >> 6);
    const int G = gridDim.x, bid = blockIdx.x;
    unsigned char* ws_k = a.ws;

    {
        unsigned char* ws = ws_k;
        bf16_t* XB = (bf16_t*)(ws + WS_XB);
        float* RS = (float*)(ws + WS_RS);
        LAS float* scr = (LAS float*)(lds + wave * 16896);
        const int gw = bid * 8 + wave, ngw = G * 8;
        for (int l = 0; l < NL; ++l) {
            bf16_t* WL = (bf16_t*)(ws + WS_W + (size_t)l * W_LAYER_BYTES);
            const float* an = a.in[I_ATTN_NORM] + l * D;
            conv_matrix(a.in[I_W_IN] + (size_t)l * D * INCOLS, D, INCOLS, an, WL + W_IN, 1792, 1, 0, scr, gw, ngw, lane);
            conv_matrix(a.in[I_W_IN] + (size_t)l * D * INCOLS, D, INCOLS, an, WL + W_G, 3072, 0, 1696, scr, gw, ngw, lane);
            conv_matrix(a.in[I_W_UQ] + (size_t)l * 256 * 768, 256, 768, a.in[I_QNORM] + l * 256, WL + W_UQ, 768, 2, 0, scr, gw, ngw, lane);
            conv_matrix(a.in[I_W_UKV] + (size_t)l * 128 * 1024, 128, 1024, a.in[I_KVNORM] + l * 128, WL + W_UKV, 1024, 3, 0, scr, gw, ngw, lane);
            conv_matrix(a.in[I_W_MEMKV] + (size_t)l * D * 1024, D, 1024, a.in[I_MEM_NORM] + l * D, WL + W_MEM, 1024, 0, 0, scr, gw, ngw, lane);
            conv_matrix(a.in[I_WO_MLA] + (size_t)l * 512 * D, 512, D, nullptr, WL + W_O, 1024, 0, 0, scr, gw, ngw, lane);
            conv_matrix(a.in[I_WO_SWA] + (size_t)l * 512 * D, 512, D, nullptr, WL + W_O + (size_t)1024 * 512, 1024, 0, 0, scr, gw, ngw, lane);
            conv_matrix(a.in[I_WO_MEM] + (size_t)l * 512 * D, 512, D, nullptr, WL + W_O + (size_t)2 * 1024 * 512, 1024, 0, 0, scr, gw, ngw, lane);
            conv_matrix(a.in[I_W_OUT] + (size_t)l * D * D, D, D, nullptr, WL + W_OUT, 1024, 0, 0, scr, gw, ngw, lane);
            conv_matrix(a.in[I_W_UP] + (size_t)l * D * DFF, D, DFF, a.in[I_MLP_NORM] + l * D, WL + W_UP, 4096, 0, 0, scr, gw, ngw, lane);
            conv_matrix(a.in[I_W_DOWN] + (size_t)l * DFF * D, DFF, D, nullptr, WL + W_DOWN, 1024, 0, 0, scr, gw, ngw, lane);
        }
        for (int m = gw; m < S; m += ngw) { const float ss = row_to_bf16(a.in[I_X] + (size_t)m * D, XB + (size_t)m * D, lane); if (lane == 0) RS[m] = ss; }
        { bf16_t* MEMB = (bf16_t*)(ws + WS_MEMB); float* RSTDM = (float*)(ws + WS_RSTDM);
          for (int m = gw; m < MEML; m += ngw) { const float ss = row_to_bf16(a.in[I_MEM] + (size_t)m * D, MEMB + (size_t)m * D, lane); if (lane == 0) RSTDM[m] = 1.0f / sqrtf(ss * (1.0f / D) + EPS); } }
        const int gt = bid * 512 + tid, ngt = G * 512;
        for (int i = gt; i < 8 * S; i += ngt) RS[S + i] = 0.f;
        { f32x2* ROPE = (f32x2*)(ws + WS_ROPE);
          for (int i = gt; i < S * 16; i += ngt) {
            const int pos = i >> 4, fi = i & 15;
            const float ang = (float)pos * rope_inv(fi);
            const double rev = (double)ang * 0.15915494309189535;
            const float fr = (float)(rev - __builtin_rint(rev));
            f32x2 cs; cs.x = __builtin_amdgcn_cosf(fr); cs.y = __builtin_amdgcn_sinf(fr);
            ROPE[i] = cs;
          } }
        { float* BIAS = (float*)(ws + WS_BIAS);
          for (int i = gt; i < 8 * 128; i += ngt) {
            const int hh = i >> 7, n = i & 127;
            int bucket = n;
            if (n >= 16) { const float lg = __builtin_amdgcn_logf((float)n * 0.0625f) * (16.0f / 3.0f); bucket = 16 + (int)lg; if (bucket > 31) bucket = 31; }
            BIAS[i] = a.in[I_RELB][bucket * 8 + hh] * LOG2E;
          } }
        { float* BG = (float*)(ws + WS_BG); float* SK = (float*)(ws + WS_SINK); float* FN = (float*)(ws + WS_FN);
          for (int i = gt; i < 2 * 3072; i += ngt) BG[i] = a.in[I_B_GATE][i];
          for (int i = gt; i < 16; i += ngt) SK[i] = a.in[I_SINKS][i] * LOG2E;
          for (int i = gt; i < 1024; i += ngt) FN[i] = a.in[I_FNORM][i];
          for (int i = gt; i < 4096; i += ngt) ((unsigned*)(ws + WS_BAR))[i] = 0u;
          if (gt == 0) { unsigned long long* pt = (unsigned long long*)(ws + WS_PTAB); pt[0] = (unsigned long long)(uintptr_t)a.in[I_X]; pt[1] = (unsigned long long)(uintptr_t)a.out; } }
    }
    if (tid < 2) ((volatile LAS unsigned*)(lds + 143360))[tid] = 0u;
    grid.sync();
    const XcdBarrier xbar = xcd_barrier_post((unsigned*)(ws_k + WS_BAR), (volatile LAS unsigned*)(lds + 143360));

    constexpr int NSTEPS = 14 * NL;
    for (int step = 0; step < NSTEPS; ++step) {
        bool do_sync = true;
        const int l = step / 14, k = step % 14;
        unsigned char* ws = ws_k; asm volatile("" : "+s"(ws));
        if (k == 4) {
            int tidv = threadIdx.x; asm volatile("" : "+v"(tidv));
            GAS unsigned char* wsg = (GAS unsigned char*)ws;
            GAS bf16_t* QMLA = (GAS bf16_t*)(wsg + WS_QMLA); GAS bf16_t* KMLA = (GAS bf16_t*)(wsg + WS_KMLA); GAS bf16_t* VMLA = (GAS bf16_t*)(wsg + WS_VMLA); GAS bf16_t* OMLA = (GAS bf16_t*)(wsg + WS_OMLA);
            for (int u = bid; u < 256; u += G) {
                const int hh = u & 7, j = u >> 3;
                for (int kk = 0; kk < 2; ++kk) {
                    const int qb = kk == 0 ? 63 - j : j;
                    attn_unit_pipe<96, 0, true>(lds, QMLA + hh * 96, 768, KMLA + hh * 96, 768, VMLA + (size_t)(hh * 64) * S, S, OMLA + hh * 64, 512, 256 * qb, 0, 4 * (qb + 1), nullptr, 0.f, tidv);
                }
            }
            tidv = threadIdx.x; asm volatile("" : "+v"(tidv));
            GAS bf16_t* QS = (GAS bf16_t*)(wsg + WS_QS); GAS bf16_t* KS = (GAS bf16_t*)(wsg + WS_KS); GAS bf16_t* VS = (GAS bf16_t*)(wsg + WS_VS);
            const GAS float* BIAS = (const GAS float*)(wsg + WS_BIAS); const GAS float* SK = (const GAS float*)(wsg + WS_SINK);
            for (int u = bid; u < 512; u += G) {
                const int hh = u >> 6, qb = u & 63, g = hh >> 2;
                const int tb = 4 * qb - 2 < 0 ? 0 : 4 * qb - 2;
                attn_unit<64, 64, 1>(lds, QS + hh * 64, 512, KS + g * 64, 128, VS + g * 64, 128, QS + hh * 64, 512, 256 * qb, tb, 4 * qb + 4, BIAS + hh * 128, SK[l * 8 + hh], tidv);
            }
            tidv = threadIdx.x; asm volatile("" : "+v"(tidv));
            GAS bf16_t* QM = (GAS bf16_t*)(wsg + WS_QM); GAS bf16_t* KMEM = (GAS bf16_t*)(wsg + WS_KMEM); GAS bf16_t* VMEM = (GAS bf16_t*)(wsg + WS_VMEM);
            for (int u = bid; u < 256; u += G) {
                const int hh = u >> 6, qb = u & 63;
                attn_unit<128, 128, 2>(lds, QM + hh * 128, 512, KMEM + hh * 128, 512, VMEM + hh * 128, 512, QM + hh * 128, 512, 256 * qb, 0, 4, nullptr, 0.f, tidv);
            }
        } else {
            const bf16_t* WL = (const bf16_t*)(ws + WS_W + (size_t)l * W_LAYER_BYTES);
            const bf16_t* XB = (const bf16_t*)(ws + WS_XB);
            pg8::Gemm g{}; Epi E{}; int cid = bid;
            E.ws = ws; E.layer = l;
            switch (k) {
            case 0: g = pg8::Gemm{XB, WL + W_IN, S, 1792, 1024}; E.mode = M_WIN; do_sync = false; break;
            case 1: g = pg8::Gemm{(const bf16_t*)(ws + WS_MEMB), WL + W_MEM, MEML, 1024, 1024}; E.mode = M_MEM; cid = G - 1 - bid; break;
            case 2: g = pg8::Gemm{(const bf16_t*)(ws + WS_CQ), WL + W_UQ, S, 768, 256}; E.mode = M_UQ; do_sync = false; break;
            case 3: g = pg8::Gemm{(const bf16_t*)(ws + WS_CKV), WL + W_UKV, S, 1024, 128}; E.mode = M_UKV; cid = G - 1 - bid; break;
            case 5: case 7: case 9: { const int br = (k - 5) >> 1; g = pg8::Gemm{XB, WL + W_G + (size_t)br * 1024 * 1024, S, 1024, 1024}; E.mode = M_GATE; E.br = br; do_sync = false; } break;
            case 6: case 8: case 10: { const int br = (k - 6) >> 1; const bf16_t* Ab = (const bf16_t*)(ws + (br == 0 ? WS_OMLA : (br == 1 ? WS_QS : WS_QM)));
                    g = pg8::Gemm{Ab, WL + W_O + (size_t)br * 1024 * 512, S, 1024, 512}; E.mode = M_Z; E.br = br; do_sync = (k == 10); } break;
            case 11: g = pg8::Gemm{(const bf16_t*)(ws + WS_YB), WL + W_OUT, S, 1024, 1024}; E.mode = M_RES; E.br = 0; break;
            case 12: g = pg8::Gemm{XB, WL + W_UP, S, 4096, 1024}; E.mode = M_UP; break;
            default: g = pg8::Gemm{(const bf16_t*)(ws + WS_H), WL + W_DOWN, S, 1024, 4096}; E.mode = M_RES; E.br = 1; break;
            }
            pg8::StaticOrder SO; SO.init(g.M, g.N, G, cid);
            pg8::gemm_phase<Epi, pg8::StaticOrder, true, true>(lds, g, SO, E);
        }
        if (do_sync) xcd_barrier(xbar);
    }
    {
        unsigned char* ws = ws_k;
        int tidf = threadIdx.x; asm volatile("" : "+v"(tidf));
        const int lane = tidf & 63, wave = __builtin_amdgcn_readfirstlane(tidf >> 6);
        const int gw = bid * 8 + wave, ngw = G * 8;
        float* X = *(float* const*)(ws + WS_PTAB + 8);
        const float* rsf = (const float*)(ws + WS_RS) + (size_t)(4 * NL) * S;
        const f32x4* gn = (const f32x4*)(ws + WS_FN) + lane;
        for (int m = gw; m < S; m += ngw) {
            f32x4* xr = (f32x4*)(X + (size_t)m * D) + lane;
            const float rstd = 1.0f / sqrtf(rsf[m] * (1.0f / D) + EPS);
#pragma unroll
            for (int j = 0; j < 4; ++j) { f32x4 v = xr[64 * j]; v = v * rstd * gn[64 * j]; xr[64 * j] = v; }
        }
    }
}

extern "C" void kernel_launch(void* const* d_in, const int* in_sizes, int n_in, void* d_out, int out_size, void* d_ws, size_t ws_size, hipStream_t stream) {
    static int grid = 0;
    if (grid == 0) {
        int dev = 0, cus = 0, per_cu = 0;
        (void)hipGetDevice(&dev);
        (void)hipDeviceGetAttribute(&cus, hipDeviceAttributeMultiprocessorCount, dev);
        (void)hipFuncSetAttribute((const void*)fwd_mega, hipFuncAttributeMaxDynamicSharedMemorySize, LDS_BYTES);
        (void)hipOccupancyMaxActiveBlocksPerMultiprocessor(&per_cu, (const void*)fwd_mega, 512, LDS_BYTES);
        if (per_cu < 1) per_cu = 1;
        grid = cus * per_cu;
        if (grid <= 0) grid = 256;
    }
    Args a{};
    for (int i = 0; i < 21; ++i) a.in[i] = (const float*)d_in[i];
    a.out = (float*)d_out; a.ws = (unsigned char*)d_ws;
    void* args[] = {&a};
    hipError_t e = hipLaunchCooperativeKernel((void*)fwd_mega, dim3(grid), dim3(512), args, LDS_BYTES, stream);
    if (e != hipSuccess) fprintf(stderr, "cooperative launch failed: %s (grid %d)\n", hipGetErrorString(e), grid);
}
```

```cpp
#include <hip/hip_runtime.h>
#include <hip/hip_cooperative_groups.h>
#include <cstdio>
#include <cstdint>
namespace cg = cooperative_groups;
namespace pg8 {
#define PG8_LAS __attribute__((address_space(3)))
typedef unsigned short bf16_t;
typedef short bf16x8 __attribute__((ext_vector_type(8)));
typedef float f32x4 __attribute__((ext_vector_type(4)));
typedef unsigned u32x4 __attribute__((ext_vector_type(4)));
constexpr int BM = 256, BK = 64, HALF = 128, HTB = HALF * BK * 2  , STAGE_BYTES = 8 * HTB, NXCD = 8, WGM = 8;

__host__ __device__ __forceinline__ int lds_byte(int r, int c) { const int st = (r >> 4) * 2 + (c >> 5), rr = r & 15, cc = c & 31, ob = rr * 64 + cc * 2; return st * 1024 + (ob ^ (((ob >> 9) & 1) << 5)); }
__host__ __device__ __forceinline__ void stage_rc(int b, int& R, int& C) { const int st = b / 1024, sb = b % 1024, swz = sb ^ (((sb >> 9) & 1) << 5); R = (st >> 1) * 16 + swz / 64; C = (st & 1) * 32 + (swz % 64) / 2; }
__host__ __device__ __forceinline__ int perm32(int rho) { const int n = rho >> 4, i = rho & 15; return 8 * (i >> 2) + 4 * n + (i & 3); }

struct Unit { int pm, pn; };
struct Gemm { const bf16_t* A; const bf16_t* Bt; int M, N, K; };

struct StaticOrder {
    int nM, nN, nwg, G, c;
    __host__ __device__ void init(int M, int N, int G_, int c_) { nM = M / BM; nN = N / BM; nwg = nM * nN; G = G_; c = c_; }
    __host__ __device__ bool next(int i, Unit& u) const {
        const long L = (long)i * G + c; if (L >= nwg) return false;
        int wgid = (int)L; { const int q = nwg / NXCD, r = nwg % NXCD, xcd = wgid % NXCD, off = wgid / NXCD; wgid = (xcd < r ? xcd * (q + 1) : r * (q + 1) + (xcd - r) * q) + off; }
        const int nig = WGM * nN, gid = wgid / nig, fm = gid * WGM, gsz = (nM - fm) < WGM ? (nM - fm) : WGM;
        u.pm = fm + ((wgid % nig) % gsz); u.pn = (wgid % nig) / gsz; return true;
    }
    __device__ __forceinline__ void a_ready(const Unit&) const {}
    __device__ __forceinline__ void done(const Unit&) const {}
};

__device__ __forceinline__ unsigned cvt_pk_bf16(float lo, float hi) { unsigned r; asm volatile("v_cvt_pk_bf16_f32 %0, %1, %2" : "=v"(r) : "v"(lo), "v"(hi)); return r; }
typedef float f32x2 __attribute__((ext_vector_type(2)));
template <class Epi, class Sched, bool ALIGN_EPI = false, bool SP2 = false>
__device__ __forceinline__ void gemm_phase(PG8_LAS unsigned char* lds, const Gemm g, const Sched& S, const Epi& E) {
    int tid_o = threadIdx.x; asm volatile("" : "+v"(tid_o));
    const int tid = tid_o, wid = __builtin_amdgcn_readfirstlane(tid >> 6), lane = tid & 63, wr = wid >> 2, wc = wid & 3, fr = lane & 15, fq = lane >> 4;
    const int K = g.K, nt = K / BK;
    unsigned voffA[2], voffB[2];
#pragma unroll
    for (int i = 0; i < 2; ++i) { int R, C; stage_rc(tid * 16 + i * 8192, R, C); const int Rb = Epi::PERM ? ((R & ~31) + perm32(R & 31)) : R;
        voffA[i] = (unsigned)(R * K + C) * 2u; voffB[i] = (unsigned)(Rb * K + C) * 2u; }
    const size_t kstep = (size_t)(BK * 2);
    const size_t hstep = (size_t)HALF * K * 2;
    const size_t tstep = 2 * hstep;
    const unsigned ldsw = (unsigned)wid * 1024u;
    const int aoff = lds_byte(wr * 64 + fr, fq * 8), boff = lds_byte(wc * 32 + fr, fq * 8);
#define PG8_SA(b, h) (((b) * 2 + (h)) * HTB)
#define PG8_SB(b, h) ((4 + (b) * 2 + (h)) * HTB)
#define PG8_STAGE(bufoff, gbase, voff) do { _Pragma("unroll") for (int _i = 0; _i < 2; ++_i) \
        __builtin_amdgcn_global_load_lds((const unsigned*)((const char*)(gbase) + (voff)[_i]), (PG8_LAS unsigned*)(lds + (bufoff) + ldsw + _i * 8192), 16, 0, 0); } while (0)
#define PG8_LDA(dst, b, h) do { _Pragma("unroll") for (int m = 0; m < 4; ++m) _Pragma("unroll") for (int k = 0; k < 2; ++k) dst[m][k] = *(const PG8_LAS bf16x8*)(lds + PG8_SA(b, h) + aoff + m * 2048 + k * 1024); } while (0)
#define PG8_LDB(dst, b, h) do { _Pragma("unroll") for (int n = 0; n < 2; ++n) _Pragma("unroll") for (int k = 0; k < 2; ++k) dst[n][k] = *(const PG8_LAS bf16x8*)(lds + PG8_SB(b, h) + boff + n * 2048 + k * 1024); } while (0)
#define PG8_MMA(ai, bj, At, Bt) do { __builtin_amdgcn_s_setprio(1); _Pragma("unroll") for (int m = 0; m < 4; ++m) _Pragma("unroll") for (int n = 0; n < 2; ++n) _Pragma("unroll") for (int k = 0; k < 2; ++k) \
        acc[ai][bj][m][n] = __builtin_amdgcn_mfma_f32_16x16x32_bf16(Bt[n][k], At[m][k], acc[ai][bj][m][n], 0, 0, 0); __builtin_amdgcn_s_setprio(0); } while (0)
#define PG8_WAIT_V(n) asm volatile("s_waitcnt vmcnt(" #n ")" ::: "memory")
#define PG8_WAIT_L(n) asm volatile("s_waitcnt lgkmcnt(" #n ")" ::: "memory")
#define PG8_BAR __builtin_amdgcn_s_barrier()
#define PG8_SCHED __builtin_amdgcn_sched_barrier(0)
    Unit cur, nxt; int ui = 0;
    if (!S.next(0, cur)) return;
    f32x4 acc[2][2][4][2];
#pragma unroll
    for (int a = 0; a < 2; ++a)
#pragma unroll
        for (int b = 0; b < 2; ++b)
#pragma unroll
            for (int m = 0; m < 4; ++m)
#pragma unroll
                for (int n = 0; n < 2; ++n) acc[a][b][m][n] = (f32x4){0.f, 0.f, 0.f, 0.f};
    bf16x8 At[4][2], B0[2][2], B1[2][2];
    const char* cA = (const char*)g.A + (size_t)cur.pm * tstep; const char* cB = (const char*)g.Bt + (size_t)cur.pn * tstep;
    S.a_ready(cur);
    if constexpr (SP2) {
        PG8_STAGE(PG8_SB(0, 0), cB, voffB); PG8_STAGE(PG8_SB(0, 1), cB + hstep, voffB); PG8_STAGE(PG8_SA(0, 0), cA, voffA); PG8_STAGE(PG8_SA(0, 1), cA + hstep, voffA);
        if (wr == 1) PG8_BAR;
        PG8_WAIT_V(2); PG8_BAR;
        PG8_STAGE(PG8_SB(1, 0), cB + kstep, voffB); PG8_STAGE(PG8_SA(1, 0), cA + kstep, voffA); PG8_STAGE(PG8_SB(1, 1), cB + hstep + kstep, voffB);
        PG8_WAIT_V(6); PG8_BAR;
    } else {
        PG8_STAGE(PG8_SB(0, 0), cB, voffB); PG8_STAGE(PG8_SA(0, 0), cA, voffA); PG8_STAGE(PG8_SB(0, 1), cB + hstep, voffB); PG8_STAGE(PG8_SA(0, 1), cA + hstep, voffA);
        if (wr == 1) PG8_BAR;
        PG8_WAIT_V(4); PG8_BAR;
        PG8_STAGE(PG8_SB(1, 0), cB + kstep, voffB); PG8_STAGE(PG8_SA(1, 0), cA + kstep, voffA); PG8_STAGE(PG8_SB(1, 1), cB + hstep + kstep, voffB);
        PG8_WAIT_V(6); PG8_BAR;
    }
    for (;;) {
        const bool has_next = S.next(ui + 1, nxt);
        const char* nA = has_next ? (const char*)g.A + (size_t)nxt.pm * tstep : cA; const char* nB = has_next ? (const char*)g.Bt + (size_t)nxt.pn * tstep : cB;
        for (int t = 0; t < nt; t += 2) {
            const bool last = (t == nt - 2);
            const char* a1 = cA + (size_t)(t + 1) * kstep;
            const char* a2 = last ? nA : cA + (size_t)(t + 2) * kstep; const char* b2 = last ? nB : cB + (size_t)(t + 2) * kstep;
            const char* a3 = a2 + kstep; const char* b3 = b2 + kstep;
            if (last && has_next) S.a_ready(nxt);
            if constexpr (SP2) {
            PG8_LDB(B0, 0, 0); PG8_LDB(B1, 0, 1); PG8_SCHED; PG8_LDA(At, 0, 0); PG8_STAGE(PG8_SA(1, 1), a1 + hstep, voffA);
            PG8_WAIT_V(8); PG8_WAIT_L(0); PG8_BAR; PG8_MMA(0, 0, At, B0); PG8_MMA(0, 1, At, B1); PG8_BAR; PG8_SCHED;
            PG8_LDA(At, 0, 1); PG8_STAGE(PG8_SB(0, 0), b2, voffB); PG8_STAGE(PG8_SB(0, 1), b2 + hstep, voffB); PG8_STAGE(PG8_SA(0, 0), a2, voffA);
            PG8_WAIT_V(8); PG8_WAIT_L(0); PG8_BAR; PG8_MMA(1, 0, At, B0); PG8_MMA(1, 1, At, B1); PG8_BAR; PG8_SCHED;
            PG8_LDB(B0, 1, 0); PG8_LDB(B1, 1, 1); PG8_SCHED; PG8_LDA(At, 1, 0); PG8_STAGE(PG8_SA(0, 1), a2 + hstep, voffA);
            PG8_WAIT_V(8); PG8_WAIT_L(0); PG8_BAR; PG8_MMA(0, 0, At, B0); PG8_MMA(0, 1, At, B1); PG8_BAR; PG8_SCHED;
            PG8_LDA(At, 1, 1); PG8_STAGE(PG8_SB(1, 0), b3, voffB); PG8_STAGE(PG8_SB(1, 1), b3 + hstep, voffB); PG8_STAGE(PG8_SA(1, 0), a3, voffA);
            PG8_WAIT_V(8); PG8_WAIT_L(0); PG8_BAR; PG8_MMA(1, 0, At, B0); PG8_MMA(1, 1, At, B1); PG8_BAR; PG8_SCHED;
            } else {
            PG8_LDB(B0, 0, 0); PG8_SCHED; PG8_LDA(At, 0, 0); PG8_STAGE(PG8_SA(1, 1), a1 + hstep, voffA);
            PG8_WAIT_L(8); PG8_BAR; PG8_WAIT_L(0); PG8_MMA(0, 0, At, B0); PG8_BAR; PG8_SCHED;
            PG8_LDB(B1, 0, 1); PG8_STAGE(PG8_SB(0, 0), b2, voffB);
            PG8_BAR; PG8_WAIT_L(0); PG8_MMA(0, 1, At, B1); PG8_BAR;
            PG8_LDA(At, 0, 1); PG8_STAGE(PG8_SA(0, 0), a2, voffA);
            PG8_BAR; PG8_WAIT_L(0); PG8_MMA(1, 0, At, B0); PG8_BAR; PG8_SCHED;
            PG8_STAGE(PG8_SB(0, 1), b2 + hstep, voffB);
            PG8_WAIT_V(6); PG8_BAR; PG8_MMA(1, 1, At, B1); PG8_BAR;
            PG8_LDB(B0, 1, 0); PG8_SCHED; PG8_LDA(At, 1, 0); PG8_STAGE(PG8_SA(0, 1), a2 + hstep, voffA);
            PG8_WAIT_L(8); PG8_BAR; PG8_WAIT_L(0); PG8_MMA(0, 0, At, B0); PG8_BAR; PG8_SCHED;
            PG8_LDB(B1, 1, 1); PG8_STAGE(PG8_SB(1, 0), b3, voffB);
            PG8_BAR; PG8_WAIT_L(0); PG8_MMA(0, 1, At, B1); PG8_BAR;
            PG8_LDA(At, 1, 1); PG8_STAGE(PG8_SA(1, 0), a3, voffA);
            PG8_BAR; PG8_WAIT_L(0); PG8_MMA(1, 0, At, B0); PG8_BAR; PG8_SCHED;
            PG8_STAGE(PG8_SB(1, 1), b3 + hstep, voffB);
            PG8_WAIT_V(6); PG8_BAR; PG8_MMA(1, 1, At, B1); PG8_BAR;
            }
        }
        if constexpr (ALIGN_EPI) { if (wr == 0) PG8_BAR; }
        if constexpr (!Epi::AFTER_DRAIN) { E(acc, cur, wr, wc, fr, fq); S.done(cur); }
        if (!has_next) break;
#pragma unroll
        for (int a = 0; a < 2; ++a)
#pragma unroll
            for (int b = 0; b < 2; ++b)
#pragma unroll
                for (int m = 0; m < 4; ++m)
#pragma unroll
                    for (int n = 0; n < 2; ++n) acc[a][b][m][n] = (f32x4){0.f, 0.f, 0.f, 0.f};
        cur = nxt; cA = nA; cB = nB; ++ui;
        if constexpr (ALIGN_EPI) { if (wr == 1) PG8_BAR; }
    }
    PG8_WAIT_V(0);
    if constexpr (!ALIGN_EPI) { if (wr == 0) PG8_BAR; }
    PG8_BAR;
    if constexpr (Epi::AFTER_DRAIN) { E.fused(acc, cur, wr, wc, fr, fq, lds, wid, lane); S.done(cur); }
#undef PG8_SA
#undef PG8_SB
#undef PG8_STAGE
#undef PG8_LDA
#undef PG8_LDB
#undef PG8_MMA
#undef PG8_WAIT_V
#undef PG8_WAIT_L
#undef PG8_BAR
#undef PG8_SCHED
}
}

typedef unsigned short bf16_t;
typedef short bf16x8 __attribute__((ext_vector_type(8)));
typedef float f32x4 __attribute__((ext_vector_type(4)));
typedef float f32x2 __attribute__((ext_vector_type(2)));
typedef float f32x16 __attribute__((ext_vector_type(16)));
typedef unsigned u32x4 __attribute__((ext_vector_type(4)));
typedef unsigned u32x2 __attribute__((ext_vector_type(2)));
typedef __bf16 bf16x2_t __attribute__((ext_vector_type(2)));
#define LAS __attribute__((address_space(3)))
#define GAS __attribute__((address_space(1)))

constexpr int S = 16384, D = 1024, DFF = 4096, NL = 2, MEML = 256;
constexpr int INCOLS = 4768;
constexpr float EPS = 1e-6f;
constexpr float LOG2E = 1.4426950408889634f;
constexpr float QS_SCALE = 0.125f * LOG2E;
constexpr float QM_SCALE = 0.08838834764831845f * LOG2E;
constexpr float QMLA_SCALE = 0.10206207261596575f * LOG2E;

constexpr size_t W_IN = 0;
constexpr size_t W_G = W_IN + (size_t)1792 * 1024;
constexpr size_t W_UQ = W_G + (size_t)3072 * 1024;
constexpr size_t W_UKV = W_UQ + (size_t)768 * 256;
constexpr size_t W_MEM = W_UKV + (size_t)1024 * 128;
constexpr size_t W_O = W_MEM + (size_t)1024 * 1024;
constexpr size_t W_OUT = W_O + (size_t)3 * 1024 * 512;
constexpr size_t W_UP = W_OUT + (size_t)1024 * 1024;
constexpr size_t W_DOWN = W_UP + (size_t)4096 * 1024;
constexpr size_t W_LAYER_ELEMS = W_DOWN + (size_t)1024 * 4096;
constexpr size_t MiB = 1u << 20;
constexpr size_t W_LAYER_BYTES = 34 * MiB;
static_assert(W_LAYER_ELEMS * 2 <= W_LAYER_BYTES, "weights");
constexpr size_t WS_W = 0;
constexpr size_t WS_XB = 68 * MiB;
constexpr size_t WS_SMALL = 100 * MiB;
constexpr size_t WS_RS = WS_SMALL;
constexpr size_t WS_RSTDM = WS_RS + 9 * (size_t)S * 4;
constexpr size_t WS_BIAS = WS_RSTDM + 1024;
constexpr size_t WS_ROPE = WS_BIAS + 4096;
constexpr size_t WS_MEMB = WS_ROPE + (size_t)S * 16 * 8;
constexpr size_t WS_KMEM = WS_MEMB + (size_t)256 * 1024 * 2;
constexpr size_t WS_VMEM = WS_KMEM + (size_t)256 * 512 * 2;
constexpr size_t WS_PTAB = WS_VMEM + (size_t)256 * 512 * 2;
constexpr size_t WS_BG = WS_PTAB + 64;
constexpr size_t WS_SINK = WS_BG + 2 * 3072 * 4;
constexpr size_t WS_FN = WS_SINK + 64;
constexpr size_t WS_BAR = WS_FN + 4096;
static_assert(WS_BAR + 16384 <= 104 * MiB, "small region");
constexpr size_t WS_H = 104 * MiB;
constexpr size_t WS_QMLA = 104 * MiB;
constexpr size_t WS_KMLA = 128 * MiB;
constexpr size_t WS_VMLA = 152 * MiB;
constexpr size_t WS_QS = 168 * MiB;
constexpr size_t WS_KS = 184 * MiB;
constexpr size_t WS_VS = 188 * MiB;
constexpr size_t WS_QM = 192 * MiB;
constexpr size_t WS_CQ = 208 * MiB;
constexpr size_t WS_CKV = 216 * MiB;
constexpr size_t WS_OMLA = 220 * MiB;
constexpr size_t WS_T = 104 * MiB;
constexpr size_t WS_YB = 136 * MiB;
static_assert(WS_OMLA + (size_t)S * 512 * 2 <= 256 * MiB, "ws");

struct Args {
    const float* in[21];
    float* out; unsigned char* ws;
};
enum { I_X = 0, I_MEM, I_RELB, I_ATTN_NORM, I_MEM_NORM, I_W_IN, I_B_GATE, I_QNORM, I_W_UQ, I_KVNORM, I_W_UKV, I_SINKS, I_W_MEMKV, I_WO_MLA, I_WO_SWA, I_WO_MEM, I_W_OUT, I_MLP_NORM, I_W_UP, I_W_DOWN, I_FNORM };

__device__ __forceinline__ unsigned cvtpk(float lo, float hi) { f32x2 v = {lo, hi}; bf16x2_t b = __builtin_convertvector(v, bf16x2_t); return __builtin_bit_cast(unsigned, b); }
__device__ __forceinline__ float bf_lo(unsigned u) { return __uint_as_float(u << 16); }
__device__ __forceinline__ float bf_hi(unsigned u) { return __uint_as_float(u & 0xffff0000u); }
__device__ __forceinline__ float wave_sum(float v) {
#pragma unroll
    for (int o = 1; o < 64; o <<= 1) v += __shfl_xor(v, o);
    return v;
}

enum { M_WIN = 0, M_MEM, M_UQ, M_UKV, M_GATE, M_Z, M_RES, M_UP };
struct Epi {
    static constexpr bool PERM = true, AFTER_DRAIN = false;
    int mode, br, layer; unsigned char* ws;
    __device__ __forceinline__ void store8(GAS bf16_t* dst, const f32x4& a, const f32x4& b) const {
        u32x4 w; w.x = cvtpk(a[0], a[1]); w.y = cvtpk(a[2], a[3]); w.z = cvtpk(b[0], b[1]); w.w = cvtpk(b[2], b[3]);
        *(GAS u32x4*)dst = w;
    }
    __device__ __forceinline__ float sq8(const f32x4& a0, const f32x4& a1) const { return (a0[0]*a0[0] + a0[1]*a0[1]) + (a0[2]*a0[2] + a0[3]*a0[3]) + (a1[0]*a1[0] + a1[1]*a1[1]) + (a1[2]*a1[2] + a1[3]*a1[3]); }
    __device__ __forceinline__ void operator()(const f32x4 (&acc)[2][2][4][2], const pg8::Unit& u, int wr, int wc, int fr_in, int fq_in) const {
        int fr = fr_in, fq = fq_in; asm volatile("" : "+v"(fr), "+v"(fq));
        const int pn = u.pn;
        GAS unsigned char* wsg = (GAS unsigned char*)ws;
        GAS float* RS = (GAS float*)(wsg + WS_RS);
        const GAS float* rs_in = RS + (size_t)(4 * layer) * S; float inv_k = 1.0f / 1024.0f;
        if (mode == M_MEM) rs_in = (const GAS float*)(wsg + WS_RSTDM);
        if (mode == M_UQ) { rs_in = RS + (size_t)(4 * layer + 1) * S; inv_k = 1.0f / 256.0f; }
        if (mode == M_UKV) { rs_in = RS + (size_t)(4 * layer + 2) * S; inv_k = 1.0f / 128.0f; }
        if (mode == M_UP) rs_in = RS + (size_t)(4 * layer + 3) * S;
        GAS float* rs_out = RS + (size_t)(4 * layer + 1) * S;
        if (mode == M_WIN && pn == 1) rs_out = RS + (size_t)(4 * layer + 2) * S;
        if (mode == M_RES) rs_out = RS + (size_t)(4 * layer + 3 + br) * S;
        const GAS float* resid = nullptr; GAS float* X = nullptr;
        if (mode == M_RES) { X = (GAS float*)*(float* const GAS*)(wsg + WS_PTAB + 8); resid = (layer == 0 && br == 0) ? (const GAS float*)*(const float* const GAS*)(wsg + WS_PTAB) : X; }
#pragma unroll
        for (int ai = 0; ai < 2; ++ai)
#pragma unroll
            for (int m = 0; m < 4; ++m) {
                const int row = u.pm * 256 + ai * 128 + wr * 64 + m * 16 + fr;
                float sc = 1.f;
                if (mode == M_MEM) sc = rs_in[row];
                else if (mode != M_Z && mode != M_RES) sc = __builtin_amdgcn_rsqf(rs_in[row] * inv_k + EPS);
                if (mode == M_UQ) sc *= QMLA_SCALE;
                float ss = 0.f;
#pragma unroll
                for (int bj = 0; bj < 2; ++bj) {
                    const int ct = bj * 128 + wc * 32 + 8 * fq;
                    f32x4 a0 = acc[ai][bj][m][0] * sc, a1 = acc[ai][bj][m][1] * sc;
                    switch (mode) {
                    case M_WIN: {
                        if (pn == 0) { store8((GAS bf16_t*)(wsg + WS_CQ) + (size_t)row * 256 + ct, a0, a1); ss += sq8(a0, a1); }
                        else if (pn == 1) {
                            if (bj == 0) { store8((GAS bf16_t*)(wsg + WS_CKV) + (size_t)row * 128 + ct, a0, a1); ss += sq8(a0, a1); }
                            else if (wc == 0) {
                                const GAS f32x2* cs = (const GAS f32x2*)(wsg + WS_ROPE) + (size_t)row * 16 + 4 * fq;
                                f32x4 o1, o2;
#pragma unroll
                                for (int e = 0; e < 4; ++e) { const f32x2 c = cs[e]; o1[e] = a0[e] * c.x - a1[e] * c.y; o2[e] = a1[e] * c.x + a0[e] * c.y; }
                                u32x2 w1, w2; w1.x = cvtpk(o1[0], o1[1]); w1.y = cvtpk(o1[2], o1[3]); w2.x = cvtpk(o2[0], o2[1]); w2.y = cvtpk(o2[2], o2[3]);
                                GAS bf16_t* kr = (GAS bf16_t*)(wsg + WS_KMLA) + (size_t)row * 768 + 64 + 4 * fq;
#pragma unroll
                                for (int hh = 0; hh < 8; ++hh) { *(GAS u32x2*)(kr + hh * 96) = w1; *(GAS u32x2*)(kr + hh * 96 + 16) = w2; }
                            }
                        }
                        else if (pn < 4) { store8((GAS bf16_t*)(wsg + WS_QS) + (size_t)row * 512 + (pn - 2) * 256 + ct, a0 * QS_SCALE, a1 * QS_SCALE); }
                        else if (pn == 4) { if (bj == 0) store8((GAS bf16_t*)(wsg + WS_KS) + (size_t)row * 128 + ct, a0, a1); else store8((GAS bf16_t*)(wsg + WS_VS) + (size_t)row * 128 + ct - 128, a0, a1); }
                        else { store8((GAS bf16_t*)(wsg + WS_QM) + (size_t)row * 512 + (pn - 5) * 256 + ct, a0 * QM_SCALE, a1 * QM_SCALE); }
                    } break;
                    case M_MEM: {
                        if (pn < 2) store8((GAS bf16_t*)(wsg + WS_KMEM) + (size_t)row * 512 + pn * 256 + ct, a0, a1);
                        else store8((GAS bf16_t*)(wsg + WS_VMEM) + (size_t)row * 512 + (pn - 2) * 256 + ct, a0, a1);
                    } break;
                    case M_UQ: {
                        if (pn < 2) { const int c = pn * 256 + ct; store8((GAS bf16_t*)(wsg + WS_QMLA) + (size_t)row * 768 + (c >> 6) * 96 + (c & 63), a0, a1); }
                        else {
                            const int head = 4 * bj + wc;
                            const GAS f32x2* cs = (const GAS f32x2*)(wsg + WS_ROPE) + (size_t)row * 16 + 4 * fq;
                            f32x4 o1, o2;
#pragma unroll
                            for (int e = 0; e < 4; ++e) { const f32x2 c = cs[e]; o1[e] = a0[e] * c.x - a1[e] * c.y; o2[e] = a1[e] * c.x + a0[e] * c.y; }
                            u32x2 w1, w2; w1.x = cvtpk(o1[0], o1[1]); w1.y = cvtpk(o1[2], o1[3]); w2.x = cvtpk(o2[0], o2[1]); w2.y = cvtpk(o2[2], o2[3]);
                            GAS bf16_t* qrp = (GAS bf16_t*)(wsg + WS_QMLA) + (size_t)row * 768 + head * 96 + 64 + 4 * fq;
                            *(GAS u32x2*)qrp = w1; *(GAS u32x2*)(qrp + 16) = w2;
                        }
                    } break;
                    case M_UKV: {
                        if (pn < 2) { const int c = pn * 256 + ct; store8((GAS bf16_t*)(wsg + WS_KMLA) + (size_t)row * 768 + (c >> 6) * 96 + (c & 63), a0, a1); }
                        else {
                            GAS unsigned short* vt = (GAS unsigned short*)(wsg + WS_VMLA) + (size_t)((pn - 2) * 256 + ct) * S + row;
                            const unsigned w0 = cvtpk(a0[0], a0[1]), w1 = cvtpk(a0[2], a0[3]), w2 = cvtpk(a1[0], a1[1]), w3 = cvtpk(a1[2], a1[3]);
                            vt[0 * (size_t)S] = (unsigned short)(w0 & 0xffffu); vt[1 * (size_t)S] = (unsigned short)(w0 >> 16);
                            vt[2 * (size_t)S] = (unsigned short)(w1 & 0xffffu); vt[3 * (size_t)S] = (unsigned short)(w1 >> 16);
                            vt[4 * (size_t)S] = (unsigned short)(w2 & 0xffffu); vt[5 * (size_t)S] = (unsigned short)(w2 >> 16);
                            vt[6 * (size_t)S] = (unsigned short)(w3 & 0xffffu); vt[7 * (size_t)S] = (unsigned short)(w3 >> 16);
                        }
                    } break;
                    case M_GATE: {
                        const int c = pn * 256 + ct;
                        const GAS float* bg = (const GAS float*)(wsg + WS_BG) + layer * 3072 + br * 1024 + c;
                        const f32x4 b0 = *(const GAS f32x4*)bg, b1 = *(const GAS f32x4*)(bg + 4);
                        f32x4 g0, g1;
#pragma unroll
                        for (int e = 0; e < 4; ++e) { g0[e] = __builtin_amdgcn_rcpf(1.f + __builtin_amdgcn_exp2f(-(a0[e] + b0[e]) * LOG2E)); g1[e] = __builtin_amdgcn_rcpf(1.f + __builtin_amdgcn_exp2f(-(a1[e] + b1[e]) * LOG2E)); }
                        store8((GAS bf16_t*)(wsg + WS_T) + (size_t)row * 1024 + c, g0, g1);
                    } break;
                    case M_Z: {
                        const int c = pn * 256 + ct;
                        const u32x4 t = *(const GAS u32x4*)((GAS bf16_t*)(wsg + WS_T) + (size_t)row * 1024 + c);
                        GAS bf16_t* yp = (GAS bf16_t*)(wsg + WS_YB) + (size_t)row * 1024 + c;
                        f32x4 y0 = {0.f, 0.f, 0.f, 0.f}, y1 = {0.f, 0.f, 0.f, 0.f};
                        if (br > 0) { const u32x4 yo = *(const GAS u32x4*)yp;
                            y0 = (f32x4){bf_lo(yo.x), bf_hi(yo.x), bf_lo(yo.y), bf_hi(yo.y)}; y1 = (f32x4){bf_lo(yo.z), bf_hi(yo.z), bf_lo(yo.w), bf_hi(yo.w)}; }
                        y0 += a0 * (f32x4){bf_lo(t.x), bf_hi(t.x), bf_lo(t.y), bf_hi(t.y)};
                        y1 += a1 * (f32x4){bf_lo(t.z), bf_hi(t.z), bf_lo(t.w), bf_hi(t.w)};
                        store8(yp, y0, y1);
                    } break;
                    case M_RES: {
                        const int c = pn * 256 + ct;
                        const f32x4 x0 = *(const GAS f32x4*)(resid + (size_t)row * 1024 + c) + a0, x1 = *(const GAS f32x4*)(resid + (size_t)row * 1024 + c + 4) + a1;
                        *(GAS f32x4*)(X + (size_t)row * 1024 + c) = x0; *(GAS f32x4*)(X + (size_t)row * 1024 + c + 4) = x1;
                        store8((GAS bf16_t*)(wsg + WS_XB) + (size_t)row * 1024 + c, x0, x1);
                        ss += sq8(x0, x1);
                    } break;
                    default: {
                        f32x4 r0, r1;
#pragma unroll
                        for (int e = 0; e < 4; ++e) { const float v0 = fmaxf(a0[e], 0.f), v1 = fmaxf(a1[e], 0.f); r0[e] = v0 * v0; r1[e] = v1 * v1; }
                        store8((GAS bf16_t*)(wsg + WS_H) + (size_t)row * 4096 + pn * 256 + ct, r0, r1);
                    } break;
                    }
                }
                if (mode == M_RES || (mode == M_WIN && pn < 2)) {
                    ss += __shfl_xor(ss, 16); ss += __shfl_xor(ss, 32);
                    if (fq == 0) __hip_atomic_fetch_add(rs_out + row, ss, __ATOMIC_RELAXED, __HIP_MEMORY_SCOPE_AGENT);
                }
            }
    }
};

__device__ __forceinline__ int crow(int i, int h) { return (i & 3) + 8 * (i >> 2) + 4 * h; }
#define MFMA32(a, b, c) __builtin_amdgcn_mfma_f32_32x32x16_bf16((a), (b), (c), 0, 0, 0)

template <int DQK, int DV, int MODE>
__device__ __forceinline__ void attn_unit(LAS unsigned char* lds, const GAS bf16_t* Q, int qpitch, const GAS bf16_t* K, int kpitch, const GAS bf16_t* V, int vpitch,
                                          GAS bf16_t* O, int opitch, int q0, int t_begin, int t_end, const GAS float* biasrow, float sink_l2, int tid) {
    constexpr int KSTR = (DQK + 8) * 2, VSTR = 144, KBUF = 64 * KSTR, VBUF = DV * VSTR;
    constexpr int NKC = DQK / 8, NKCH = 64 * NKC, KIT = (NKCH + 511) / 512, VIT = DV / 64, NC = DQK / 16, NDB = DV / 32;
    constexpr int OFF_K = 0, OFF_V = 2 * KBUF, OFF_BIAS = 2 * KBUF + 2 * VBUF;
    static_assert(OFF_BIAS + 512 <= 131072, "attention lds");
    const int lane = tid & 63, w = __builtin_amdgcn_readfirstlane(tid >> 6), r = lane & 31, h = lane >> 5;
    const int R0 = q0 + 32 * w;
    LAS float* biasl = (LAS float*)(lds + OFF_BIAS);
    if (MODE == 1) { if (tid < 128) biasl[tid] = biasrow[tid]; }
    bf16x8 qr[NC];
#pragma unroll
    for (int c = 0; c < NC; ++c) qr[c] = *(const GAS bf16x8*)(Q + (size_t)(R0 + r) * qpitch + 16 * c + 8 * h);
    u32x4 kst[KIT], vst[VIT];
    const int vpos = (lane & ~15) | (((lane >> 2) & 1) << 3) | (((lane >> 3) & 1) << 2) | (lane & 3);
#define ATT_LOAD(t) do { \
        _Pragma("unroll") for (int i_ = 0; i_ < KIT; ++i_) { const int c_ = tid + 512 * i_; if (c_ < NKCH) { const int row_ = c_ / NKC, col_ = c_ % NKC; \
            kst[i_] = *(const GAS u32x4*)(K + (size_t)(64 * (t) + row_) * kpitch + col_ * 8); } } \
        _Pragma("unroll") for (int i_ = 0; i_ < VIT; ++i_) vst[i_] = *(const GAS u32x4*)(V + (size_t)(64 * (t) + lane) * vpitch + (w + 8 * i_) * 8); } while (0)
#define ATT_STORE(buf) do { \
        _Pragma("unroll") for (int i_ = 0; i_ < KIT; ++i_) { const int c_ = tid + 512 * i_; if (c_ < NKCH) { const int row_ = c_ / NKC, col_ = c_ % NKC; \
            *(LAS u32x4*)(lds + OFF_K + (buf) * KBUF + row_ * KSTR + col_ * 16) = kst[i_]; } } \
        _Pragma("unroll") for (int i_ = 0; i_ < VIT; ++i_) { LAS unsigned short* vd_ = (LAS unsigned short*)(lds + OFF_V + (buf) * VBUF + ((w + 8 * i_) * 8) * VSTR + vpos * 2); \
            const u32x4 v_ = vst[i_]; \
            vd_[0 * (VSTR / 2)] = (unsigned short)(v_.x & 0xffffu); vd_[1 * (VSTR / 2)] = (unsigned short)(v_.x >> 16); \
            vd_[2 * (VSTR / 2)] = (unsigned short)(v_.y & 0xffffu); vd_[3 * (VSTR / 2)] = (unsigned short)(v_.y >> 16); \
            vd_[4 * (VSTR / 2)] = (unsigned short)(v_.z & 0xffffu); vd_[5 * (VSTR / 2)] = (unsigned short)(v_.z >> 16); \
            vd_[6 * (VSTR / 2)] = (unsigned short)(v_.w & 0xffffu); vd_[7 * (VSTR / 2)] = (unsigned short)(v_.w >> 16); } } while (0)

    float mrun = (MODE == 1) ? sink_l2 : -INFINITY;
    float lrun = (MODE == 1 && h == 0) ? 1.f : 0.f;
    f32x16 o[NDB];
#pragma unroll
    for (int db = 0; db < NDB; ++db)
#pragma unroll
        for (int i = 0; i < 16; ++i) o[db][i] = 0.f;

    ATT_LOAD(t_begin);
    ATT_STORE(0);
    __syncthreads();
    for (int t = t_begin; t < t_end; ++t) {
        const int buf = (t - t_begin) & 1;
        const bool more = (t + 1 < t_end);
        if (more) ATT_LOAD(t + 1);
        bool skip = false;
        if (MODE == 0) skip = (64 * t > R0 + 31);
        if (MODE == 1) skip = (64 * t > R0 + 31) || (64 * t + 63 < R0 - 127);
        if (!skip) {
            f32x16 p0, p1;
#pragma unroll
            for (int i = 0; i < 16; ++i) { p0[i] = 0.f; p1[i] = 0.f; }
            const LAS unsigned char* kp = lds + OFF_K + buf * KBUF + r * KSTR + h * 16;
#pragma unroll
            for (int c = 0; c < NC; ++c) {
                const bf16x8 k0 = *(const LAS bf16x8*)(kp + c * 32);
                const bf16x8 k1 = *(const LAS bf16x8*)(kp + 32 * KSTR + c * 32);
                p0 = MFMA32(k0, qr[c], p0); p1 = MFMA32(k1, qr[c], p1);
            }
            const int qa = R0 + r;
            if (MODE == 0) {
                if (64 * t + 63 > R0) {
#pragma unroll
                    for (int i = 0; i < 16; ++i) { const int kv = 64 * t + crow(i, h); if (kv > qa) p0[i] = -INFINITY; if (kv + 32 > qa) p1[i] = -INFINITY; }
                }
            }
            if (MODE == 1) {
#pragma unroll
                for (int i = 0; i < 16; ++i) { const int d0 = qa - (64 * t + crow(i, h)), d1 = d0 - 32;
                    const float b0 = biasl[d0 & 127], b1 = biasl[d1 & 127];
                    p0[i] = (d0 >= 0 && d0 < 128) ? p0[i] + b0 : -INFINITY; p1[i] = (d1 >= 0 && d1 < 128) ? p1[i] + b1 : -INFINITY; }
            }
            float mx = fmaxf(p0[0], p1[0]);
#pragma unroll
            for (int i = 1; i < 16; ++i) mx = fmaxf(mx, fmaxf(p0[i], p1[i]));
            mx = fmaxf(mx, __shfl_xor(mx, 32));
            const float mnew = fmaxf(mrun, mx);
            const float alpha = __builtin_amdgcn_exp2f(mrun - mnew);
            mrun = mnew;
            float ls = 0.f;
#pragma unroll
            for (int i = 0; i < 16; ++i) { p0[i] = __builtin_amdgcn_exp2f(p0[i] - mnew); p1[i] = __builtin_amdgcn_exp2f(p1[i] - mnew); ls += p0[i] + p1[i]; }
            lrun = lrun * alpha + ls;
#pragma unroll
            for (int db = 0; db < NDB; ++db)
#pragma unroll
                for (int i = 0; i < 16; ++i) o[db][i] *= alpha;
            bf16x8 pa[4];
#pragma unroll
            for (int s = 0; s < 4; ++s) {
                u32x4 pk;
                if (s < 2) { pk.x = cvtpk(p0[8 * s + 0], p0[8 * s + 1]); pk.y = cvtpk(p0[8 * s + 2], p0[8 * s + 3]); pk.z = cvtpk(p0[8 * s + 4], p0[8 * s + 5]); pk.w = cvtpk(p0[8 * s + 6], p0[8 * s + 7]); }
                else { const int s2 = s - 2; pk.x = cvtpk(p1[8 * s2 + 0], p1[8 * s2 + 1]); pk.y = cvtpk(p1[8 * s2 + 2], p1[8 * s2 + 3]); pk.z = cvtpk(p1[8 * s2 + 4], p1[8 * s2 + 5]); pk.w = cvtpk(p1[8 * s2 + 6], p1[8 * s2 + 7]); }
                pa[s] = __builtin_bit_cast(bf16x8, pk);
            }
            const LAS unsigned char* vp = lds + OFF_V + buf * VBUF + r * VSTR + h * 16;
#pragma unroll
            for (int db = 0; db < NDB; ++db)
#pragma unroll
                for (int s = 0; s < 4; ++s) {
                    const bf16x8 vf = *(const LAS bf16x8*)(vp + db * 32 * VSTR + s * 32);
                    o[db] = MFMA32(vf, pa[s], o[db]);
                }
        }
        if (more) ATT_STORE(buf ^ 1);
        __syncthreads();
    }
    lrun += __shfl_xor(lrun, 32);
    const float inv = 1.f / lrun;
    GAS bf16_t* orow = O + (size_t)(R0 + r) * opitch;
#pragma unroll
    for (int db = 0; db < NDB; ++db)
#pragma unroll
        for (int g = 0; g < 4; ++g) {
            u32x2 wv; wv.x = cvtpk(o[db][4 * g + 0] * inv, o[db][4 * g + 1] * inv); wv.y = cvtpk(o[db][4 * g + 2] * inv, o[db][4 * g + 3] * inv);
            *(GAS u32x2*)(orow + 32 * db + 8 * g + 4 * h) = wv;
        }
#undef ATT_LOAD
#undef ATT_STORE
}

constexpr float ATT_THR = 8.0f;
__device__ __forceinline__ float max3f(float a, float b, float c) { return __builtin_fmaxf(__builtin_fmaxf(a, b), c); }
template <int DQK>
__device__ __forceinline__ void att_qk(f32x16& s0, f32x16& s1, const LAS unsigned char* kp, const bf16x8 (&qr)[DQK / 16]) {
    constexpr int NC = DQK / 16, KSTR = (DQK + 8) * 2;
    f32x16 z;
#pragma unroll
    for (int i = 0; i < 16; ++i) z[i] = 0.f;
#pragma unroll
    for (int c = 0; c < NC; ++c) {
        const bf16x8 k0 = *(const LAS bf16x8*)(kp + c * 32);
        const bf16x8 k1 = *(const LAS bf16x8*)(kp + 32 * KSTR + c * 32);
        if (c == 0) { s0 = MFMA32(k0, qr[0], z); s1 = MFMA32(k1, qr[0], z); }
        else { s0 = MFMA32(k0, qr[c], s0); s1 = MFMA32(k1, qr[c], s1); }
    }
}
template <int MODE>
__device__ __forceinline__ void att_pre(f32x16& s0, f32x16& s1, f32x16 (&o)[2], float& mhat, float& lrun, bool& first, int t, int R0, int qa, int h, const LAS float* biasl) {
#pragma unroll
    for (int i = 0; i < 16; ++i) { s0[i] -= mhat; s1[i] -= mhat; }
    if (MODE == 0) {
        if (64 * t + 63 > R0) {
#pragma unroll
            for (int i = 0; i < 16; ++i) { const int kv = 64 * t + crow(i, h); if (kv > qa) s0[i] = -INFINITY; if (kv + 32 > qa) s1[i] = -INFINITY; }
        }
    }
    if (MODE == 1) {
#pragma unroll
        for (int i = 0; i < 16; ++i) { const int d0 = qa - (64 * t + crow(i, h)), d1 = d0 - 32;
            const float b0 = biasl[d0 & 127], b1 = biasl[d1 & 127];
            s0[i] = (d0 >= 0 && d0 < 128) ? s0[i] + b0 : -INFINITY; s1[i] = (d1 >= 0 && d1 < 128) ? s1[i] + b1 : -INFINITY; }
    }
    float a = max3f(s0[0], s0[1], s1[0]), b = max3f(s0[2], s0[3], s1[1]); a = max3f(a, s1[2], s1[3]);
#pragma unroll
    for (int i = 4; i < 16; i += 4) { a = max3f(a, s0[i], s0[i + 1]); b = max3f(b, s0[i + 2], s0[i + 3]); a = max3f(a, s1[i], s1[i + 1]); b = max3f(b, s1[i + 2], s1[i + 3]); }
    float rm = __builtin_fmaxf(a, b);
    { auto rr = __builtin_amdgcn_permlane32_swap(__float_as_uint(rm), __float_as_uint(rm), false, false); rm = __builtin_fmaxf(__uint_as_float(rr[0]), __uint_as_float(rr[1])); }
    if (first || __any(rm > ATT_THR)) {
        const float dl = first ? rm : __builtin_fmaxf(rm, 0.f);
        mhat += dl;
#pragma unroll
        for (int i = 0; i < 16; ++i) { s0[i] -= dl; s1[i] -= dl; }
        if (!first) { const float f = __builtin_amdgcn_exp2f(-dl); lrun *= f;
#pragma unroll
            for (int i = 0; i < 16; ++i) { o[0][i] *= f; o[1][i] *= f; } }
        first = false;
    }
}
__device__ __forceinline__ void att_post_half(f32x16& s, float& lrun, bf16x8& pa0, bf16x8& pa1) {
    float ls = 0.f;
#pragma unroll
    for (int i = 0; i < 16; ++i) { s[i] = __builtin_amdgcn_exp2f(s[i]); ls += s[i]; }
    lrun += ls;
    u32x4 pk; pk.x = cvtpk(s[0], s[1]); pk.y = cvtpk(s[2], s[3]); pk.z = cvtpk(s[4], s[5]); pk.w = cvtpk(s[6], s[7]);
    pa0 = __builtin_bit_cast(bf16x8, pk);
    u32x4 pq; pq.x = cvtpk(s[8], s[9]); pq.y = cvtpk(s[10], s[11]); pq.z = cvtpk(s[12], s[13]); pq.w = cvtpk(s[14], s[15]);
    pa1 = __builtin_bit_cast(bf16x8, pq);
}
__device__ __forceinline__ void att_pv(f32x16 (&o)[2], const bf16x8 (&pa)[4], const LAS unsigned char* vp) {
#pragma unroll
    for (int db = 0; db < 2; ++db)
#pragma unroll
        for (int s = 0; s < 4; ++s) {
            const bf16x8 vf = *(const LAS bf16x8*)(vp + db * 32 * 144 + s * 32);
            o[db] = MFMA32(vf, pa[s], o[db]);
        }
}
template <int DQK, int MODE, bool VT>
__device__ __forceinline__ void attn_unit_pipe(LAS unsigned char* lds, const GAS bf16_t* Q, int qpitch, const GAS bf16_t* K, int kpitch, const GAS bf16_t* V, int vpitch,
                                               GAS bf16_t* O, int opitch, int q0, int t_begin, int t_end, const GAS float* biasrow, float sink_l2, int tid_in) {
    int tid = tid_in; asm volatile("" : "+v"(tid));
    constexpr int DV = 64, KSTR = (DQK + 8) * 2, VSTR = 144, KBUF = 64 * KSTR, VBUF = DV * VSTR;
    constexpr int NKC = DQK / 8, NKCH = 64 * NKC, KIT = (NKCH + 511) / 512, NC = DQK / 16;
    constexpr int OFF_K = 0, OFF_V = 2 * KBUF, OFF_BIAS = 2 * KBUF + 2 * VBUF;
    const int lane = tid & 63, w = __builtin_amdgcn_readfirstlane(tid >> 6), r = lane & 31, h = lane >> 5;
    const int R0 = q0 + 32 * w, qa = R0 + r;
    LAS float* biasl = (LAS float*)(lds + OFF_BIAS);
    if (MODE == 1) { if (tid < 128) biasl[tid] = biasrow[tid]; }
    bf16x8 qr[NC];
#pragma unroll
    for (int c = 0; c < NC; ++c) qr[c] = *(const GAS bf16x8*)(Q + (size_t)(R0 + r) * qpitch + 16 * c + 8 * h);
    u32x4 kstA[KIT], vstA, kstB[KIT], vstB;
    const int vpos = (lane & ~15) | (((lane >> 2) & 1) << 3) | (((lane >> 3) & 1) << 2) | (lane & 3);
#define ATP_LOADK(KST, t) do { \
        _Pragma("unroll") for (int i_ = 0; i_ < KIT; ++i_) { const int c_ = tid + 512 * i_; if (c_ < NKCH) { const int row_ = c_ / NKC, col_ = c_ % NKC; \
            KST[i_] = *(const GAS u32x4*)(K + (size_t)(64 * (t) + row_) * kpitch + col_ * 8); } } } while (0)
#define ATP_LOADV(VST, t) do { if (VT) VST = *(const GAS u32x4*)(V + (size_t)(tid >> 3) * vpitch + 64 * (t) + (tid & 7) * 8); \
        else VST = *(const GAS u32x4*)(V + (size_t)(64 * (t) + lane) * vpitch + w * 8); } while (0)
#define ATP_STOREK(KST, buf) do { \
        _Pragma("unroll") for (int i_ = 0; i_ < KIT; ++i_) { const int c_ = tid + 512 * i_; if (c_ < NKCH) { const int row_ = c_ / NKC, col_ = c_ % NKC; \
            *(LAS u32x4*)(lds + OFF_K + (buf) * KBUF + row_ * KSTR + col_ * 16) = KST[i_]; } } } while (0)
#define ATP_STOREV(VST, buf) do { if (VT) { LAS unsigned char* vt_ = lds + OFF_V + (buf) * VBUF + (tid >> 3) * VSTR + (16 * ((tid & 7) >> 1) + 4 * (tid & 1)) * 2; \
            u32x2 lo_, hi_; lo_.x = VST.x; lo_.y = VST.y; hi_.x = VST.z; hi_.y = VST.w; *(LAS u32x2*)vt_ = lo_; *(LAS u32x2*)(vt_ + 16) = hi_; } else { \
            LAS unsigned short* vd_ = (LAS unsigned short*)(lds + OFF_V + (buf) * VBUF + (w * 8) * VSTR + vpos * 2); \
            vd_[0 * (VSTR / 2)] = (unsigned short)(VST.x & 0xffffu); vd_[1 * (VSTR / 2)] = (unsigned short)(VST.x >> 16); \
            vd_[2 * (VSTR / 2)] = (unsigned short)(VST.y & 0xffffu); vd_[3 * (VSTR / 2)] = (unsigned short)(VST.y >> 16); \
            vd_[4 * (VSTR / 2)] = (unsigned short)(VST.z & 0xffffu); vd_[5 * (VSTR / 2)] = (unsigned short)(VST.z >> 16); \
            vd_[6 * (VSTR / 2)] = (unsigned short)(VST.w & 0xffffu); vd_[7 * (VSTR / 2)] = (unsigned short)(VST.w >> 16); } } while (0)
#define ATP_SKIP(t) ((MODE == 0) ? (64 * (t) > R0 + 31) : ((MODE == 1) ? ((64 * (t) > R0 + 31) || (64 * (t) + 63 < R0 - 127)) : false))

    float mhat = (MODE == 1) ? sink_l2 : 0.f;
    float lrun = (MODE == 1 && h == 0) ? 1.f : 0.f;
    bool first = (MODE != 1);
    f32x16 o[2], sA0, sA1, sB0, sB1; bf16x8 pa[4];
#pragma unroll
    for (int i = 0; i < 16; ++i) { o[0][i] = 0.f; o[1][i] = 0.f; sA0[i] = 0.f; sA1[i] = 0.f; sB0[i] = 0.f; sB1[i] = 0.f; }
    const LAS unsigned char* kbase = lds + OFF_K + r * KSTR + h * 16;
    const LAS unsigned char* vbase = lds + OFF_V + r * VSTR + h * 16;

    ATP_LOADK(kstA, t_begin); ATP_LOADV(vstA, t_begin);
    if (t_begin + 1 < t_end) ATP_LOADK(kstB, t_begin + 1);
    ATP_STOREK(kstA, 0); ATP_STOREV(vstA, 0);
    if (t_begin + 1 < t_end) ATP_STOREK(kstB, 1);
    if (t_begin + 2 < t_end) ATP_LOADK(kstA, t_begin + 2);
    if (t_begin + 1 < t_end) ATP_LOADV(vstA, t_begin + 1);
    __syncthreads();
    if (!ATP_SKIP(t_begin)) att_qk<DQK>(sA0, sA1, kbase, qr);
    __syncthreads();
#define ATP_KF(c, hf) (*(const LAS bf16x8*)(kpn_ + (hf) * 32 * KSTR + (c) * 32))
#define ATP_VF(db, s_) (*(const LAS bf16x8*)(vpc_ + (db) * 32 * 144 + (s_) * 32))
#define ATP_SB() __builtin_amdgcn_sched_barrier(0)
#define ATP_ITER_FAST(C0, C1, N0, N1, KCUR, VCUR, KNXT, VNXT, T) do { \
        const int t_ = (T); const int sc_ = (t_ - t_begin) & 1; \
        const LAS unsigned char* kpn_ = kbase + (sc_ ^ 1) * KBUF; const LAS unsigned char* vpc_ = vbase + sc_ * VBUF; \
          \
        const bf16x8 ka0_ = ATP_KF(0, 0), kb0_ = ATP_KF(0, 1), ka1_ = ATP_KF(1, 0), kb1_ = ATP_KF(1, 1), ka2_ = ATP_KF(2, 0), kb2_ = ATP_KF(2, 1); \
        ATP_LOADK(KNXT, t_ + 3); ATP_LOADV(VNXT, t_ + 2); \
        att_pre<2>(C0, C1, o, mhat, lrun, first, t_, R0, qa, h, biasl); \
        ATP_SB(); \
          \
        const bf16x8 ka3_ = ATP_KF(3, 0), kb3_ = ATP_KF(3, 1), ka4_ = ATP_KF(4, 0), kb4_ = ATP_KF(4, 1), ka5_ = ATP_KF(5, 0), kb5_ = ATP_KF(5, 1); \
        { f32x16 z_; _Pragma("unroll") for (int i_ = 0; i_ < 16; ++i_) z_[i_] = 0.f; N0 = MFMA32(ka0_, qr[0], z_); N1 = MFMA32(kb0_, qr[0], z_); } \
        N0 = MFMA32(ka1_, qr[1], N0); N1 = MFMA32(kb1_, qr[1], N1); \
        N0 = MFMA32(ka2_, qr[2], N0); N1 = MFMA32(kb2_, qr[2], N1); \
        att_post_half(C0, lrun, pa[0], pa[1]); \
        ATP_SB(); \
          \
        const bf16x8 v00_ = ATP_VF(0, 0), v01_ = ATP_VF(0, 1), v10_ = ATP_VF(1, 0), v11_ = ATP_VF(1, 1); \
        const bf16x8 v02_ = ATP_VF(0, 2), v03_ = ATP_VF(0, 3), v12_ = ATP_VF(1, 2), v13_ = ATP_VF(1, 3); \
        N0 = MFMA32(ka3_, qr[3], N0); N1 = MFMA32(kb3_, qr[3], N1); \
        N0 = MFMA32(ka4_, qr[4], N0); N1 = MFMA32(kb4_, qr[4], N1); \
        N0 = MFMA32(ka5_, qr[5], N0); N1 = MFMA32(kb5_, qr[5], N1); \
        o[0] = MFMA32(v00_, pa[0], o[0]); o[1] = MFMA32(v10_, pa[0], o[1]); \
        o[0] = MFMA32(v01_, pa[1], o[0]); o[1] = MFMA32(v11_, pa[1], o[1]); \
        att_post_half(C1, lrun, pa[2], pa[3]); \
        ATP_SB(); \
          \
        o[0] = MFMA32(v02_, pa[2], o[0]); o[1] = MFMA32(v12_, pa[2], o[1]); \
        o[0] = MFMA32(v03_, pa[3], o[0]); o[1] = MFMA32(v13_, pa[3], o[1]); \
        ATP_STOREK(KCUR, sc_); ATP_STOREV(VCUR, sc_ ^ 1); \
        ATP_SB(); asm volatile("s_waitcnt lgkmcnt(0)\n\ts_barrier" ::: "memory"); ATP_SB(); } while (0)
#define ATP_ITER_GEN(C0, C1, N0, N1, KCUR, VCUR, KNXT, VNXT, T) do { \
        const int t_ = (T); const bool m1_ = (t_ + 1 < t_end), m2_ = (t_ + 2 < t_end), m3_ = (t_ + 3 < t_end); \
        if (m3_) ATP_LOADK(KNXT, t_ + 3); if (m2_) ATP_LOADV(VNXT, t_ + 2); \
        const bool sk_ = ATP_SKIP(t_), skn_ = !m1_ || ATP_SKIP(t_ + 1); \
        const int sc_ = (t_ - t_begin) & 1; \
        const LAS unsigned char* kpn_ = kbase + (sc_ ^ 1) * KBUF; const LAS unsigned char* vpc_ = vbase + sc_ * VBUF; \
        if (!sk_) att_pre<MODE>(C0, C1, o, mhat, lrun, first, t_, R0, qa, h, biasl); \
        if (!skn_) att_qk<DQK>(N0, N1, kpn_, qr); \
        if (!sk_) { att_post_half(C0, lrun, pa[0], pa[1]); att_post_half(C1, lrun, pa[2], pa[3]); att_pv(o, pa, vpc_); } \
        if (m2_) ATP_STOREK(KCUR, sc_); if (m1_) ATP_STOREV(VCUR, sc_ ^ 1); \
        ATP_SB(); asm volatile("s_waitcnt lgkmcnt(0)\n\ts_barrier" ::: "memory"); ATP_SB(); } while (0)
    int t = t_begin;
    if (MODE == 0) {
        const int n_fast = (q0 >> 6) - 1;
        for (; t + 1 < n_fast; t += 2) { ATP_ITER_FAST(sA0, sA1, sB0, sB1, kstA, vstA, kstB, vstB, t); ATP_ITER_FAST(sB0, sB1, sA0, sA1, kstB, vstB, kstA, vstA, t + 1); }
    }
    for (; t < t_end; ++t) {
        ATP_ITER_GEN(sA0, sA1, sB0, sB1, kstA, vstA, kstB, vstB, t);
        sA0 = sB0; sA1 = sB1; vstA = vstB;
#pragma unroll
        for (int i_ = 0; i_ < KIT; ++i_) kstA[i_] = kstB[i_];
    }

    { auto rr = __builtin_amdgcn_permlane32_swap(__float_as_uint(lrun), __float_as_uint(lrun), false, false); lrun = __uint_as_float(rr[0]) + __uint_as_float(rr[1]); }
    const float inv = 1.f / lrun;
    GAS bf16_t* orow = O + (size_t)(R0 + r) * opitch;
#pragma unroll
    for (int db = 0; db < 2; ++db)
#pragma unroll
        for (int g = 0; g < 4; ++g) {
            u32x2 wv; wv.x = cvtpk(o[db][4 * g + 0] * inv, o[db][4 * g + 1] * inv); wv.y = cvtpk(o[db][4 * g + 2] * inv, o[db][4 * g + 3] * inv);
            *(GAS u32x2*)(orow + 32 * db + 8 * g + 4 * h) = wv;
        }
#undef ATP_LOADK
#undef ATP_LOADV
#undef ATP_STOREK
#undef ATP_STOREV
#undef ATP_SKIP
#undef ATP_ITER_FAST
#undef ATP_ITER_GEN
#undef ATP_KF
#undef ATP_VF
#undef ATP_SB
}

__device__ __forceinline__ int map_col(int kind, int off, int n) {
    switch (kind) {
    case 1: {
        if (n < 256) return n;
        if (n < 512) { const int j = n - 256; if (j < 128) return 256 + j; if (j < 160) { const int p = j - 128; return 384 + 16 * ((p >> 2) & 1) + 4 * (p >> 3) + (p & 3); } return -1; }
        if (n < 1024) return 416 + (n - 512);
        if (n < 1280) return 928 + (n - 1024);
        return 1184 + (n - 1280);
    }
    case 2: {
        if (n < 512) return (n >> 6) * 96 + (n & 63);
        const int j = n - 512, hd = j >> 5, p = j & 31; return hd * 96 + 64 + 16 * ((p >> 2) & 1) + 4 * (p >> 3) + (p & 3);
    }
    case 3: {
        if (n < 512) return (n >> 6) * 128 + (n & 63);
        const int j = n - 512; return (j >> 6) * 128 + 64 + (j & 63);
    }
    default: return off + n;
    }
}
__device__ __forceinline__ void conv_item(const float* W, int K, int Nsrc, const float* gain, bf16_t* WT, int Ndst, int kind, int off, LAS float* scr, int it, int lane) {
    const int nblk = Ndst / 64;
    const int kq = lane >> 4, n4 = lane & 15;
    const int kb = it / nblk, nb = it % nblk, k0 = 64 * kb, n0 = 64 * nb;
    const int src = map_col(kind, off, n0 + 4 * n4);
    f32x4 v[16];
#pragma unroll
    for (int i = 0; i < 16; ++i) { v[i] = (f32x4){0.f, 0.f, 0.f, 0.f}; if (src >= 0) v[i] = *(const f32x4*)(W + (size_t)(k0 + 4 * i + kq) * Nsrc + src); }
    if (gain) {
#pragma unroll
        for (int i = 0; i < 16; ++i) v[i] = v[i] * gain[k0 + 4 * i + kq];
    }
#pragma unroll
    for (int i = 0; i < 16; ++i) { LAS float* d = scr + (4 * i + kq) * 65 + 4 * n4; d[0] = v[i][0]; d[1] = v[i][1]; d[2] = v[i][2]; d[3] = v[i][3]; }
    asm volatile("s_waitcnt lgkmcnt(0)" ::: "memory");
    const int c = lane & 7;
#pragma unroll
    for (int j = 0; j < 8; ++j) { const int n = (lane >> 3) + 8 * j; const LAS float* sp = scr + (8 * c) * 65 + n;
        u32x4 o; o.x = cvtpk(sp[0 * 65], sp[1 * 65]); o.y = cvtpk(sp[2 * 65], sp[3 * 65]); o.z = cvtpk(sp[4 * 65], sp[5 * 65]); o.w = cvtpk(sp[6 * 65], sp[7 * 65]);
        *(u32x4*)(WT + (size_t)(n0 + n) * K + k0 + 8 * c) = o; }
    asm volatile("s_waitcnt lgkmcnt(0)" ::: "memory");
}
__device__ __forceinline__ float row_to_bf16(const float* xrow, bf16_t* orow, int lane) {
    const f32x4* xr = (const f32x4*)xrow + lane;
    f32x4 v[4]; float s = 0.f;
#pragma unroll
    for (int j = 0; j < 4; ++j) { v[j] = xr[64 * j]; s += (v[j][0] * v[j][0] + v[j][1] * v[j][1]) + (v[j][2] * v[j][2] + v[j][3] * v[j][3]); }
    u32x2* o8 = (u32x2*)orow + lane;
#pragma unroll
    for (int j = 0; j < 4; ++j) { u32x2 wv; wv.x = cvtpk(v[j][0], v[j][1]); wv.y = cvtpk(v[j][2], v[j][3]); o8[64 * j] = wv; }
    return wave_sum(s);
}
__device__ __forceinline__ float rope_inv(int i) {
    const float t[16] = {1.000000000e+00f, 5.623413324e-01f, 3.162277639e-01f, 1.778279394e-01f, 1.000000015e-01f, 5.623412877e-02f, 3.162277862e-02f, 1.778279431e-02f,
                         9.999999776e-03f, 5.623413250e-03f, 3.162277862e-03f, 1.778279431e-03f, 1.000000047e-03f, 5.623413017e-04f, 3.162277862e-04f, 1.778279402e-04f};
    float r = t[0];
#pragma unroll
    for (int k = 1; k < 16; ++k) r = (i == k) ? t[k] : r;
    return r;
}

#define XB_TMO      128
#define XB_XCNT(j)  (256  + 64 * (j))
#define XB_XSUB(j)  (1280 + 64 * (j))
#define XB_XGEN(j)  (2304 + 64 * (j))
#define XB_TOP      3328
#define XB_TOPGEN   3392
#define XCD_BAR_WORDS 3456
#define XB_SPIN_CAP (1u << 18)

__device__ __forceinline__ unsigned xb_ld(unsigned* p)              { return __hip_atomic_load(p, __ATOMIC_RELAXED, __HIP_MEMORY_SCOPE_AGENT); }
__device__ __forceinline__ unsigned xb_add(unsigned* p, unsigned v) { return __hip_atomic_fetch_add(p, v, __ATOMIC_RELAXED, __HIP_MEMORY_SCOPE_AGENT); }
__device__ __forceinline__ unsigned xb_xcc_id() { return (unsigned)__builtin_amdgcn_s_getreg((3 << 11) | 20) & 0xFu; }
#define XB_SPIN(cond, bar) do { unsigned _sp = 0; while (cond) { __builtin_amdgcn_s_sleep(1); \
    if ((++_sp & 255u) == 0u) { if (xb_ld(&(bar)[XB_TMO])) break; if (_sp > XB_SPIN_CAP) { atomicAdd(&(bar)[XB_TMO], 1u); break; } } } } while (0)

struct XcdBarrier {
    unsigned* bar; unsigned x;
    volatile LAS unsigned* st;
};

__device__ __forceinline__ XcdBarrier xcd_barrier_post(unsigned* bar, volatile LAS unsigned* st) {
    XcdBarrier b; b.bar = bar; b.x = xb_xcc_id(); b.st = st;
    if (threadIdx.x == 0) (void)xb_add(&bar[XB_XCNT(b.x)], 1u);
    return b;
}
__device__ __forceinline__ void xcd_barrier_complete(unsigned* bar, unsigned x, unsigned& nloc, unsigned& nx) {
    const unsigned G = gridDim.x * gridDim.y * gridDim.z;
    unsigned sum, cnt, mine, sp = 0u;
    for (;;) {
        sum = 0u; cnt = 0u; mine = 0u;
#pragma unroll
        for (unsigned j = 0; j < 16; ++j) { const unsigned c = xb_ld(&bar[XB_XCNT(j)]); sum += c; cnt += (c > 0u) ? 1u : 0u; mine = (j == x) ? c : mine; }
        if (sum == G) break;
        __builtin_amdgcn_s_sleep(1);
        if ((++sp & 255u) == 0u) { if (xb_ld(&bar[XB_TMO])) break; if (sp > XB_SPIN_CAP) { atomicAdd(&bar[XB_TMO], 1u); break; } }
    }
    nloc = mine > 0u ? mine : 1u; nx = cnt > 0u ? cnt : 1u;
}

__device__ __forceinline__ void xcd_barrier(const XcdBarrier& b) {
    asm volatile("s_waitcnt vmcnt(0)" ::: "memory");
    __syncthreads();
    if (threadIdx.x == 0) {
        unsigned* bar = b.bar;
        __builtin_amdgcn_s_waitcnt(0);
        unsigned nloc = b.st[0], nx = b.st[1];
        if (nloc == 0u) { xcd_barrier_complete(bar, b.x, nloc, nx); b.st[0] = nloc; b.st[1] = nx; }
        const unsigned old = xb_add(&bar[XB_XSUB(b.x)], 1u);
        const unsigned gen = old / nloc;
        if (old + 1u == (gen + 1u) * nloc) {
            __builtin_amdgcn_fence(__ATOMIC_RELEASE, "agent");
            asm volatile("s_waitcnt vmcnt(0)" ::: "memory");
            const unsigned og = xb_add(&bar[XB_TOP], 1u);
            const unsigned tg = og / nx;
            if (og + 1u == (tg + 1u) * nx) xb_add(&bar[XB_TOPGEN], 1u);
            else XB_SPIN(xb_ld(&bar[XB_TOPGEN]) == tg, bar);
            __builtin_amdgcn_fence(__ATOMIC_ACQUIRE, "agent");
            xb_add(&bar[XB_XGEN(b.x)], 1u);
            asm volatile("s_waitcnt vmcnt(0)" ::: "memory");
        } else {
            XB_SPIN(xb_ld(&bar[XB_XGEN(b.x)]) == gen, bar);
            __builtin_amdgcn_fence(__ATOMIC_ACQUIRE, "agent");
            asm volatile("s_waitcnt vmcnt(0)" ::: "memory");
        }
    }
    __syncthreads();
}

constexpr int LDS_BYTES = 147456;
__global__ void __launch_bounds__(512, 2) fwd_mega(Args a) {
    extern __shared__ __attribute__((aligned(16))) unsigned char lds_raw[];
    LAS unsigned char* lds = (LAS unsigned char*)lds_raw;
    cg::grid_group grid = cg::this_grid();
    const int tid = threadIdx.x, lane = tid & 63, wave = __builtin_amdgcn_readfirstlane(tid >> 6);
    const int G = gridDim.x, bid = blockIdx.x;
    unsigned char* ws_k = a.ws;

    {
        unsigned char* ws = ws_k;
        bf16_t* XB = (bf16_t*)(ws + WS_XB);
        float* RS = (float*)(ws + WS_RS);
        LAS float* scr = (LAS float*)(lds + wave * 16896);
        const int gw = bid * 8 + wave, ngw = G * 8;
        constexpr int IT_WG = 448, IT_UQ = 1216, IT_UKV = 1264, IT_MEM = 1296, IT_O0 = 1552, IT_O1 = 1680, IT_O2 = 1808, IT_OUT = 1936, IT_UP = 2192, IT_DOWN = 3216, IT_LAYER = 4240;
        for (int itg = gw; itg < NL * IT_LAYER; itg += ngw) {
            const int l = itg / IT_LAYER, r = itg % IT_LAYER;
            bf16_t* WL = (bf16_t*)(ws + WS_W + (size_t)l * W_LAYER_BYTES);
            const float* Wp; const float* gp = nullptr; bf16_t* Dp; int Kk, Ns, Nd, kind = 0, off = 0, it;
            if (r < IT_WG)        { it = r;           Wp = a.in[I_W_IN] + (size_t)l * D * INCOLS; Kk = D; Ns = INCOLS; gp = a.in[I_ATTN_NORM] + l * D; Dp = WL + W_IN; Nd = 1792; kind = 1; }
            else if (r < IT_UQ)   { it = r - IT_WG;   Wp = a.in[I_W_IN] + (size_t)l * D * INCOLS; Kk = D; Ns = INCOLS; gp = a.in[I_ATTN_NORM] + l * D; Dp = WL + W_G; Nd = 3072; off = 1696; }
            else if (r < IT_UKV)  { it = r - IT_UQ;   Wp = a.in[I_W_UQ] + (size_t)l * 256 * 768; Kk = 256; Ns = 768; gp = a.in[I_QNORM] + l * 256; Dp = WL + W_UQ; Nd = 768; kind = 2; }
            else if (r < IT_MEM)  { it = r - IT_UKV;  Wp = a.in[I_W_UKV] + (size_t)l * 128 * 1024; Kk = 128; Ns = 1024; gp = a.in[I_KVNORM] + l * 128; Dp = WL + W_UKV; Nd = 1024; kind = 3; }
            else if (r < IT_O0)   { it = r - IT_MEM;  Wp = a.in[I_W_MEMKV] + (size_t)l * D * 1024; Kk = D; Ns = 1024; gp = a.in[I_MEM_NORM] + l * D; Dp = WL + W_MEM; Nd = 1024; }
            else if (r < IT_O1)   { it = r - IT_O0;   Wp = a.in[I_WO_MLA] + (size_t)l * 512 * D; Kk = 512; Ns = D; Dp = WL + W_O; Nd = 1024; }
            else if (r < IT_O2)   { it = r - IT_O1;   Wp = a.in[I_WO_SWA] + (size_t)l * 512 * D; Kk = 512; Ns = D; Dp = WL + W_O + (size_t)1024 * 512; Nd = 1024; }
            else if (r < IT_OUT)  { it = r - IT_O2;   Wp = a.in[I_WO_MEM] + (size_t)l * 512 * D; Kk = 512; Ns = D; Dp = WL + W_O + (size_t)2 * 1024 * 512; Nd = 1024; }
            else if (r < IT_UP)   { it = r - IT_OUT;  Wp = a.in[I_W_OUT] + (size_t)l * D * D; Kk = D; Ns = D; Dp = WL + W_OUT; Nd = 1024; }
            else if (r < IT_DOWN) { it = r - IT_UP;   Wp = a.in[I_W_UP] + (size_t)l * D * DFF; Kk = D; Ns = DFF; gp = a.in[I_MLP_NORM] + l * D; Dp = WL + W_UP; Nd = 4096; }
            else                  { it = r - IT_DOWN; Wp = a.in[I_W_DOWN] + (size_t)l * DFF * D; Kk = DFF; Ns = D; Dp = WL + W_DOWN; Nd = 1024; }
            conv_item(Wp, Kk, Ns, gp, Dp, Nd, kind, off, scr, it, lane);
        }
        for (int m = gw; m < S; m += ngw) { const float ss = row_to_bf16(a.in[I_X] + (size_t)m * D, XB + (size_t)m * D, lane); if (lane == 0) RS[m] = ss; }
        { bf16_t* MEMB = (bf16_t*)(ws + WS_MEMB); float* RSTDM = (float*)(ws + WS_RSTDM);
          for (int m = gw; m < MEML; m += ngw) { const float ss = row_to_bf16(a.in[I_MEM] + (size_t)m * D, MEMB + (size_t)m * D, lane); if (lane == 0) RSTDM[m] = 1.0f / sqrtf(ss * (1.0f / D) + EPS); } }
        const int gt = bid * 512 + tid, ngt = G * 512;
        for (int i = gt; i < 8 * S; i += ngt) RS[S + i] = 0.f;
        { f32x2* ROPE = (f32x2*)(ws + WS_ROPE);
          for (int i = gt; i < S * 16; i += ngt) {
            const int pos = i >> 4, fi = i & 15;
            const float ang = (float)pos * rope_inv(fi);
            const double rev = (double)ang * 0.15915494309189535;
            const float fr = (float)(rev - __builtin_rint(rev));
            f32x2 cs; cs.x = __builtin_amdgcn_cosf(fr); cs.y = __builtin_amdgcn_sinf(fr);
            ROPE[i] = cs;
          } }
        { float* BIAS = (float*)(ws + WS_BIAS);
          for (int i = gt; i < 8 * 128; i += ngt) {
            const int hh = i >> 7, n = i & 127;
            int bucket = n;
            if (n >= 16) { const float lg = __builtin_amdgcn_logf((float)n * 0.0625f) * (16.0f / 3.0f); bucket = 16 + (int)lg; if (bucket > 31) bucket = 31; }
            BIAS[i] = a.in[I_RELB][bucket * 8 + hh] * LOG2E;
          } }
        { float* BG = (float*)(ws + WS_BG); float* SK = (float*)(ws + WS_SINK); float* FN = (float*)(ws + WS_FN);
          for (int i = gt; i < 2 * 3072; i += ngt) BG[i] = a.in[I_B_GATE][i];
          for (int i = gt; i < 16; i += ngt) SK[i] = a.in[I_SINKS][i] * LOG2E;
          for (int i = gt; i < 1024; i += ngt) FN[i] = a.in[I_FNORM][i];
          for (int i = gt; i < 4096; i += ngt) ((unsigned*)(ws + WS_BAR))[i] = 0u;
          if (gt == 0) { unsigned long long* pt = (unsigned long long*)(ws + WS_PTAB); pt[0] = (unsigned long long)(uintptr_t)a.in[I_X]; pt[1] = (unsigned long long)(uintptr_t)a.out; } }
    }
    if (tid < 2) ((volatile LAS unsigned*)(lds + 143360))[tid] = 0u;
    grid.sync();
    const XcdBarrier xbar = xcd_barrier_post((unsigned*)(ws_k + WS_BAR), (volatile LAS unsigned*)(lds + 143360));

    constexpr int NSTEPS = 14 * NL;
    for (int step = 0; step < NSTEPS; ++step) {
        bool do_sync = true;
        const int l = step / 14, k = step % 14;
        unsigned char* ws = ws_k; asm volatile("" : "+s"(ws));
        if (k == 4) {
            int tidv = threadIdx.x; asm volatile("" : "+v"(tidv));
            GAS unsigned char* wsg = (GAS unsigned char*)ws;
            GAS bf16_t* QMLA = (GAS bf16_t*)(wsg + WS_QMLA); GAS bf16_t* KMLA = (GAS bf16_t*)(wsg + WS_KMLA); GAS bf16_t* VMLA = (GAS bf16_t*)(wsg + WS_VMLA); GAS bf16_t* OMLA = (GAS bf16_t*)(wsg + WS_OMLA);
            for (int u = bid; u < 256; u += G) {
                const int hh = u & 7, j = u >> 3;
                for (int kk = 0; kk < 2; ++kk) {
                    const int qb = kk == 0 ? 63 - j : j;
                    attn_unit_pipe<96, 0, true>(lds, QMLA + hh * 96, 768, KMLA + hh * 96, 768, VMLA + (size_t)(hh * 64) * S, S, OMLA + hh * 64, 512, 256 * qb, 0, 4 * (qb + 1), nullptr, 0.f, tidv);
                }
            }
            tidv = threadIdx.x; asm volatile("" : "+v"(tidv));
            GAS bf16_t* QS = (GAS bf16_t*)(wsg + WS_QS); GAS bf16_t* KS = (GAS bf16_t*)(wsg + WS_KS); GAS bf16_t* VS = (GAS bf16_t*)(wsg + WS_VS);
            const GAS float* BIAS = (const GAS float*)(wsg + WS_BIAS); const GAS float* SK = (const GAS float*)(wsg + WS_SINK);
            for (int u = bid; u < 512; u += G) {
                const int hh = u >> 6, qb = u & 63, g = hh >> 2;
                const int tb = 4 * qb - 2 < 0 ? 0 : 4 * qb - 2;
                attn_unit<64, 64, 1>(lds, QS + hh * 64, 512, KS + g * 64, 128, VS + g * 64, 128, QS + hh * 64, 512, 256 * qb, tb, 4 * qb + 4, BIAS + hh * 128, SK[l * 8 + hh], tidv);
            }
            tidv = threadIdx.x; asm volatile("" : "+v"(tidv));
            GAS bf16_t* QM = (GAS bf16_t*)(wsg + WS_QM); GAS bf16_t* KMEM = (GAS bf16_t*)(wsg + WS_KMEM); GAS bf16_t* VMEM = (GAS bf16_t*)(wsg + WS_VMEM);
            for (int u = bid; u < 256; u += G) {
                const int hh = u >> 6, qb = u & 63;
                attn_unit<128, 128, 2>(lds, QM + hh * 128, 512, KMEM + hh * 128, 512, VMEM + hh * 128, 512, QM + hh * 128, 512, 256 * qb, 0, 4, nullptr, 0.f, tidv);
            }
        } else {
            const bf16_t* WL = (const bf16_t*)(ws + WS_W + (size_t)l * W_LAYER_BYTES);
            const bf16_t* XB = (const bf16_t*)(ws + WS_XB);
            pg8::Gemm g{}; Epi E{}; int cid = bid;
            E.ws = ws; E.layer = l;
            switch (k) {
            case 0: g = pg8::Gemm{XB, WL + W_IN, S, 1792, 1024}; E.mode = M_WIN; do_sync = false; break;
            case 1: g = pg8::Gemm{(const bf16_t*)(ws + WS_MEMB), WL + W_MEM, MEML, 1024, 1024}; E.mode = M_MEM; cid = G - 1 - bid; break;
            case 2: g = pg8::Gemm{(const bf16_t*)(ws + WS_CQ), WL + W_UQ, S, 768, 256}; E.mode = M_UQ; do_sync = false; break;
            case 3: g = pg8::Gemm{(const bf16_t*)(ws + WS_CKV), WL + W_UKV, S, 1024, 128}; E.mode = M_UKV; cid = G - 1 - bid; break;
            case 5: case 7: case 9: { const int br = (k - 5) >> 1; g = pg8::Gemm{XB, WL + W_G + (size_t)br * 1024 * 1024, S, 1024, 1024}; E.mode = M_GATE; E.br = br; do_sync = false; } break;
            case 6: case 8: case 10: { const int br = (k - 6) >> 1; const bf16_t* Ab = (const bf16_t*)(ws + (br == 0 ? WS_OMLA : (br == 1 ? WS_QS : WS_QM)));
                    g = pg8::Gemm{Ab, WL + W_O + (size_t)br * 1024 * 512, S, 1024, 512}; E.mode = M_Z; E.br = br; do_sync = (k == 10); } break;
            case 11: g = pg8::Gemm{(const bf16_t*)(ws + WS_YB), WL + W_OUT, S, 1024, 1024}; E.mode = M_RES; E.br = 0; break;
            case 12: g = pg8::Gemm{XB, WL + W_UP, S, 4096, 1024}; E.mode = M_UP; break;
            default: g = pg8::Gemm{(const bf16_t*)(ws + WS_H), WL + W_DOWN, S, 1024, 4096}; E.mode = M_RES; E.br = 1; break;
            }
            pg8::StaticOrder SO; SO.init(g.M, g.N, G, cid);
            pg8::gemm_phase<Epi, pg8::StaticOrder, true, true>(lds, g, SO, E);
        }
        if (do_sync) xcd_barrier(xbar);
    }
    {
        unsigned char* ws = ws_k;
        int tidf = threadIdx.x; asm volatile("" : "+v"(tidf));
        const int lane = tidf & 63, wave = __builtin_amdgcn_readfirstlane(tidf >> 6);
        const int gw = bid * 8 + wave, ngw = G * 8;
        float* X = *(float* const*)(ws + WS_PTAB + 8);
        const float* rsf = (const float*)(ws + WS_RS) + (size_t)(4 * NL) * S;
        const f32x4* gn = (const f32x4*)(ws + WS_FN) + lane;
        for (int m = gw; m < S; m += ngw) {
            f32x4* xr = (f32x4*)(X + (size_t)m * D) + lane;
            const float rstd = 1.0f / sqrtf(rsf[m] * (1.0f / D) + EPS);
#pragma unroll
            for (int j = 0; j < 4; ++j) { f32x4 v = xr[64 * j]; v = v * rstd * gn[64 * j]; xr[64 * j] = v; }
        }
    }
}

extern "C" void kernel_launch(void* const* d_in, const int* in_sizes, int n_in, void* d_out, int out_size, void* d_ws, size_t ws_size, hipStream_t stream) {
    static int grid = 0;
    if (grid == 0) {
        int dev = 0, cus = 0, per_cu = 0;
        (void)hipGetDevice(&dev);
        (void)hipDeviceGetAttribute(&cus, hipDeviceAttributeMultiprocessorCount, dev);
        (void)hipFuncSetAttribute((const void*)fwd_mega, hipFuncAttributeMaxDynamicSharedMemorySize, LDS_BYTES);
        (void)hipOccupancyMaxActiveBlocksPerMultiprocessor(&per_cu, (const void*)fwd_mega, 512, LDS_BYTES);
        if (per_cu < 1) per_cu = 1;
        grid = cus * per_cu;
        if (grid <= 0) grid = 256;
    }
    Args a{};
    for (int i = 0; i < 21; ++i) a.in[i] = (const float*)d_in[i];
    a.out = (float*)d_out; a.ws = (unsigned char*)d_ws;
    void* args[] = {&a};
    hipError_t e = hipLaunchCooperativeKernel((void*)fwd_mega, dim3(grid), dim3(512), args, LDS_BYTES, stream);
    if (e != hipSuccess) fprintf(stderr, "cooperative launch failed: %s (grid %d)\n", hipGetErrorString(e), grid);
}
```

```cpp
#include <hip/hip_runtime.h>
#include <hip/hip_cooperative_groups.h>
#include <cstdio>
#include <cstdint>
namespace cg = cooperative_groups;
namespace pg8 {
#define PG8_LAS __attribute__((address_space(3)))
typedef unsigned short bf16_t;
typedef short bf16x8 __attribute__((ext_vector_type(8)));
typedef float f32x4 __attribute__((ext_vector_type(4)));
typedef unsigned u32x4 __attribute__((ext_vector_type(4)));
constexpr int BM = 256, BK = 64, HALF = 128, HTB = HALF * BK * 2  , STAGE_BYTES = 8 * HTB, NXCD = 8, WGM = 8;

__host__ __device__ __forceinline__ int lds_byte(int r, int c) { const int st = (r >> 4) * 2 + (c >> 5), rr = r & 15, cc = c & 31, ob = rr * 64 + cc * 2; return st * 1024 + (ob ^ (((ob >> 9) & 1) << 5)); }
__host__ __device__ __forceinline__ void stage_rc(int b, int& R, int& C) { const int st = b / 1024, sb = b % 1024, swz = sb ^ (((sb >> 9) & 1) << 5); R = (st >> 1) * 16 + swz / 64; C = (st & 1) * 32 + (swz % 64) / 2; }
__host__ __device__ __forceinline__ int perm32(int rho) { const int n = rho >> 4, i = rho & 15; return 8 * (i >> 2) + 4 * n + (i & 3); }

struct Unit { int pm, pn; };
struct Gemm { const bf16_t* A; const bf16_t* Bt; int M, N, K; };

struct StaticOrder {
    int nM, nN, nwg, G, c;
    __host__ __device__ void init(int M, int N, int G_, int c_) { nM = M / BM; nN = N / BM; nwg = nM * nN; G = G_; c = c_; }
    __host__ __device__ bool next(int i, Unit& u) const {
        const long L = (long)i * G + c; if (L >= nwg) return false;
        int wgid = (int)L; { const int q = nwg / NXCD, r = nwg % NXCD, xcd = wgid % NXCD, off = wgid / NXCD; wgid = (xcd < r ? xcd * (q + 1) : r * (q + 1) + (xcd - r) * q) + off; }
        const int nig = WGM * nN, gid = wgid / nig, fm = gid * WGM, gsz = (nM - fm) < WGM ? (nM - fm) : WGM;
        u.pm = fm + ((wgid % nig) % gsz); u.pn = (wgid % nig) / gsz; return true;
    }
    __device__ __forceinline__ void a_ready(const Unit&) const {}
    __device__ __forceinline__ void done(const Unit&) const {}
};

__device__ __forceinline__ unsigned cvt_pk_bf16(float lo, float hi) { unsigned r; asm volatile("v_cvt_pk_bf16_f32 %0, %1, %2" : "=v"(r) : "v"(lo), "v"(hi)); return r; }
typedef float f32x2 __attribute__((ext_vector_type(2)));
template <class Epi, class Sched, bool ALIGN_EPI = false, bool SP2 = false>
__device__ __forceinline__ void gemm_phase(PG8_LAS unsigned char* lds, const Gemm g, const Sched& S, const Epi& E) {
    int tid_o = threadIdx.x; asm volatile("" : "+v"(tid_o));
    const int tid = tid_o, wid = __builtin_amdgcn_readfirstlane(tid >> 6), lane = tid & 63, wr = wid >> 2, wc = wid & 3, fr = lane & 15, fq = lane >> 4;
    const int K = g.K, nt = K / BK;
    unsigned voffA[2], voffB[2];
#pragma unroll
    for (int i = 0; i < 2; ++i) { int R, C; stage_rc(tid * 16 + i * 8192, R, C); const int Rb = Epi::PERM ? ((R & ~31) + perm32(R & 31)) : R;
        voffA[i] = (unsigned)(R * K + C) * 2u; voffB[i] = (unsigned)(Rb * K + C) * 2u; }
    const size_t kstep = (size_t)(BK * 2);
    const size_t hstep = (size_t)HALF * K * 2;
    const size_t tstep = 2 * hstep;
    const unsigned ldsw = (unsigned)wid * 1024u;
    const int aoff = lds_byte(wr * 64 + fr, fq * 8), boff = lds_byte(wc * 32 + fr, fq * 8);
#define PG8_SA(b, h) (((b) * 2 + (h)) * HTB)
#define PG8_SB(b, h) ((4 + (b) * 2 + (h)) * HTB)
#define PG8_STAGE(bufoff, gbase, voff) do { _Pragma("unroll") for (int _i = 0; _i < 2; ++_i) \
        __builtin_amdgcn_global_load_lds((const unsigned*)((const char*)(gbase) + (voff)[_i]), (PG8_LAS unsigned*)(lds + (bufoff) + ldsw + _i * 8192), 16, 0, 0); } while (0)
#define PG8_LDA(dst, b, h) do { _Pragma("unroll") for (int m = 0; m < 4; ++m) _Pragma("unroll") for (int k = 0; k < 2; ++k) dst[m][k] = *(const PG8_LAS bf16x8*)(lds + PG8_SA(b, h) + aoff + m * 2048 + k * 1024); } while (0)
#define PG8_LDB(dst, b, h) do { _Pragma("unroll") for (int n = 0; n < 2; ++n) _Pragma("unroll") for (int k = 0; k < 2; ++k) dst[n][k] = *(const PG8_LAS bf16x8*)(lds + PG8_SB(b, h) + boff + n * 2048 + k * 1024); } while (0)
#define PG8_MMA(ai, bj, At, Bt) do { __builtin_amdgcn_s_setprio(1); _Pragma("unroll") for (int m = 0; m < 4; ++m) _Pragma("unroll") for (int n = 0; n < 2; ++n) _Pragma("unroll") for (int k = 0; k < 2; ++k) \
        acc[ai][bj][m][n] = __builtin_amdgcn_mfma_f32_16x16x32_bf16(Bt[n][k], At[m][k], acc[ai][bj][m][n], 0, 0, 0); __builtin_amdgcn_s_setprio(0); } while (0)
#define PG8_WAIT_V(n) asm volatile("s_waitcnt vmcnt(" #n ")" ::: "memory")
#define PG8_WAIT_L(n) asm volatile("s_waitcnt lgkmcnt(" #n ")" ::: "memory")
#define PG8_BAR __builtin_amdgcn_s_barrier()
#define PG8_SCHED __builtin_amdgcn_sched_barrier(0)
    Unit cur, nxt; int ui = 0;
    if (!S.next(0, cur)) return;
    f32x4 acc[2][2][4][2];
#pragma unroll
    for (int a = 0; a < 2; ++a)
#pragma unroll
        for (int b = 0; b < 2; ++b)
#pragma unroll
            for (int m = 0; m < 4; ++m)
#pragma unroll
                for (int n = 0; n < 2; ++n) acc[a][b][m][n] = (f32x4){0.f, 0.f, 0.f, 0.f};
    bf16x8 At[4][2], B0[2][2], B1[2][2];
    const char* cA = (const char*)g.A + (size_t)cur.pm * tstep; const char* cB = (const char*)g.Bt + (size_t)cur.pn * tstep;
    S.a_ready(cur);
    if constexpr (SP2) {
        PG8_STAGE(PG8_SB(0, 0), cB, voffB); PG8_STAGE(PG8_SB(0, 1), cB + hstep, voffB); PG8_STAGE(PG8_SA(0, 0), cA, voffA); PG8_STAGE(PG8_SA(0, 1), cA + hstep, voffA);
        if (wr == 1) PG8_BAR;
        PG8_WAIT_V(2); PG8_BAR;
        PG8_STAGE(PG8_SB(1, 0), cB + kstep, voffB); PG8_STAGE(PG8_SA(1, 0), cA + kstep, voffA); PG8_STAGE(PG8_SB(1, 1), cB + hstep + kstep, voffB);
        PG8_WAIT_V(6); PG8_BAR;
    } else {
        PG8_STAGE(PG8_SB(0, 0), cB, voffB); PG8_STAGE(PG8_SA(0, 0), cA, voffA); PG8_STAGE(PG8_SB(0, 1), cB + hstep, voffB); PG8_STAGE(PG8_SA(0, 1), cA + hstep, voffA);
        if (wr == 1) PG8_BAR;
        PG8_WAIT_V(4); PG8_BAR;
        PG8_STAGE(PG8_SB(1, 0), cB + kstep, voffB); PG8_STAGE(PG8_SA(1, 0), cA + kstep, voffA); PG8_STAGE(PG8_SB(1, 1), cB + hstep + kstep, voffB);
        PG8_WAIT_V(6); PG8_BAR;
    }
    for (;;) {
        const bool has_next = S.next(ui + 1, nxt);
        const char* nA = has_next ? (const char*)g.A + (size_t)nxt.pm * tstep : cA; const char* nB = has_next ? (const char*)g.Bt + (size_t)nxt.pn * tstep : cB;
        for (int t = 0; t < nt; t += 2) {
            const bool last = (t == nt - 2);
            const char* a1 = cA + (size_t)(t + 1) * kstep;
            const char* a2 = last ? nA : cA + (size_t)(t + 2) * kstep; const char* b2 = last ? nB : cB + (size_t)(t + 2) * kstep;
            const char* a3 = a2 + kstep; const char* b3 = b2 + kstep;
            if (last && has_next) S.a_ready(nxt);
            if constexpr (SP2) {
            PG8_LDB(B0, 0, 0); PG8_LDB(B1, 0, 1); PG8_SCHED; PG8_LDA(At, 0, 0); PG8_STAGE(PG8_SA(1, 1), a1 + hstep, voffA);
            PG8_WAIT_V(8); PG8_WAIT_L(0); PG8_BAR; PG8_MMA(0, 0, At, B0); PG8_MMA(0, 1, At, B1); PG8_BAR; PG8_SCHED;
            PG8_LDA(At, 0, 1); PG8_STAGE(PG8_SB(0, 0), b2, voffB); PG8_STAGE(PG8_SB(0, 1), b2 + hstep, voffB); PG8_STAGE(PG8_SA(0, 0), a2, voffA);
            PG8_WAIT_V(8); PG8_WAIT_L(0); PG8_BAR; PG8_MMA(1, 0, At, B0); PG8_MMA(1, 1, At, B1); PG8_BAR; PG8_SCHED;
            PG8_LDB(B0, 1, 0); PG8_LDB(B1, 1, 1); PG8_SCHED; PG8_LDA(At, 1, 0); PG8_STAGE(PG8_SA(0, 1), a2 + hstep, voffA);
            PG8_WAIT_V(8); PG8_WAIT_L(0); PG8_BAR; PG8_MMA(0, 0, At, B0); PG8_MMA(0, 1, At, B1); PG8_BAR; PG8_SCHED;
            PG8_LDA(At, 1, 1); PG8_STAGE(PG8_SB(1, 0), b3, voffB); PG8_STAGE(PG8_SB(1, 1), b3 + hstep, voffB); PG8_STAGE(PG8_SA(1, 0), a3, voffA);
            PG8_WAIT_V(8); PG8_WAIT_L(0); PG8_BAR; PG8_MMA(1, 0, At, B0); PG8_MMA(1, 1, At, B1); PG8_BAR; PG8_SCHED;
            } else {
            PG8_LDB(B0, 0, 0); PG8_SCHED; PG8_LDA(At, 0, 0); PG8_STAGE(PG8_SA(1, 1), a1 + hstep, voffA);
            PG8_WAIT_L(8); PG8_BAR; PG8_WAIT_L(0); PG8_MMA(0, 0, At, B0); PG8_BAR; PG8_SCHED;
            PG8_LDB(B1, 0, 1); PG8_STAGE(PG8_SB(0, 0), b2, voffB);
            PG8_BAR; PG8_WAIT_L(0); PG8_MMA(0, 1, At, B1); PG8_BAR;
            PG8_LDA(At, 0, 1); PG8_STAGE(PG8_SA(0, 0), a2, voffA);
            PG8_BAR; PG8_WAIT_L(0); PG8_MMA(1, 0, At, B0); PG8_BAR; PG8_SCHED;
            PG8_STAGE(PG8_SB(0, 1), b2 + hstep, voffB);
            PG8_WAIT_V(6); PG8_BAR; PG8_MMA(1, 1, At, B1); PG8_BAR;
            PG8_LDB(B0, 1, 0); PG8_SCHED; PG8_LDA(At, 1, 0); PG8_STAGE(PG8_SA(0, 1), a2 + hstep, voffA);
            PG8_WAIT_L(8); PG8_BAR; PG8_WAIT_L(0); PG8_MMA(0, 0, At, B0); PG8_BAR; PG8_SCHED;
            PG8_LDB(B1, 1, 1); PG8_STAGE(PG8_SB(1, 0), b3, voffB);
            PG8_BAR; PG8_WAIT_L(0); PG8_MMA(0, 1, At, B1); PG8_BAR;
            PG8_LDA(At, 1, 1); PG8_STAGE(PG8_SA(1, 0), a3, voffA);
            PG8_BAR; PG8_WAIT_L(0); PG8_MMA(1, 0, At, B0); PG8_BAR; PG8_SCHED;
            PG8_STAGE(PG8_SB(1, 1), b3 + hstep, voffB);
            PG8_WAIT_V(6); PG8_BAR; PG8_MMA(1, 1, At, B1); PG8_BAR;
            }
        }
        if constexpr (ALIGN_EPI) { if (wr == 0) PG8_BAR; }
        if constexpr (!Epi::AFTER_DRAIN) { E(acc, cur, wr, wc, fr, fq); S.done(cur); }
        if (!has_next) break;
#pragma unroll
        for (int a = 0; a < 2; ++a)
#pragma unroll
            for (int b = 0; b < 2; ++b)
#pragma unroll
                for (int m = 0; m < 4; ++m)
#pragma unroll
                    for (int n = 0; n < 2; ++n) acc[a][b][m][n] = (f32x4){0.f, 0.f, 0.f, 0.f};
        cur = nxt; cA = nA; cB = nB; ++ui;
        if constexpr (ALIGN_EPI) { if (wr == 1) PG8_BAR; }
    }
    PG8_WAIT_V(0);
    if constexpr (!ALIGN_EPI) { if (wr == 0) PG8_BAR; }
    PG8_BAR;
    if constexpr (Epi::AFTER_DRAIN) { E.fused(acc, cur, wr, wc, fr, fq, lds, wid, lane); S.done(cur); }
#undef PG8_SA
#undef PG8_SB
#undef PG8_STAGE
#undef PG8_LDA
#undef PG8_LDB
#undef PG8_MMA
#undef PG8_WAIT_V
#undef PG8_WAIT_L
#undef PG8_BAR
#undef PG8_SCHED
}
}

typedef unsigned short bf16_t;
typedef short bf16x8 __attribute__((ext_vector_type(8)));
typedef float f32x4 __attribute__((ext_vector_type(4)));
typedef float f32x2 __attribute__((ext_vector_type(2)));
typedef float f32x16 __attribute__((ext_vector_type(16)));
typedef unsigned u32x4 __attribute__((ext_vector_type(4)));
typedef unsigned u32x2 __attribute__((ext_vector_type(2)));
typedef __bf16 bf16x2_t __attribute__((ext_vector_type(2)));
#define LAS __attribute__((address_space(3)))
#define GAS __attribute__((address_space(1)))

constexpr int S = 16384, D = 1024, DFF = 4096, NL = 2, MEML = 256;
constexpr int INCOLS = 4768;
constexpr float EPS = 1e-6f;
constexpr float LOG2E = 1.4426950408889634f;
constexpr float QS_SCALE = 0.125f * LOG2E;
constexpr float QM_SCALE = 0.08838834764831845f * LOG2E;
constexpr float QMLA_SCALE = 0.10206207261596575f * LOG2E;

constexpr size_t W_IN = 0;
constexpr size_t W_G = W_IN + (size_t)1792 * 1024;
constexpr size_t W_UQ = W_G + (size_t)3072 * 1024;
constexpr size_t W_UKV = W_UQ + (size_t)768 * 256;
constexpr size_t W_MEM = W_UKV + (size_t)1024 * 128;
constexpr size_t W_O = W_MEM + (size_t)1024 * 1024;
constexpr size_t W_OUT = W_O + (size_t)3 * 1024 * 512;
constexpr size_t W_UP = W_OUT + (size_t)1024 * 1024;
constexpr size_t W_DOWN = W_UP + (size_t)4096 * 1024;
constexpr size_t W_LAYER_ELEMS = W_DOWN + (size_t)1024 * 4096;
constexpr size_t MiB = 1u << 20;
constexpr size_t W_LAYER_BYTES = 34 * MiB;
static_assert(W_LAYER_ELEMS * 2 <= W_LAYER_BYTES, "weights");
constexpr size_t WS_W = 0;
constexpr size_t WS_XB = 68 * MiB;
constexpr size_t WS_SMALL = 100 * MiB;
constexpr size_t WS_RS = WS_SMALL;
constexpr size_t WS_RSTDM = WS_RS + 9 * (size_t)S * 4;
constexpr size_t WS_BIAS = WS_RSTDM + 1024;
constexpr size_t WS_ROPE = WS_BIAS + 4096;
constexpr size_t WS_MEMB = WS_ROPE + (size_t)S * 16 * 8;
constexpr size_t WS_KMEM = WS_MEMB + (size_t)256 * 1024 * 2;
constexpr size_t WS_VMEM = WS_KMEM + (size_t)256 * 512 * 2;
constexpr size_t WS_PTAB = WS_VMEM + (size_t)256 * 512 * 2;
constexpr size_t WS_BG = WS_PTAB + 64;
constexpr size_t WS_SINK = WS_BG + 2 * 3072 * 4;
constexpr size_t WS_FN = WS_SINK + 64;
constexpr size_t WS_BAR = WS_FN + 4096;
static_assert(WS_BAR + 16384 <= 104 * MiB, "small region");
constexpr size_t WS_H = 104 * MiB;
constexpr size_t WS_QMLA = 104 * MiB;
constexpr size_t WS_KMLA = 128 * MiB;
constexpr size_t WS_VMLA = 152 * MiB;
constexpr size_t WS_QS = 168 * MiB;
constexpr size_t WS_KS = 184 * MiB;
constexpr size_t WS_VS = 188 * MiB;
constexpr size_t WS_QM = 192 * MiB;
constexpr size_t WS_CQ = 208 * MiB;
constexpr size_t WS_CKV = 216 * MiB;
constexpr size_t WS_OMLA = 220 * MiB;
constexpr size_t WS_T = 104 * MiB;
constexpr size_t WS_YB = 136 * MiB;
static_assert(WS_OMLA + (size_t)S * 512 * 2 <= 256 * MiB, "ws");
constexpr size_t WS_RSP = 236 * MiB;
static_assert(WS_RSP + 9 * (size_t)S * 16 * 4 <= 256 * MiB, "ws");

struct Args {
    const float* in[21];
    float* out; unsigned char* ws;
};
enum { I_X = 0, I_MEM, I_RELB, I_ATTN_NORM, I_MEM_NORM, I_W_IN, I_B_GATE, I_QNORM, I_W_UQ, I_KVNORM, I_W_UKV, I_SINKS, I_W_MEMKV, I_WO_MLA, I_WO_SWA, I_WO_MEM, I_W_OUT, I_MLP_NORM, I_W_UP, I_W_DOWN, I_FNORM };

__device__ __forceinline__ unsigned cvtpk(float lo, float hi) { f32x2 v = {lo, hi}; bf16x2_t b = __builtin_convertvector(v, bf16x2_t); return __builtin_bit_cast(unsigned, b); }
__device__ __forceinline__ float bf_lo(unsigned u) { return __uint_as_float(u << 16); }
__device__ __forceinline__ float bf_hi(unsigned u) { return __uint_as_float(u & 0xffff0000u); }
__device__ __forceinline__ float wave_sum(float v) {
#pragma unroll
    for (int o = 1; o < 64; o <<= 1) v += __shfl_xor(v, o);
    return v;
}

enum { M_WIN = 0, M_MEM, M_UQ, M_UKV, M_GATE, M_Z, M_RES, M_UP };
struct Epi {
    static constexpr bool PERM = true, AFTER_DRAIN = false;
    int mode, br, layer; unsigned char* ws;
    __device__ __forceinline__ void store8(GAS bf16_t* dst, const f32x4& a, const f32x4& b) const {
        u32x4 w; w.x = cvtpk(a[0], a[1]); w.y = cvtpk(a[2], a[3]); w.z = cvtpk(b[0], b[1]); w.w = cvtpk(b[2], b[3]);
        *(GAS u32x4*)dst = w;
    }
    __device__ __forceinline__ float sq8(const f32x4& a0, const f32x4& a1) const { return (a0[0]*a0[0] + a0[1]*a0[1]) + (a0[2]*a0[2] + a0[3]*a0[3]) + (a1[0]*a1[0] + a1[1]*a1[1]) + (a1[2]*a1[2] + a1[3]*a1[3]); }
    __device__ __forceinline__ void operator()(const f32x4 (&acc)[2][2][4][2], const pg8::Unit& u, int wr, int wc, int fr_in, int fq_in) const {
        int fr = fr_in, fq = fq_in; asm volatile("" : "+v"(fr), "+v"(fq));
        const int pn = u.pn;
        GAS unsigned char* wsg = (GAS unsigned char*)ws;
        GAS float* RS = (GAS float*)(wsg + WS_RSP);
        const GAS float* rs_in = RS + (size_t)(4 * layer) * S * 16; float inv_k = 1.0f / 1024.0f; int nq = 4;
        if (mode == M_MEM) rs_in = (const GAS float*)(wsg + WS_RSTDM);
        if (mode == M_UQ) { rs_in = RS + (size_t)(4 * layer + 1) * S * 16; inv_k = 1.0f / 256.0f; nq = 1; }
        if (mode == M_UKV) { rs_in = RS + (size_t)(4 * layer + 2) * S * 16; inv_k = 1.0f / 128.0f; nq = 1; }
        if (mode == M_UP) rs_in = RS + (size_t)(4 * layer + 3) * S * 16;
        GAS float* rs_out = RS + (size_t)(4 * layer + 1) * S * 16 + wc;
        if (mode == M_WIN && pn == 1) rs_out = RS + (size_t)(4 * layer + 2) * S * 16 + wc;
        if (mode == M_RES) rs_out = RS + (size_t)(4 * layer + 3 + br) * S * 16 + pn * 4 + wc;
        const GAS float* resid = nullptr; GAS float* X = nullptr;
        if (mode == M_RES && layer == 0 && br == 0) resid = (const GAS float*)*(const float* const GAS*)(wsg + WS_PTAB);
#pragma unroll
        for (int ai = 0; ai < 2; ++ai)
#pragma unroll
            for (int m = 0; m < 4; ++m) {
                const int row = u.pm * 256 + ai * 128 + wr * 64 + m * 16 + fr;
                float sc = 1.f;
                if (mode == M_MEM) sc = rs_in[row];
                else if (mode != M_Z && mode != M_RES) {
                    const GAS f32x4* pp = (const GAS f32x4*)(rs_in + (size_t)row * 16);
                    f32x4 p = pp[0]; float rs = (p[0] + p[1]) + (p[2] + p[3]);
                    if (nq == 4) { p = pp[1]; rs += (p[0] + p[1]) + (p[2] + p[3]); p = pp[2]; rs += (p[0] + p[1]) + (p[2] + p[3]); p = pp[3]; rs += (p[0] + p[1]) + (p[2] + p[3]); }
                    sc = __builtin_amdgcn_rsqf(rs * inv_k + EPS);
                }
                if (mode == M_UQ) sc *= QMLA_SCALE;
                float ss = 0.f;
#pragma unroll
                for (int bj = 0; bj < 2; ++bj) {
                    const int ct = bj * 128 + wc * 32 + 8 * fq;
                    f32x4 a0 = acc[ai][bj][m][0] * sc, a1 = acc[ai][bj][m][1] * sc;
                    switch (mode) {
                    case M_WIN: {
                        if (pn == 0) { store8((GAS bf16_t*)(wsg + WS_CQ) + (size_t)row * 256 + ct, a0, a1); ss += sq8(a0, a1); }
                        else if (pn == 1) {
                            if (bj == 0) { store8((GAS bf16_t*)(wsg + WS_CKV) + (size_t)row * 128 + ct, a0, a1); ss += sq8(a0, a1); }
                            else if (wc == 0) {
                                const GAS f32x2* cs = (const GAS f32x2*)(wsg + WS_ROPE) + (size_t)row * 16 + 4 * fq;
                                f32x4 o1, o2;
#pragma unroll
                                for (int e = 0; e < 4; ++e) { const f32x2 c = cs[e]; o1[e] = a0[e] * c.x - a1[e] * c.y; o2[e] = a1[e] * c.x + a0[e] * c.y; }
                                u32x2 w1, w2; w1.x = cvtpk(o1[0], o1[1]); w1.y = cvtpk(o1[2], o1[3]); w2.x = cvtpk(o2[0], o2[1]); w2.y = cvtpk(o2[2], o2[3]);
                                GAS bf16_t* kr = (GAS bf16_t*)(wsg + WS_KMLA) + (size_t)row * 768 + 64 + 4 * fq;
#pragma unroll
                                for (int hh = 0; hh < 8; ++hh) { *(GAS u32x2*)(kr + hh * 96) = w1; *(GAS u32x2*)(kr + hh * 96 + 16) = w2; }
                            }
                        }
                        else if (pn < 4) { store8((GAS bf16_t*)(wsg + WS_QS) + (size_t)row * 512 + (pn - 2) * 256 + ct, a0 * QS_SCALE, a1 * QS_SCALE); }
                        else if (pn == 4) { if (bj == 0) store8((GAS bf16_t*)(wsg + WS_KS) + (size_t)row * 128 + ct, a0, a1); else store8((GAS bf16_t*)(wsg + WS_VS) + (size_t)row * 128 + ct - 128, a0, a1); }
                        else { store8((GAS bf16_t*)(wsg + WS_QM) + (size_t)row * 512 + (pn - 5) * 256 + ct, a0 * QM_SCALE, a1 * QM_SCALE); }
                    } break;
                    case M_MEM: {
                        if (pn < 2) store8((GAS bf16_t*)(wsg + WS_KMEM) + (size_t)row * 512 + pn * 256 + ct, a0, a1);
                        else store8((GAS bf16_t*)(wsg + WS_VMEM) + (size_t)row * 512 + (pn - 2) * 256 + ct, a0, a1);
                    } break;
                    case M_UQ: {
                        if (pn < 2) { const int c = pn * 256 + ct; store8((GAS bf16_t*)(wsg + WS_QMLA) + (size_t)row * 768 + (c >> 6) * 96 + (c & 63), a0, a1); }
                        else {
                            const int head = 4 * bj + wc;
                            const GAS f32x2* cs = (const GAS f32x2*)(wsg + WS_ROPE) + (size_t)row * 16 + 4 * fq;
                            f32x4 o1, o2;
#pragma unroll
                            for (int e = 0; e < 4; ++e) { const f32x2 c = cs[e]; o1[e] = a0[e] * c.x - a1[e] * c.y; o2[e] = a1[e] * c.x + a0[e] * c.y; }
                            u32x2 w1, w2; w1.x = cvtpk(o1[0], o1[1]); w1.y = cvtpk(o1[2], o1[3]); w2.x = cvtpk(o2[0], o2[1]); w2.y = cvtpk(o2[2], o2[3]);
                            GAS bf16_t* qrp = (GAS bf16_t*)(wsg + WS_QMLA) + (size_t)row * 768 + head * 96 + 64 + 4 * fq;
                            *(GAS u32x2*)qrp = w1; *(GAS u32x2*)(qrp + 16) = w2;
                        }
                    } break;
                    case M_UKV: {
                        if (pn < 2) { const int c = pn * 256 + ct; store8((GAS bf16_t*)(wsg + WS_KMLA) + (size_t)row * 768 + (c >> 6) * 96 + (c & 63), a0, a1); }
                        else {
                            GAS unsigned short* vt = (GAS unsigned short*)(wsg + WS_VMLA) + (size_t)((pn - 2) * 256 + ct) * S + row;
                            const unsigned w0 = cvtpk(a0[0], a0[1]), w1 = cvtpk(a0[2], a0[3]), w2 = cvtpk(a1[0], a1[1]), w3 = cvtpk(a1[2], a1[3]);
                            vt[0 * (size_t)S] = (unsigned short)(w0 & 0xffffu); vt[1 * (size_t)S] = (unsigned short)(w0 >> 16);
                            vt[2 * (size_t)S] = (unsigned short)(w1 & 0xffffu); vt[3 * (size_t)S] = (unsigned short)(w1 >> 16);
                            vt[4 * (size_t)S] = (unsigned short)(w2 & 0xffffu); vt[5 * (size_t)S] = (unsigned short)(w2 >> 16);
                            vt[6 * (size_t)S] = (unsigned short)(w3 & 0xffffu); vt[7 * (size_t)S] = (unsigned short)(w3 >> 16);
                        }
                    } break;
                    case M_GATE: {
                        const int c = pn * 256 + ct;
                        const GAS float* bg = (const GAS float*)(wsg + WS_BG) + layer * 3072 + br * 1024 + c;
                        const f32x4 b0 = *(const GAS f32x4*)bg, b1 = *(const GAS f32x4*)(bg + 4);
                        f32x4 g0, g1;
#pragma unroll
                        for (int e = 0; e < 4; ++e) { g0[e] = __builtin_amdgcn_rcpf(1.f + __builtin_amdgcn_exp2f(-(a0[e] + b0[e]) * LOG2E)); g1[e] = __builtin_amdgcn_rcpf(1.f + __builtin_amdgcn_exp2f(-(a1[e] + b1[e]) * LOG2E)); }
                        store8((GAS bf16_t*)(wsg + WS_T) + (size_t)row * 1024 + c, g0, g1);
                    } break;
                    case M_Z: {
                        const int c = pn * 256 + ct;
                        const u32x4 t = *(const GAS u32x4*)((GAS bf16_t*)(wsg + WS_T) + (size_t)row * 1024 + c);
                        GAS bf16_t* yp = (GAS bf16_t*)(wsg + WS_YB) + (size_t)row * 1024 + c;
                        f32x4 y0 = {0.f, 0.f, 0.f, 0.f}, y1 = {0.f, 0.f, 0.f, 0.f};
                        if (br > 0) { const u32x4 yo = *(const GAS u32x4*)yp;
                            y0 = (f32x4){bf_lo(yo.x), bf_hi(yo.x), bf_lo(yo.y), bf_hi(yo.y)}; y1 = (f32x4){bf_lo(yo.z), bf_hi(yo.z), bf_lo(yo.w), bf_hi(yo.w)}; }
                        y0 += a0 * (f32x4){bf_lo(t.x), bf_hi(t.x), bf_lo(t.y), bf_hi(t.y)};
                        y1 += a1 * (f32x4){bf_lo(t.z), bf_hi(t.z), bf_lo(t.w), bf_hi(t.w)};
                        store8(yp, y0, y1);
                    } break;
                    case M_RES: {
                        const int c = pn * 256 + ct;
                        GAS bf16_t* xbp = (GAS bf16_t*)(wsg + WS_XB) + (size_t)row * 1024 + c;
                        f32x4 x0, x1;
                        if (resid) { x0 = *(const GAS f32x4*)(resid + (size_t)row * 1024 + c); x1 = *(const GAS f32x4*)(resid + (size_t)row * 1024 + c + 4); }
                        else { const u32x4 xo = *(const GAS u32x4*)xbp; x0 = (f32x4){bf_lo(xo.x), bf_hi(xo.x), bf_lo(xo.y), bf_hi(xo.y)}; x1 = (f32x4){bf_lo(xo.z), bf_hi(xo.z), bf_lo(xo.w), bf_hi(xo.w)}; }
                        x0 += a0; x1 += a1;
                        store8(xbp, x0, x1);
                        ss += sq8(x0, x1);
                    } break;
                    default: {
                        f32x4 r0, r1;
#pragma unroll
                        for (int e = 0; e < 4; ++e) { const float v0 = fmaxf(a0[e], 0.f), v1 = fmaxf(a1[e], 0.f); r0[e] = v0 * v0; r1[e] = v1 * v1; }
                        store8((GAS bf16_t*)(wsg + WS_H) + (size_t)row * 4096 + pn * 256 + ct, r0, r1);
                    } break;
                    }
                }
                if (mode == M_RES || (mode == M_WIN && pn < 2)) {
                    ss += __shfl_xor(ss, 16); ss += __shfl_xor(ss, 32);
                    if (fq == 0) rs_out[(size_t)row * 16] = ss;
                }
            }
    }
};

__device__ __forceinline__ int crow(int i, int h) { return (i & 3) + 8 * (i >> 2) + 4 * h; }
#define MFMA32(a, b, c) __builtin_amdgcn_mfma_f32_32x32x16_bf16((a), (b), (c), 0, 0, 0)

template <int DQK, int DV, int MODE>
__device__ __forceinline__ void attn_unit(LAS unsigned char* lds, const GAS bf16_t* Q, int qpitch, const GAS bf16_t* K, int kpitch, const GAS bf16_t* V, int vpitch,
                                          GAS bf16_t* O, int opitch, int q0, int t_begin, int t_end, const GAS float* biasrow, float sink_l2, int tid) {
    constexpr int KSTR = (DQK + 8) * 2, VSTR = 144, KBUF = 64 * KSTR, VBUF = DV * VSTR;
    constexpr int NKC = DQK / 8, NKCH = 64 * NKC, KIT = (NKCH + 511) / 512, VIT = DV / 64, NC = DQK / 16, NDB = DV / 32;
    constexpr int OFF_K = 0, OFF_V = 2 * KBUF, OFF_BIAS = 2 * KBUF + 2 * VBUF;
    static_assert(OFF_BIAS + 512 <= 131072, "attention lds");
    const int lane = tid & 63, w = __builtin_amdgcn_readfirstlane(tid >> 6), r = lane & 31, h = lane >> 5;
    const int R0 = q0 + 32 * w;
    LAS float* biasl = (LAS float*)(lds + OFF_BIAS);
    if (MODE == 1) { if (tid < 128) biasl[tid] = biasrow[tid]; }
    bf16x8 qr[NC];
#pragma unroll
    for (int c = 0; c < NC; ++c) qr[c] = *(const GAS bf16x8*)(Q + (size_t)(R0 + r) * qpitch + 16 * c + 8 * h);
    u32x4 kst[KIT], vst[VIT];
    const int vpos = (lane & ~15) | (((lane >> 2) & 1) << 3) | (((lane >> 3) & 1) << 2) | (lane & 3);
#define ATT_LOAD(t) do { \
        _Pragma("unroll") for (int i_ = 0; i_ < KIT; ++i_) { const int c_ = tid + 512 * i_; if (c_ < NKCH) { const int row_ = c_ / NKC, col_ = c_ % NKC; \
            kst[i_] = *(const GAS u32x4*)(K + (size_t)(64 * (t) + row_) * kpitch + col_ * 8); } } \
        _Pragma("unroll") for (int i_ = 0; i_ < VIT; ++i_) vst[i_] = *(const GAS u32x4*)(V + (size_t)(64 * (t) + lane) * vpitch + (w + 8 * i_) * 8); } while (0)
#define ATT_STORE(buf) do { \
        _Pragma("unroll") for (int i_ = 0; i_ < KIT; ++i_) { const int c_ = tid + 512 * i_; if (c_ < NKCH) { const int row_ = c_ / NKC, col_ = c_ % NKC; \
            *(LAS u32x4*)(lds + OFF_K + (buf) * KBUF + row_ * KSTR + col_ * 16) = kst[i_]; } } \
        _Pragma("unroll") for (int i_ = 0; i_ < VIT; ++i_) { LAS unsigned short* vd_ = (LAS unsigned short*)(lds + OFF_V + (buf) * VBUF + ((w + 8 * i_) * 8) * VSTR + vpos * 2); \
            const u32x4 v_ = vst[i_]; \
            vd_[0 * (VSTR / 2)] = (unsigned short)(v_.x & 0xffffu); vd_[1 * (VSTR / 2)] = (unsigned short)(v_.x >> 16); \
            vd_[2 * (VSTR / 2)] = (unsigned short)(v_.y & 0xffffu); vd_[3 * (VSTR / 2)] = (unsigned short)(v_.y >> 16); \
            vd_[4 * (VSTR / 2)] = (unsigned short)(v_.z & 0xffffu); vd_[5 * (VSTR / 2)] = (unsigned short)(v_.z >> 16); \
            vd_[6 * (VSTR / 2)] = (unsigned short)(v_.w & 0xffffu); vd_[7 * (VSTR / 2)] = (unsigned short)(v_.w >> 16); } } while (0)

    float mrun = (MODE == 1) ? sink_l2 : -INFINITY;
    float lrun = (MODE == 1 && h == 0) ? 1.f : 0.f;
    f32x16 o[NDB];
#pragma unroll
    for (int db = 0; db < NDB; ++db)
#pragma unroll
        for (int i = 0; i < 16; ++i) o[db][i] = 0.f;

    ATT_LOAD(t_begin);
    ATT_STORE(0);
    __syncthreads();
    for (int t = t_begin; t < t_end; ++t) {
        const int buf = (t - t_begin) & 1;
        const bool more = (t + 1 < t_end);
        if (more) ATT_LOAD(t + 1);
        bool skip = false;
        if (MODE == 0) skip = (64 * t > R0 + 31);
        if (MODE == 1) skip = (64 * t > R0 + 31) || (64 * t + 63 < R0 - 127);
        if (!skip) {
            f32x16 p0, p1;
#pragma unroll
            for (int i = 0; i < 16; ++i) { p0[i] = 0.f; p1[i] = 0.f; }
            const LAS unsigned char* kp = lds + OFF_K + buf * KBUF + r * KSTR + h * 16;
#pragma unroll
            for (int c = 0; c < NC; ++c) {
                const bf16x8 k0 = *(const LAS bf16x8*)(kp + c * 32);
                const bf16x8 k1 = *(const LAS bf16x8*)(kp + 32 * KSTR + c * 32);
                p0 = MFMA32(k0, qr[c], p0); p1 = MFMA32(k1, qr[c], p1);
            }
            const int qa = R0 + r;
            if (MODE == 0) {
                if (64 * t + 63 > R0) {
#pragma unroll
                    for (int i = 0; i < 16; ++i) { const int kv = 64 * t + crow(i, h); if (kv > qa) p0[i] = -INFINITY; if (kv + 32 > qa) p1[i] = -INFINITY; }
                }
            }
            if (MODE == 1) {
#pragma unroll
                for (int i = 0; i < 16; ++i) { const int d0 = qa - (64 * t + crow(i, h)), d1 = d0 - 32;
                    const float b0 = biasl[d0 & 127], b1 = biasl[d1 & 127];
                    p0[i] = (d0 >= 0 && d0 < 128) ? p0[i] + b0 : -INFINITY; p1[i] = (d1 >= 0 && d1 < 128) ? p1[i] + b1 : -INFINITY; }
            }
            float mx = fmaxf(p0[0], p1[0]);
#pragma unroll
            for (int i = 1; i < 16; ++i) mx = fmaxf(mx, fmaxf(p0[i], p1[i]));
            mx = fmaxf(mx, __shfl_xor(mx, 32));
            const float mnew = fmaxf(mrun, mx);
            const float alpha = __builtin_amdgcn_exp2f(mrun - mnew);
            mrun = mnew;
            float ls = 0.f;
#pragma unroll
            for (int i = 0; i < 16; ++i) { p0[i] = __builtin_amdgcn_exp2f(p0[i] - mnew); p1[i] = __builtin_amdgcn_exp2f(p1[i] - mnew); ls += p0[i] + p1[i]; }
            lrun = lrun * alpha + ls;
#pragma unroll
            for (int db = 0; db < NDB; ++db)
#pragma unroll
                for (int i = 0; i < 16; ++i) o[db][i] *= alpha;
            bf16x8 pa[4];
#pragma unroll
            for (int s = 0; s < 4; ++s) {
                u32x4 pk;
                if (s < 2) { pk.x = cvtpk(p0[8 * s + 0], p0[8 * s + 1]); pk.y = cvtpk(p0[8 * s + 2], p0[8 * s + 3]); pk.z = cvtpk(p0[8 * s + 4], p0[8 * s + 5]); pk.w = cvtpk(p0[8 * s + 6], p0[8 * s + 7]); }
                else { const int s2 = s - 2; pk.x = cvtpk(p1[8 * s2 + 0], p1[8 * s2 + 1]); pk.y = cvtpk(p1[8 * s2 + 2], p1[8 * s2 + 3]); pk.z = cvtpk(p1[8 * s2 + 4], p1[8 * s2 + 5]); pk.w = cvtpk(p1[8 * s2 + 6], p1[8 * s2 + 7]); }
                pa[s] = __builtin_bit_cast(bf16x8, pk);
            }
            const LAS unsigned char* vp = lds + OFF_V + buf * VBUF + r * VSTR + h * 16;
#pragma unroll
            for (int db = 0; db < NDB; ++db)
#pragma unroll
                for (int s = 0; s < 4; ++s) {
                    const bf16x8 vf = *(const LAS bf16x8*)(vp + db * 32 * VSTR + s * 32);
                    o[db] = MFMA32(vf, pa[s], o[db]);
                }
        }
        if (more) ATT_STORE(buf ^ 1);
        __syncthreads();
    }
    lrun += __shfl_xor(lrun, 32);
    const float inv = 1.f / lrun;
    GAS bf16_t* orow = O + (size_t)(R0 + r) * opitch;
#pragma unroll
    for (int db = 0; db < NDB; ++db)
#pragma unroll
        for (int g = 0; g < 4; ++g) {
            u32x2 wv; wv.x = cvtpk(o[db][4 * g + 0] * inv, o[db][4 * g + 1] * inv); wv.y = cvtpk(o[db][4 * g + 2] * inv, o[db][4 * g + 3] * inv);
            *(GAS u32x2*)(orow + 32 * db + 8 * g + 4 * h) = wv;
        }
#undef ATT_LOAD
#undef ATT_STORE
}

constexpr float ATT_THR = 8.0f;
__device__ __forceinline__ float max3f(float a, float b, float c) { return __builtin_fmaxf(__builtin_fmaxf(a, b), c); }
template <int DQK>
__device__ __forceinline__ void att_qk(f32x16& s0, f32x16& s1, const LAS unsigned char* kp, const bf16x8 (&qr)[DQK / 16]) {
    constexpr int NC = DQK / 16, KSTR = (DQK + 8) * 2;
    f32x16 z;
#pragma unroll
    for (int i = 0; i < 16; ++i) z[i] = 0.f;
#pragma unroll
    for (int c = 0; c < NC; ++c) {
        const bf16x8 k0 = *(const LAS bf16x8*)(kp + c * 32);
        const bf16x8 k1 = *(const LAS bf16x8*)(kp + 32 * KSTR + c * 32);
        if (c == 0) { s0 = MFMA32(k0, qr[0], z); s1 = MFMA32(k1, qr[0], z); }
        else { s0 = MFMA32(k0, qr[c], s0); s1 = MFMA32(k1, qr[c], s1); }
    }
}
template <int MODE>
__device__ __forceinline__ void att_pre(f32x16& s0, f32x16& s1, f32x16 (&o)[2], float& mhat, float& lrun, bool& first, int t, int R0, int qa, int h, const LAS float* biasl) {
#pragma unroll
    for (int i = 0; i < 16; ++i) { s0[i] -= mhat; s1[i] -= mhat; }
    if (MODE == 0) {
        if (64 * t + 63 > R0) {
#pragma unroll
            for (int i = 0; i < 16; ++i) { const int kv = 64 * t + crow(i, h); if (kv > qa) s0[i] = -INFINITY; if (kv + 32 > qa) s1[i] = -INFINITY; }
        }
    }
    if (MODE == 1) {
#pragma unroll
        for (int i = 0; i < 16; ++i) { const int d0 = qa - (64 * t + crow(i, h)), d1 = d0 - 32;
            const float b0 = biasl[d0 & 127], b1 = biasl[d1 & 127];
            s0[i] = (d0 >= 0 && d0 < 128) ? s0[i] + b0 : -INFINITY; s1[i] = (d1 >= 0 && d1 < 128) ? s1[i] + b1 : -INFINITY; }
    }
    float a = max3f(s0[0], s0[1], s1[0]), b = max3f(s0[2], s0[3], s1[1]); a = max3f(a, s1[2], s1[3]);
#pragma unroll
    for (int i = 4; i < 16; i += 4) { a = max3f(a, s0[i], s0[i + 1]); b = max3f(b, s0[i + 2], s0[i + 3]); a = max3f(a, s1[i], s1[i + 1]); b = max3f(b, s1[i + 2], s1[i + 3]); }
    float rm = __builtin_fmaxf(a, b);
    { auto rr = __builtin_amdgcn_permlane32_swap(__float_as_uint(rm), __float_as_uint(rm), false, false); rm = __builtin_fmaxf(__uint_as_float(rr[0]), __uint_as_float(rr[1])); }
    if (first || __any(rm > ATT_THR)) {
        const float dl = first ? rm : __builtin_fmaxf(rm, 0.f);
        mhat += dl;
#pragma unroll
        for (int i = 0; i < 16; ++i) { s0[i] -= dl; s1[i] -= dl; }
        if (!first) { const float f = __builtin_amdgcn_exp2f(-dl); lrun *= f;
#pragma unroll
            for (int i = 0; i < 16; ++i) { o[0][i] *= f; o[1][i] *= f; } }
        first = false;
    }
}
__device__ __forceinline__ void att_post_half(f32x16& s, float& lrun, bf16x8& pa0, bf16x8& pa1) {
    float ls = 0.f;
#pragma unroll
    for (int i = 0; i < 16; ++i) { s[i] = __builtin_amdgcn_exp2f(s[i]); ls += s[i]; }
    lrun += ls;
    u32x4 pk; pk.x = cvtpk(s[0], s[1]); pk.y = cvtpk(s[2], s[3]); pk.z = cvtpk(s[4], s[5]); pk.w = cvtpk(s[6], s[7]);
    pa0 = __builtin_bit_cast(bf16x8, pk);
    u32x4 pq; pq.x = cvtpk(s[8], s[9]); pq.y = cvtpk(s[10], s[11]); pq.z = cvtpk(s[12], s[13]); pq.w = cvtpk(s[14], s[15]);
    pa1 = __builtin_bit_cast(bf16x8, pq);
}
__device__ __forceinline__ void att_pv(f32x16 (&o)[2], const bf16x8 (&pa)[4], const LAS unsigned char* vp) {
#pragma unroll
    for (int db = 0; db < 2; ++db)
#pragma unroll
        for (int s = 0; s < 4; ++s) {
            const bf16x8 vf = *(const LAS bf16x8*)(vp + db * 32 * 144 + s * 32);
            o[db] = MFMA32(vf, pa[s], o[db]);
        }
}
template <int DQK, int MODE, bool VT>
__device__ __forceinline__ void attn_unit_pipe(LAS unsigned char* lds, const GAS bf16_t* Q, int qpitch, const GAS bf16_t* K, int kpitch, const GAS bf16_t* V, int vpitch,
                                               GAS bf16_t* O, int opitch, int q0, int t_begin, int t_end, const GAS float* biasrow, float sink_l2, int tid_in) {
    int tid = tid_in; asm volatile("" : "+v"(tid));
    constexpr int DV = 64, KSTR = (DQK + 8) * 2, VSTR = 144, KBUF = 64 * KSTR, VBUF = DV * VSTR;
    constexpr int NKC = DQK / 8, NKCH = 64 * NKC, KIT = (NKCH + 511) / 512, NC = DQK / 16;
    constexpr int OFF_K = 0, OFF_V = 2 * KBUF, OFF_BIAS = 2 * KBUF + 2 * VBUF;
    const int lane = tid & 63, w = __builtin_amdgcn_readfirstlane(tid >> 6), r = lane & 31, h = lane >> 5;
    const int R0 = q0 + 32 * w, qa = R0 + r;
    LAS float* biasl = (LAS float*)(lds + OFF_BIAS);
    if (MODE == 1) { if (tid < 128) biasl[tid] = biasrow[tid]; }
    bf16x8 qr[NC];
#pragma unroll
    for (int c = 0; c < NC; ++c) qr[c] = *(const GAS bf16x8*)(Q + (size_t)(R0 + r) * qpitch + 16 * c + 8 * h);
    u32x4 kstA[KIT], vstA, kstB[KIT], vstB;
    const int vpos = (lane & ~15) | (((lane >> 2) & 1) << 3) | (((lane >> 3) & 1) << 2) | (lane & 3);
#define ATP_LOADK(KST, t) do { \
        _Pragma("unroll") for (int i_ = 0; i_ < KIT; ++i_) { const int c_ = tid + 512 * i_; if (c_ < NKCH) { const int row_ = c_ / NKC, col_ = c_ % NKC; \
            KST[i_] = *(const GAS u32x4*)(K + (size_t)(64 * (t) + row_) * kpitch + col_ * 8); } } } while (0)
#define ATP_LOADV(VST, t) do { if (VT) VST = *(const GAS u32x4*)(V + (size_t)(tid >> 3) * vpitch + 64 * (t) + (tid & 7) * 8); \
        else VST = *(const GAS u32x4*)(V + (size_t)(64 * (t) + lane) * vpitch + w * 8); } while (0)
#define ATP_STOREK(KST, buf) do { \
        _Pragma("unroll") for (int i_ = 0; i_ < KIT; ++i_) { const int c_ = tid + 512 * i_; if (c_ < NKCH) { const int row_ = c_ / NKC, col_ = c_ % NKC; \
            *(LAS u32x4*)(lds + OFF_K + (buf) * KBUF + row_ * KSTR + col_ * 16) = KST[i_]; } } } while (0)
#define ATP_STOREV(VST, buf) do { if (VT) { LAS unsigned char* vt_ = lds + OFF_V + (buf) * VBUF + (tid >> 3) * VSTR + (16 * ((tid & 7) >> 1) + 4 * (tid & 1)) * 2; \
            u32x2 lo_, hi_; lo_.x = VST.x; lo_.y = VST.y; hi_.x = VST.z; hi_.y = VST.w; *(LAS u32x2*)vt_ = lo_; *(LAS u32x2*)(vt_ + 16) = hi_; } else { \
            LAS unsigned short* vd_ = (LAS unsigned short*)(lds + OFF_V + (buf) * VBUF + (w * 8) * VSTR + vpos * 2); \
            vd_[0 * (VSTR / 2)] = (unsigned short)(VST.x & 0xffffu); vd_[1 * (VSTR / 2)] = (unsigned short)(VST.x >> 16); \
            vd_[2 * (VSTR / 2)] = (unsigned short)(VST.y & 0xffffu); vd_[3 * (VSTR / 2)] = (unsigned short)(VST.y >> 16); \
            vd_[4 * (VSTR / 2)] = (unsigned short)(VST.z & 0xffffu); vd_[5 * (VSTR / 2)] = (unsigned short)(VST.z >> 16); \
            vd_[6 * (VSTR / 2)] = (unsigned short)(VST.w & 0xffffu); vd_[7 * (VSTR / 2)] = (unsigned short)(VST.w >> 16); } } while (0)
#define ATP_SKIP(t) ((MODE == 0) ? (64 * (t) > R0 + 31) : ((MODE == 1) ? ((64 * (t) > R0 + 31) || (64 * (t) + 63 < R0 - 127)) : false))

    float mhat = (MODE == 1) ? sink_l2 : 0.f;
    float lrun = (MODE == 1 && h == 0) ? 1.f : 0.f;
    bool first = (MODE != 1);
    f32x16 o[2], sA0, sA1, sB0, sB1; bf16x8 pa[4];
#pragma unroll
    for (int i = 0; i < 16; ++i) { o[0][i] = 0.f; o[1][i] = 0.f; sA0[i] = 0.f; sA1[i] = 0.f; sB0[i] = 0.f; sB1[i] = 0.f; }
    const LAS unsigned char* kbase = lds + OFF_K + r * KSTR + h * 16;
    const LAS unsigned char* vbase = lds + OFF_V + r * VSTR + h * 16;

    ATP_LOADK(kstA, t_begin); ATP_LOADV(vstA, t_begin);
    if (t_begin + 1 < t_end) ATP_LOADK(kstB, t_begin + 1);
    ATP_STOREK(kstA, 0); ATP_STOREV(vstA, 0);
    if (t_begin + 1 < t_end) ATP_STOREK(kstB, 1);
    if (t_begin + 2 < t_end) ATP_LOADK(kstA, t_begin + 2);
    if (t_begin + 1 < t_end) ATP_LOADV(vstA, t_begin + 1);
    __syncthreads();
    if (!ATP_SKIP(t_begin)) att_qk<DQK>(sA0, sA1, kbase, qr);
    __syncthreads();
#define ATP_KF(c, hf) (*(const LAS bf16x8*)(kpn_ + (hf) * 32 * KSTR + (c) * 32))
#define ATP_VF(db, s_) (*(const LAS bf16x8*)(vpc_ + (db) * 32 * 144 + (s_) * 32))
#define ATP_SB() __builtin_amdgcn_sched_barrier(0)
#define ATP_ITER_FAST(C0, C1, N0, N1, KCUR, VCUR, KNXT, VNXT, T) do { \
        const int t_ = (T); const int sc_ = (t_ - t_begin) & 1; \
        const LAS unsigned char* kpn_ = kbase + (sc_ ^ 1) * KBUF; const LAS unsigned char* vpc_ = vbase + sc_ * VBUF; \
          \
        const bf16x8 ka0_ = ATP_KF(0, 0), kb0_ = ATP_KF(0, 1), ka1_ = ATP_KF(1, 0), kb1_ = ATP_KF(1, 1), ka2_ = ATP_KF(2, 0), kb2_ = ATP_KF(2, 1); \
        ATP_LOADK(KNXT, t_ + 3); ATP_LOADV(VNXT, t_ + 2); \
        att_pre<2>(C0, C1, o, mhat, lrun, first, t_, R0, qa, h, biasl); \
        ATP_SB(); \
          \
        const bf16x8 ka3_ = ATP_KF(3, 0), kb3_ = ATP_KF(3, 1), ka4_ = ATP_KF(4, 0), kb4_ = ATP_KF(4, 1), ka5_ = ATP_KF(5, 0), kb5_ = ATP_KF(5, 1); \
        { f32x16 z_; _Pragma("unroll") for (int i_ = 0; i_ < 16; ++i_) z_[i_] = 0.f; N0 = MFMA32(ka0_, qr[0], z_); N1 = MFMA32(kb0_, qr[0], z_); } \
        N0 = MFMA32(ka1_, qr[1], N0); N1 = MFMA32(kb1_, qr[1], N1); \
        N0 = MFMA32(ka2_, qr[2], N0); N1 = MFMA32(kb2_, qr[2], N1); \
        att_post_half(C0, lrun, pa[0], pa[1]); \
        ATP_SB(); \
          \
        const bf16x8 v00_ = ATP_VF(0, 0), v01_ = ATP_VF(0, 1), v10_ = ATP_VF(1, 0), v11_ = ATP_VF(1, 1); \
        const bf16x8 v02_ = ATP_VF(0, 2), v03_ = ATP_VF(0, 3), v12_ = ATP_VF(1, 2), v13_ = ATP_VF(1, 3); \
        N0 = MFMA32(ka3_, qr[3], N0); N1 = MFMA32(kb3_, qr[3], N1); \
        N0 = MFMA32(ka4_, qr[4], N0); N1 = MFMA32(kb4_, qr[4], N1); \
        N0 = MFMA32(ka5_, qr[5], N0); N1 = MFMA32(kb5_, qr[5], N1); \
        o[0] = MFMA32(v00_, pa[0], o[0]); o[1] = MFMA32(v10_, pa[0], o[1]); \
        o[0] = MFMA32(v01_, pa[1], o[0]); o[1] = MFMA32(v11_, pa[1], o[1]); \
        att_post_half(C1, lrun, pa[2], pa[3]); \
        ATP_SB(); \
          \
        o[0] = MFMA32(v02_, pa[2], o[0]); o[1] = MFMA32(v12_, pa[2], o[1]); \
        o[0] = MFMA32(v03_, pa[3], o[0]); o[1] = MFMA32(v13_, pa[3], o[1]); \
        ATP_STOREK(KCUR, sc_); ATP_STOREV(VCUR, sc_ ^ 1); \
        ATP_SB(); asm volatile("s_waitcnt lgkmcnt(0)\n\ts_barrier" ::: "memory"); ATP_SB(); } while (0)
#define ATP_ITER_GEN(C0, C1, N0, N1, KCUR, VCUR, KNXT, VNXT, T) do { \
        const int t_ = (T); const bool m1_ = (t_ + 1 < t_end), m2_ = (t_ + 2 < t_end), m3_ = (t_ + 3 < t_end); \
        if (m3_) ATP_LOADK(KNXT, t_ + 3); if (m2_) ATP_LOADV(VNXT, t_ + 2); \
        const bool sk_ = ATP_SKIP(t_), skn_ = !m1_ || ATP_SKIP(t_ + 1); \
        const int sc_ = (t_ - t_begin) & 1; \
        const LAS unsigned char* kpn_ = kbase + (sc_ ^ 1) * KBUF; const LAS unsigned char* vpc_ = vbase + sc_ * VBUF; \
        if (!sk_) att_pre<MODE>(C0, C1, o, mhat, lrun, first, t_, R0, qa, h, biasl); \
        if (!skn_) att_qk<DQK>(N0, N1, kpn_, qr); \
        if (!sk_) { att_post_half(C0, lrun, pa[0], pa[1]); att_post_half(C1, lrun, pa[2], pa[3]); att_pv(o, pa, vpc_); } \
        if (m2_) ATP_STOREK(KCUR, sc_); if (m1_) ATP_STOREV(VCUR, sc_ ^ 1); \
        ATP_SB(); asm volatile("s_waitcnt lgkmcnt(0)\n\ts_barrier" ::: "memory"); ATP_SB(); } while (0)
    int t = t_begin;
    if (MODE == 0) {
        const int n_fast = (q0 >> 6) - 1;
        for (; t + 1 < n_fast; t += 2) { ATP_ITER_FAST(sA0, sA1, sB0, sB1, kstA, vstA, kstB, vstB, t); ATP_ITER_FAST(sB0, sB1, sA0, sA1, kstB, vstB, kstA, vstA, t + 1); }
    }
    for (; t < t_end; ++t) {
        ATP_ITER_GEN(sA0, sA1, sB0, sB1, kstA, vstA, kstB, vstB, t);
        sA0 = sB0; sA1 = sB1; vstA = vstB;
#pragma unroll
        for (int i_ = 0; i_ < KIT; ++i_) kstA[i_] = kstB[i_];
    }

    { auto rr = __builtin_amdgcn_permlane32_swap(__float_as_uint(lrun), __float_as_uint(lrun), false, false); lrun = __uint_as_float(rr[0]) + __uint_as_float(rr[1]); }
    const float inv = 1.f / lrun;
    GAS bf16_t* orow = O + (size_t)(R0 + r) * opitch;
#pragma unroll
    for (int db = 0; db < 2; ++db)
#pragma unroll
        for (int g = 0; g < 4; ++g) {
            u32x2 wv; wv.x = cvtpk(o[db][4 * g + 0] * inv, o[db][4 * g + 1] * inv); wv.y = cvtpk(o[db][4 * g + 2] * inv, o[db][4 * g + 3] * inv);
            *(GAS u32x2*)(orow + 32 * db + 8 * g + 4 * h) = wv;
        }
#undef ATP_LOADK
#undef ATP_LOADV
#undef ATP_STOREK
#undef ATP_STOREV
#undef ATP_SKIP
#undef ATP_ITER_FAST
#undef ATP_ITER_GEN
#undef ATP_KF
#undef ATP_VF
#undef ATP_SB
}

__device__ __forceinline__ int map_col(int kind, int off, int n) {
    switch (kind) {
    case 1: {
        if (n < 256) return n;
        if (n < 512) { const int j = n - 256; if (j < 128) return 256 + j; if (j < 160) { const int p = j - 128; return 384 + 16 * ((p >> 2) & 1) + 4 * (p >> 3) + (p & 3); } return -1; }
        if (n < 1024) return 416 + (n - 512);
        if (n < 1280) return 928 + (n - 1024);
        return 1184 + (n - 1280);
    }
    case 2: {
        if (n < 512) return (n >> 6) * 96 + (n & 63);
        const int j = n - 512, hd = j >> 5, p = j & 31; return hd * 96 + 64 + 16 * ((p >> 2) & 1) + 4 * (p >> 3) + (p & 3);
    }
    case 3: {
        if (n < 512) return (n >> 6) * 128 + (n & 63);
        const int j = n - 512; return (j >> 6) * 128 + 64 + (j & 63);
    }
    default: return off + n;
    }
}
__device__ __forceinline__ void conv_item(const float* W, int K, int Nsrc, const float* gain, bf16_t* WT, int Ndst, int kind, int off, LAS float* scr, int it, int lane) {
    const int nblk = Ndst / 64;
    const int kq = lane >> 4, n4 = lane & 15;
    const int kb = it / nblk, nb = it % nblk, k0 = 64 * kb, n0 = 64 * nb;
    const int src = map_col(kind, off, n0 + 4 * n4);
    f32x4 v[16];
#pragma unroll
    for (int i = 0; i < 16; ++i) { v[i] = (f32x4){0.f, 0.f, 0.f, 0.f}; if (src >= 0) v[i] = *(const f32x4*)(W + (size_t)(k0 + 4 * i + kq) * Nsrc + src); }
    if (gain) {
#pragma unroll
        for (int i = 0; i < 16; ++i) v[i] = v[i] * gain[k0 + 4 * i + kq];
    }
#pragma unroll
    for (int i = 0; i < 16; ++i) { LAS float* d = scr + (4 * i + kq) * 65 + 4 * n4; d[0] = v[i][0]; d[1] = v[i][1]; d[2] = v[i][2]; d[3] = v[i][3]; }
    asm volatile("s_waitcnt lgkmcnt(0)" ::: "memory");
    const int c = lane & 7;
#pragma unroll
    for (int j = 0; j < 8; ++j) { const int n = (lane >> 3) + 8 * j; const LAS float* sp = scr + (8 * c) * 65 + n;
        u32x4 o; o.x = cvtpk(sp[0 * 65], sp[1 * 65]); o.y = cvtpk(sp[2 * 65], sp[3 * 65]); o.z = cvtpk(sp[4 * 65], sp[5 * 65]); o.w = cvtpk(sp[6 * 65], sp[7 * 65]);
        *(u32x4*)(WT + (size_t)(n0 + n) * K + k0 + 8 * c) = o; }
    asm volatile("s_waitcnt lgkmcnt(0)" ::: "memory");
}
__device__ __forceinline__ float row_to_bf16(const float* xrow, bf16_t* orow, int lane) {
    const f32x4* xr = (const f32x4*)xrow + lane;
    f32x4 v[4]; float s = 0.f;
#pragma unroll
    for (int j = 0; j < 4; ++j) { v[j] = xr[64 * j]; s += (v[j][0] * v[j][0] + v[j][1] * v[j][1]) + (v[j][2] * v[j][2] + v[j][3] * v[j][3]); }
    u32x2* o8 = (u32x2*)orow + lane;
#pragma unroll
    for (int j = 0; j < 4; ++j) { u32x2 wv; wv.x = cvtpk(v[j][0], v[j][1]); wv.y = cvtpk(v[j][2], v[j][3]); o8[64 * j] = wv; }
    return wave_sum(s);
}
__device__ __forceinline__ float rope_inv(int i) {
    const float t[16] = {1.000000000e+00f, 5.623413324e-01f, 3.162277639e-01f, 1.778279394e-01f, 1.000000015e-01f, 5.623412877e-02f, 3.162277862e-02f, 1.778279431e-02f,
                         9.999999776e-03f, 5.623413250e-03f, 3.162277862e-03f, 1.778279431e-03f, 1.000000047e-03f, 5.623413017e-04f, 3.162277862e-04f, 1.778279402e-04f};
    float r = t[0];
#pragma unroll
    for (int k = 1; k < 16; ++k) r = (i == k) ? t[k] : r;
    return r;
}

#define XB_TMO      128
#define XB_XCNT(j)  (256  + 64 * (j))
#define XB_XSUB(j)  (1280 + 64 * (j))
#define XB_XGEN(j)  (2304 + 64 * (j))
#define XB_TOP      3328
#define XB_TOPGEN   3392
#define XCD_BAR_WORDS 3456
#define XB_SPIN_CAP (1u << 18)

__device__ __forceinline__ unsigned xb_ld(unsigned* p)              { return __hip_atomic_load(p, __ATOMIC_RELAXED, __HIP_MEMORY_SCOPE_AGENT); }
__device__ __forceinline__ unsigned xb_add(unsigned* p, unsigned v) { return __hip_atomic_fetch_add(p, v, __ATOMIC_RELAXED, __HIP_MEMORY_SCOPE_AGENT); }
__device__ __forceinline__ unsigned xb_xcc_id() { return (unsigned)__builtin_amdgcn_s_getreg((3 << 11) | 20) & 0xFu; }
#define XB_SPIN(cond, bar) do { unsigned _sp = 0; while (cond) { __builtin_amdgcn_s_sleep(1); \
    if ((++_sp & 255u) == 0u) { if (xb_ld(&(bar)[XB_TMO])) break; if (_sp > XB_SPIN_CAP) { atomicAdd(&(bar)[XB_TMO], 1u); break; } } } } while (0)

struct XcdBarrier {
    unsigned* bar; unsigned x;
    volatile LAS unsigned* st;
};

__device__ __forceinline__ XcdBarrier xcd_barrier_post(unsigned* bar, volatile LAS unsigned* st) {
    XcdBarrier b; b.bar = bar; b.x = xb_xcc_id(); b.st = st;
    if (threadIdx.x == 0) (void)xb_add(&bar[XB_XCNT(b.x)], 1u);
    return b;
}
__device__ __forceinline__ void xcd_barrier_complete(unsigned* bar, unsigned x, unsigned& nloc, unsigned& nx) {
    const unsigned G = gridDim.x * gridDim.y * gridDim.z;
    unsigned sum, cnt, mine, sp = 0u;
    for (;;) {
        sum = 0u; cnt = 0u; mine = 0u;
#pragma unroll
        for (unsigned j = 0; j < 16; ++j) { const unsigned c = xb_ld(&bar[XB_XCNT(j)]); sum += c; cnt += (c > 0u) ? 1u : 0u; mine = (j == x) ? c : mine; }
        if (sum == G) break;
        __builtin_amdgcn_s_sleep(1);
        if ((++sp & 255u) == 0u) { if (xb_ld(&bar[XB_TMO])) break; if (sp > XB_SPIN_CAP) { atomicAdd(&bar[XB_TMO], 1u); break; } }
    }
    nloc = mine > 0u ? mine : 1u; nx = cnt > 0u ? cnt : 1u;
}

__device__ __forceinline__ void xcd_barrier(const XcdBarrier& b) {
    asm volatile("s_waitcnt vmcnt(0)" ::: "memory");
    __syncthreads();
    if (threadIdx.x == 0) {
        unsigned* bar = b.bar;
        __builtin_amdgcn_s_waitcnt(0);
        unsigned nloc = b.st[0], nx = b.st[1];
        if (nloc == 0u) { xcd_barrier_complete(bar, b.x, nloc, nx); b.st[0] = nloc; b.st[1] = nx; }
        const unsigned old = xb_add(&bar[XB_XSUB(b.x)], 1u);
        const unsigned gen = old / nloc;
        if (old + 1u == (gen + 1u) * nloc) {
            __builtin_amdgcn_fence(__ATOMIC_RELEASE, "agent");
            asm volatile("s_waitcnt vmcnt(0)" ::: "memory");
            const unsigned og = xb_add(&bar[XB_TOP], 1u);
            const unsigned tg = og / nx;
            if (og + 1u == (tg + 1u) * nx) xb_add(&bar[XB_TOPGEN], 1u);
            else XB_SPIN(xb_ld(&bar[XB_TOPGEN]) == tg, bar);
            __builtin_amdgcn_fence(__ATOMIC_ACQUIRE, "agent");
            xb_add(&bar[XB_XGEN(b.x)], 1u);
            asm volatile("s_waitcnt vmcnt(0)" ::: "memory");
        } else {
            XB_SPIN(xb_ld(&bar[XB_XGEN(b.x)]) == gen, bar);
            __builtin_amdgcn_fence(__ATOMIC_ACQUIRE, "agent");
            asm volatile("s_waitcnt vmcnt(0)" ::: "memory");
        }
    }
    __syncthreads();
}

constexpr int LDS_BYTES = 147456;
__global__ void __launch_bounds__(512, 2) fwd_mega(Args a) {
    extern __shared__ __attribute__((aligned(16))) unsigned char lds_raw[];
    LAS unsigned char* lds = (LAS unsigned char*)lds_raw;
    cg::grid_group grid = cg::this_grid();
    const int tid = threadIdx.x, lane = tid & 63, wave = __builtin_amdgcn_readfirstlane(tid >> 6);
    const int G = gridDim.x, bid = blockIdx.x;
    unsigned char* ws_k = a.ws;

    {
        unsigned char* ws = ws_k;
        bf16_t* XB = (bf16_t*)(ws + WS_XB);
        float* RS = (float*)(ws + WS_RSP);
        LAS float* scr = (LAS float*)(lds + wave * 16896);
        const int gw = bid * 8 + wave, ngw = G * 8;
        constexpr int IT_WG = 448, IT_UQ = 1216, IT_UKV = 1264, IT_MEM = 1296, IT_O0 = 1552, IT_O1 = 1680, IT_O2 = 1808, IT_OUT = 1936, IT_UP = 2192, IT_DOWN = 3216, IT_LAYER = 4240;
        for (int itg = gw; itg < NL * IT_LAYER; itg += ngw) {
            const int l = itg / IT_LAYER, r = itg % IT_LAYER;
            bf16_t* WL = (bf16_t*)(ws + WS_W + (size_t)l * W_LAYER_BYTES);
            const float* Wp; const float* gp = nullptr; bf16_t* Dp; int Kk, Ns, Nd, kind = 0, off = 0, it;
            if (r < IT_WG)        { it = r;           Wp = a.in[I_W_IN] + (size_t)l * D * INCOLS; Kk = D; Ns = INCOLS; gp = a.in[I_ATTN_NORM] + l * D; Dp = WL + W_IN; Nd = 1792; kind = 1; }
            else if (r < IT_UQ)   { it = r - IT_WG;   Wp = a.in[I_W_IN] + (size_t)l * D * INCOLS; Kk = D; Ns = INCOLS; gp = a.in[I_ATTN_NORM] + l * D; Dp = WL + W_G; Nd = 3072; off = 1696; }
            else if (r < IT_UKV)  { it = r - IT_UQ;   Wp = a.in[I_W_UQ] + (size_t)l * 256 * 768; Kk = 256; Ns = 768; gp = a.in[I_QNORM] + l * 256; Dp = WL + W_UQ; Nd = 768; kind = 2; }
            else if (r < IT_MEM)  { it = r - IT_UKV;  Wp = a.in[I_W_UKV] + (size_t)l * 128 * 1024; Kk = 128; Ns = 1024; gp = a.in[I_KVNORM] + l * 128; Dp = WL + W_UKV; Nd = 1024; kind = 3; }
            else if (r < IT_O0)   { it = r - IT_MEM;  Wp = a.in[I_W_MEMKV] + (size_t)l * D * 1024; Kk = D; Ns = 1024; gp = a.in[I_MEM_NORM] + l * D; Dp = WL + W_MEM; Nd = 1024; }
            else if (r < IT_O1)   { it = r - IT_O0;   Wp = a.in[I_WO_MLA] + (size_t)l * 512 * D; Kk = 512; Ns = D; Dp = WL + W_O; Nd = 1024; }
            else if (r < IT_O2)   { it = r - IT_O1;   Wp = a.in[I_WO_SWA] + (size_t)l * 512 * D; Kk = 512; Ns = D; Dp = WL + W_O + (size_t)1024 * 512; Nd = 1024; }
            else if (r < IT_OUT)  { it = r - IT_O2;   Wp = a.in[I_WO_MEM] + (size_t)l * 512 * D; Kk = 512; Ns = D; Dp = WL + W_O + (size_t)2 * 1024 * 512; Nd = 1024; }
            else if (r < IT_UP)   { it = r - IT_OUT;  Wp = a.in[I_W_OUT] + (size_t)l * D * D; Kk = D; Ns = D; Dp = WL + W_OUT; Nd = 1024; }
            else if (r < IT_DOWN) { it = r - IT_UP;   Wp = a.in[I_W_UP] + (size_t)l * D * DFF; Kk = D; Ns = DFF; gp = a.in[I_MLP_NORM] + l * D; Dp = WL + W_UP; Nd = 4096; }
            else                  { it = r - IT_DOWN; Wp = a.in[I_W_DOWN] + (size_t)l * DFF * D; Kk = DFF; Ns = D; Dp = WL + W_DOWN; Nd = 1024; }
            conv_item(Wp, Kk, Ns, gp, Dp, Nd, kind, off, scr, it, lane);
        }
        for (int m = gw; m < S; m += ngw) { const float ss = row_to_bf16(a.in[I_X] + (size_t)m * D, XB + (size_t)m * D, lane); if (lane < 16) RS[(size_t)m * 16 + lane] = (lane == 0) ? ss : 0.f; }
        { bf16_t* MEMB = (bf16_t*)(ws + WS_MEMB); float* RSTDM = (float*)(ws + WS_RSTDM);
          for (int m = gw; m < MEML; m += ngw) { const float ss = row_to_bf16(a.in[I_MEM] + (size_t)m * D, MEMB + (size_t)m * D, lane); if (lane == 0) RSTDM[m] = 1.0f / sqrtf(ss * (1.0f / D) + EPS); } }
        const int gt = bid * 512 + tid, ngt = G * 512;
        { f32x2* ROPE = (f32x2*)(ws + WS_ROPE);
          for (int i = gt; i < S * 16; i += ngt) {
            const int pos = i >> 4, fi = i & 15;
            const float ang = (float)pos * rope_inv(fi);
            const double rev = (double)ang * 0.15915494309189535;
            const float fr = (float)(rev - __builtin_rint(rev));
            f32x2 cs; cs.x = __builtin_amdgcn_cosf(fr); cs.y = __builtin_amdgcn_sinf(fr);
            ROPE[i] = cs;
          } }
        { float* BIAS = (float*)(ws + WS_BIAS);
          for (int i = gt; i < 8 * 128; i += ngt) {
            const int hh = i >> 7, n = i & 127;
            int bucket = n;
            if (n >= 16) { const float lg = __builtin_amdgcn_logf((float)n * 0.0625f) * (16.0f / 3.0f); bucket = 16 + (int)lg; if (bucket > 31) bucket = 31; }
            BIAS[i] = a.in[I_RELB][bucket * 8 + hh] * LOG2E;
          } }
        { float* BG = (float*)(ws + WS_BG); float* SK = (float*)(ws + WS_SINK); float* FN = (float*)(ws + WS_FN);
          for (int i = gt; i < 2 * 3072; i += ngt) BG[i] = a.in[I_B_GATE][i];
          for (int i = gt; i < 16; i += ngt) SK[i] = a.in[I_SINKS][i] * LOG2E;
          for (int i = gt; i < 1024; i += ngt) FN[i] = a.in[I_FNORM][i];
          for (int i = gt; i < 4096; i += ngt) ((unsigned*)(ws + WS_BAR))[i] = 0u;
          if (gt == 0) { unsigned long long* pt = (unsigned long long*)(ws + WS_PTAB); pt[0] = (unsigned long long)(uintptr_t)a.in[I_X]; pt[1] = (unsigned long long)(uintptr_t)a.out; } }
    }
    if (tid < 2) ((volatile LAS unsigned*)(lds + 143360))[tid] = 0u;
    grid.sync();
    const XcdBarrier xbar = xcd_barrier_post((unsigned*)(ws_k + WS_BAR), (volatile LAS unsigned*)(lds + 143360));

    constexpr int NSTEPS = 14 * NL;
    for (int step = 0; step < NSTEPS; ++step) {
        bool do_sync = true;
        const int l = step / 14, k = step % 14;
        unsigned char* ws = ws_k; asm volatile("" : "+s"(ws));
        if (k == 4) {
            int tidv = threadIdx.x; asm volatile("" : "+v"(tidv));
            GAS unsigned char* wsg = (GAS unsigned char*)ws;
            GAS bf16_t* QMLA = (GAS bf16_t*)(wsg + WS_QMLA); GAS bf16_t* KMLA = (GAS bf16_t*)(wsg + WS_KMLA); GAS bf16_t* VMLA = (GAS bf16_t*)(wsg + WS_VMLA); GAS bf16_t* OMLA = (GAS bf16_t*)(wsg + WS_OMLA);
            for (int u = bid; u < 256; u += G) {
                const int hh = u & 7, j = u >> 3;
                for (int kk = 0; kk < 2; ++kk) {
                    const int qb = kk == 0 ? 63 - j : j;
                    attn_unit_pipe<96, 0, true>(lds, QMLA + hh * 96, 768, KMLA + hh * 96, 768, VMLA + (size_t)(hh * 64) * S, S, OMLA + hh * 64, 512, 256 * qb, 0, 4 * (qb + 1), nullptr, 0.f, tidv);
                }
            }
            tidv = threadIdx.x; asm volatile("" : "+v"(tidv));
            GAS bf16_t* QS = (GAS bf16_t*)(wsg + WS_QS); GAS bf16_t* KS = (GAS bf16_t*)(wsg + WS_KS); GAS bf16_t* VS = (GAS bf16_t*)(wsg + WS_VS);
            const GAS float* BIAS = (const GAS float*)(wsg + WS_BIAS); const GAS float* SK = (const GAS float*)(wsg + WS_SINK);
            for (int u = bid; u < 512; u += G) {
                const int hh = u >> 6, qb = u & 63, g = hh >> 2;
                const int tb = 4 * qb - 2 < 0 ? 0 : 4 * qb - 2;
                attn_unit<64, 64, 1>(lds, QS + hh * 64, 512, KS + g * 64, 128, VS + g * 64, 128, QS + hh * 64, 512, 256 * qb, tb, 4 * qb + 4, BIAS + hh * 128, SK[l * 8 + hh], tidv);
            }
            tidv = threadIdx.x; asm volatile("" : "+v"(tidv));
            GAS bf16_t* QM = (GAS bf16_t*)(wsg + WS_QM); GAS bf16_t* KMEM = (GAS bf16_t*)(wsg + WS_KMEM); GAS bf16_t* VMEM = (GAS bf16_t*)(wsg + WS_VMEM);
            for (int u = bid; u < 256; u += G) {
                const int hh = u >> 6, qb = u & 63;
                attn_unit<128, 128, 2>(lds, QM + hh * 128, 512, KMEM + hh * 128, 512, VMEM + hh * 128, 512, QM + hh * 128, 512, 256 * qb, 0, 4, nullptr, 0.f, tidv);
            }
        } else {
            const bf16_t* WL = (const bf16_t*)(ws + WS_W + (size_t)l * W_LAYER_BYTES);
            const bf16_t* XB = (const bf16_t*)(ws + WS_XB);
            pg8::Gemm g{}; Epi E{}; int cid = bid;
            E.ws = ws; E.layer = l;
            switch (k) {
            case 0: g = pg8::Gemm{XB, WL + W_IN, S, 1792, 1024}; E.mode = M_WIN; do_sync = false; break;
            case 1: g = pg8::Gemm{(const bf16_t*)(ws + WS_MEMB), WL + W_MEM, MEML, 1024, 1024}; E.mode = M_MEM; cid = G - 1 - bid; break;
            case 2: g = pg8::Gemm{(const bf16_t*)(ws + WS_CQ), WL + W_UQ, S, 768, 256}; E.mode = M_UQ; do_sync = false; break;
            case 3: g = pg8::Gemm{(const bf16_t*)(ws + WS_CKV), WL + W_UKV, S, 1024, 128}; E.mode = M_UKV; cid = G - 1 - bid; break;
            case 5: case 7: case 9: { const int br = (k - 5) >> 1; g = pg8::Gemm{XB, WL + W_G + (size_t)br * 1024 * 1024, S, 1024, 1024}; E.mode = M_GATE; E.br = br; do_sync = false; } break;
            case 6: case 8: case 10: { const int br = (k - 6) >> 1; const bf16_t* Ab = (const bf16_t*)(ws + (br == 0 ? WS_OMLA : (br == 1 ? WS_QS : WS_QM)));
                    g = pg8::Gemm{Ab, WL + W_O + (size_t)br * 1024 * 512, S, 1024, 512}; E.mode = M_Z; E.br = br; do_sync = (k == 10); } break;
            case 11: g = pg8::Gemm{(const bf16_t*)(ws + WS_YB), WL + W_OUT, S, 1024, 1024}; E.mode = M_RES; E.br = 0; break;
            case 12: g = pg8::Gemm{XB, WL + W_UP, S, 4096, 1024}; E.mode = M_UP; break;
            default: g = pg8::Gemm{(const bf16_t*)(ws + WS_H), WL + W_DOWN, S, 1024, 4096}; E.mode = M_RES; E.br = 1; break;
            }
            pg8::StaticOrder SO; SO.init(g.M, g.N, G, cid);
            pg8::gemm_phase<Epi, pg8::StaticOrder, true, true>(lds, g, SO, E);
        }
        if (do_sync) xcd_barrier(xbar);
    }
    {
        unsigned char* ws = ws_k;
        int tidf = threadIdx.x; asm volatile("" : "+v"(tidf));
        const int lane = tidf & 63, wave = __builtin_amdgcn_readfirstlane(tidf >> 6);
        const int gw = bid * 8 + wave, ngw = G * 8;
        float* X = *(float* const*)(ws + WS_PTAB + 8);
        const float* rsf = (const float*)(ws + WS_RSP) + (size_t)(4 * NL) * S * 16;
        const f32x4* gn = (const f32x4*)(ws + WS_FN) + lane;
        const bf16_t* XBf = (const bf16_t*)(ws + WS_XB);
        for (int m = gw; m < S; m += ngw) {
            f32x4* xr = (f32x4*)(X + (size_t)m * D) + lane;
            const u32x2* xb = (const u32x2*)(XBf + (size_t)m * D) + lane;
            float rsum = 0.f;
#pragma unroll
            for (int k4 = 0; k4 < 4; ++k4) { const f32x4 p = *(const f32x4*)(rsf + (size_t)m * 16 + 4 * k4); rsum += (p[0] + p[1]) + (p[2] + p[3]); }
            const float rstd = 1.0f / sqrtf(rsum * (1.0f / D) + EPS);
#pragma unroll
            for (int j = 0; j < 4; ++j) { const u32x2 p = xb[64 * j]; f32x4 v = {bf_lo(p.x), bf_hi(p.x), bf_lo(p.y), bf_hi(p.y)}; v = v * rstd * gn[64 * j]; xr[64 * j] = v; }
        }
    }
}

extern "C" void kernel_launch(void* const* d_in, const int* in_sizes, int n_in, void* d_out, int out_size, void* d_ws, size_t ws_size, hipStream_t stream) {
    static int grid = 0;
    if (grid == 0) {
        int dev = 0, cus = 0, per_cu = 0;
        (void)hipGetDevice(&dev);
        (void)hipDeviceGetAttribute(&cus, hipDeviceAttributeMultiprocessorCount, dev);
        (void)hipFuncSetAttribute((const void*)fwd_mega, hipFuncAttributeMaxDynamicSharedMemorySize, LDS_BYTES);
        (void)hipOccupancyMaxActiveBlocksPerMultiprocessor(&per_cu, (const void*)fwd_mega, 512, LDS_BYTES);
        if (per_cu < 1) per_cu = 1;
        grid = cus * per_cu;
        if (grid <= 0) grid = 256;
    }
    Args a{};
    for (int i = 0; i < 21; ++i) a.in[i] = (const float*)d_in[i];
    a.out = (float*)d_out; a.ws = (unsigned char*)d_ws;
    void* args[] = {&a};
    hipError_t e = hipLaunchCooperativeKernel((void*)fwd_mega, dim3(grid), dim3(512), args, LDS_BYTES, stream);
    if (e != hipSuccess) fprintf(stderr, "cooperative launch failed: %s (grid %d)\n", hipGetErrorString(e), grid);
}
```

```cpp
#include <hip/hip_runtime.h>
#include <hip/hip_cooperative_groups.h>
#include <cstdio>
#include <cstdint>
namespace cg = cooperative_groups;
namespace pg8 {
#define PG8_LAS __attribute__((address_space(3)))
typedef unsigned short bf16_t;
typedef short bf16x8 __attribute__((ext_vector_type(8)));
typedef float f32x4 __attribute__((ext_vector_type(4)));
typedef unsigned u32x4 __attribute__((ext_vector_type(4)));
constexpr int BM = 256, BK = 64, HALF = 128, HTB = HALF * BK * 2  , STAGE_BYTES = 8 * HTB, NXCD = 8, WGM = 8;

__host__ __device__ __forceinline__ int lds_byte(int r, int c) { const int st = (r >> 4) * 2 + (c >> 5), rr = r & 15, cc = c & 31, ob = rr * 64 + cc * 2; return st * 1024 + (ob ^ (((ob >> 9) & 1) << 5)); }
__host__ __device__ __forceinline__ void stage_rc(int b, int& R, int& C) { const int st = b / 1024, sb = b % 1024, swz = sb ^ (((sb >> 9) & 1) << 5); R = (st >> 1) * 16 + swz / 64; C = (st & 1) * 32 + (swz % 64) / 2; }
__host__ __device__ __forceinline__ int perm32(int rho) { const int n = rho >> 4, i = rho & 15; return 8 * (i >> 2) + 4 * n + (i & 3); }

struct Unit { int pm, pn; };
struct Gemm { const bf16_t* A; const bf16_t* Bt; int M, N, K; };

struct StaticOrder {
    int nM, nN, nwg, G, c;
    __host__ __device__ void init(int M, int N, int G_, int c_) { nM = M / BM; nN = N / BM; nwg = nM * nN; G = G_; c = c_; }
    __host__ __device__ bool next(int i, Unit& u) const {
        const long L = (long)i * G + c; if (L >= nwg) return false;
        int wgid = (int)L; { const int q = nwg / NXCD, r = nwg % NXCD, xcd = wgid % NXCD, off = wgid / NXCD; wgid = (xcd < r ? xcd * (q + 1) : r * (q + 1) + (xcd - r) * q) + off; }
        const int nig = WGM * nN, gid = wgid / nig, fm = gid * WGM, gsz = (nM - fm) < WGM ? (nM - fm) : WGM;
        u.pm = fm + ((wgid % nig) % gsz); u.pn = (wgid % nig) / gsz; return true;
    }
    __device__ __forceinline__ void a_ready(const Unit&) const {}
    __device__ __forceinline__ void done(const Unit&) const {}
};

__device__ __forceinline__ unsigned cvt_pk_bf16(float lo, float hi) { unsigned r; asm volatile("v_cvt_pk_bf16_f32 %0, %1, %2" : "=v"(r) : "v"(lo), "v"(hi)); return r; }
typedef float f32x2 __attribute__((ext_vector_type(2)));
template <class Epi, class Sched, bool ALIGN_EPI = false, bool SP2 = false>
__device__ __forceinline__ void gemm_phase(PG8_LAS unsigned char* lds, const Gemm g, const Sched& S, const Epi& E) {
    int tid_o = threadIdx.x; asm volatile("" : "+v"(tid_o));
    const int tid = tid_o, wid = __builtin_amdgcn_readfirstlane(tid >> 6), lane = tid & 63, wr = wid >> 2, wc = wid & 3, fr = lane & 15, fq = lane >> 4;
    const int K = g.K, nt = K / BK;
    unsigned voffA[2], voffB[2];
#pragma unroll
    for (int i = 0; i < 2; ++i) { int R, C; stage_rc(tid * 16 + i * 8192, R, C); const int Rb = Epi::PERM ? ((R & ~31) + perm32(R & 31)) : R;
        voffA[i] = (unsigned)(R * K + C) * 2u; voffB[i] = (unsigned)(Rb * K + C) * 2u; }
    const size_t kstep = (size_t)(BK * 2);
    const size_t hstep = (size_t)HALF * K * 2;
    const size_t tstep = 2 * hstep;
    const unsigned ldsw = (unsigned)wid * 1024u;
    const int aoff = lds_byte(wr * 64 + fr, fq * 8), boff = lds_byte(wc * 32 + fr, fq * 8);
#define PG8_SA(b, h) (((b) * 2 + (h)) * HTB)
#define PG8_SB(b, h) ((4 + (b) * 2 + (h)) * HTB)
#define PG8_STAGE(bufoff, gbase, voff) do { _Pragma("unroll") for (int _i = 0; _i < 2; ++_i) \
        __builtin_amdgcn_global_load_lds((const unsigned*)((const char*)(gbase) + (voff)[_i]), (PG8_LAS unsigned*)(lds + (bufoff) + ldsw + _i * 8192), 16, 0, 0); } while (0)
#define PG8_LDA(dst, b, h) do { _Pragma("unroll") for (int m = 0; m < 4; ++m) _Pragma("unroll") for (int k = 0; k < 2; ++k) dst[m][k] = *(const PG8_LAS bf16x8*)(lds + PG8_SA(b, h) + aoff + m * 2048 + k * 1024); } while (0)
#define PG8_LDB(dst, b, h) do { _Pragma("unroll") for (int n = 0; n < 2; ++n) _Pragma("unroll") for (int k = 0; k < 2; ++k) dst[n][k] = *(const PG8_LAS bf16x8*)(lds + PG8_SB(b, h) + boff + n * 2048 + k * 1024); } while (0)
#define PG8_MMA(ai, bj, At, Bt) do { __builtin_amdgcn_s_setprio(1); _Pragma("unroll") for (int m = 0; m < 4; ++m) _Pragma("unroll") for (int n = 0; n < 2; ++n) _Pragma("unroll") for (int k = 0; k < 2; ++k) \
        acc[ai][bj][m][n] = __builtin_amdgcn_mfma_f32_16x16x32_bf16(Bt[n][k], At[m][k], acc[ai][bj][m][n], 0, 0, 0); __builtin_amdgcn_s_setprio(0); } while (0)
#define PG8_WAIT_V(n) asm volatile("s_waitcnt vmcnt(" #n ")" ::: "memory")
#define PG8_WAIT_L(n) asm volatile("s_waitcnt lgkmcnt(" #n ")" ::: "memory")
#define PG8_BAR __builtin_amdgcn_s_barrier()
#define PG8_SCHED __builtin_amdgcn_sched_barrier(0)
    Unit cur, nxt; int ui = 0;
    if (!S.next(0, cur)) return;
    f32x4 acc[2][2][4][2];
#pragma unroll
    for (int a = 0; a < 2; ++a)
#pragma unroll
        for (int b = 0; b < 2; ++b)
#pragma unroll
            for (int m = 0; m < 4; ++m)
#pragma unroll
                for (int n = 0; n < 2; ++n) acc[a][b][m][n] = (f32x4){0.f, 0.f, 0.f, 0.f};
    bf16x8 At[4][2], B0[2][2], B1[2][2];
    const char* cA = (const char*)g.A + (size_t)cur.pm * tstep; const char* cB = (const char*)g.Bt + (size_t)cur.pn * tstep;
    S.a_ready(cur);
    if constexpr (SP2) {
        PG8_STAGE(PG8_SB(0, 0), cB, voffB); PG8_STAGE(PG8_SB(0, 1), cB + hstep, voffB); PG8_STAGE(PG8_SA(0, 0), cA, voffA); PG8_STAGE(PG8_SA(0, 1), cA + hstep, voffA);
        if (wr == 1) PG8_BAR;
        PG8_WAIT_V(2); PG8_BAR;
        PG8_STAGE(PG8_SB(1, 0), cB + kstep, voffB); PG8_STAGE(PG8_SA(1, 0), cA + kstep, voffA); PG8_STAGE(PG8_SB(1, 1), cB + hstep + kstep, voffB);
        PG8_WAIT_V(6); PG8_BAR;
    } else {
        PG8_STAGE(PG8_SB(0, 0), cB, voffB); PG8_STAGE(PG8_SA(0, 0), cA, voffA); PG8_STAGE(PG8_SB(0, 1), cB + hstep, voffB); PG8_STAGE(PG8_SA(0, 1), cA + hstep, voffA);
        if (wr == 1) PG8_BAR;
        PG8_WAIT_V(4); PG8_BAR;
        PG8_STAGE(PG8_SB(1, 0), cB + kstep, voffB); PG8_STAGE(PG8_SA(1, 0), cA + kstep, voffA); PG8_STAGE(PG8_SB(1, 1), cB + hstep + kstep, voffB);
        PG8_WAIT_V(6); PG8_BAR;
    }
    for (;;) {
        const bool has_next = S.next(ui + 1, nxt);
        const char* nA = has_next ? (const char*)g.A + (size_t)nxt.pm * tstep : cA; const char* nB = has_next ? (const char*)g.Bt + (size_t)nxt.pn * tstep : cB;
        for (int t = 0; t < nt; t += 2) {
            const bool last = (t == nt - 2);
            const char* a1 = cA + (size_t)(t + 1) * kstep;
            const char* a2 = last ? nA : cA + (size_t)(t + 2) * kstep; const char* b2 = last ? nB : cB + (size_t)(t + 2) * kstep;
            const char* a3 = a2 + kstep; const char* b3 = b2 + kstep;
            if (last && has_next) S.a_ready(nxt);
            if constexpr (SP2) {
            PG8_LDB(B0, 0, 0); PG8_LDB(B1, 0, 1); PG8_SCHED; PG8_LDA(At, 0, 0); PG8_STAGE(PG8_SA(1, 1), a1 + hstep, voffA);
            PG8_WAIT_V(8); PG8_WAIT_L(0); PG8_BAR; PG8_MMA(0, 0, At, B0); PG8_MMA(0, 1, At, B1); PG8_BAR; PG8_SCHED;
            PG8_LDA(At, 0, 1); PG8_STAGE(PG8_SB(0, 0), b2, voffB); PG8_STAGE(PG8_SB(0, 1), b2 + hstep, voffB); PG8_STAGE(PG8_SA(0, 0), a2, voffA);
            PG8_WAIT_V(8); PG8_WAIT_L(0); PG8_BAR; PG8_MMA(1, 0, At, B0); PG8_MMA(1, 1, At, B1); PG8_BAR; PG8_SCHED;
            PG8_LDB(B0, 1, 0); PG8_LDB(B1, 1, 1); PG8_SCHED; PG8_LDA(At, 1, 0); PG8_STAGE(PG8_SA(0, 1), a2 + hstep, voffA);
            PG8_WAIT_V(8); PG8_WAIT_L(0); PG8_BAR; PG8_MMA(0, 0, At, B0); PG8_MMA(0, 1, At, B1); PG8_BAR; PG8_SCHED;
            PG8_LDA(At, 1, 1); PG8_STAGE(PG8_SB(1, 0), b3, voffB); PG8_STAGE(PG8_SB(1, 1), b3 + hstep, voffB); PG8_STAGE(PG8_SA(1, 0), a3, voffA);
            PG8_WAIT_V(8); PG8_WAIT_L(0); PG8_BAR; PG8_MMA(1, 0, At, B0); PG8_MMA(1, 1, At, B1); PG8_BAR; PG8_SCHED;
            } else {
            PG8_LDB(B0, 0, 0); PG8_SCHED; PG8_LDA(At, 0, 0); PG8_STAGE(PG8_SA(1, 1), a1 + hstep, voffA);
            PG8_WAIT_L(8); PG8_BAR; PG8_WAIT_L(0); PG8_MMA(0, 0, At, B0); PG8_BAR; PG8_SCHED;
            PG8_LDB(B1, 0, 1); PG8_STAGE(PG8_SB(0, 0), b2, voffB);
            PG8_BAR; PG8_WAIT_L(0); PG8_MMA(0, 1, At, B1); PG8_BAR;
            PG8_LDA(At, 0, 1); PG8_STAGE(PG8_SA(0, 0), a2, voffA);
            PG8_BAR; PG8_WAIT_L(0); PG8_MMA(1, 0, At, B0); PG8_BAR; PG8_SCHED;
            PG8_STAGE(PG8_SB(0, 1), b2 + hstep, voffB);
            PG8_WAIT_V(6); PG8_BAR; PG8_MMA(1, 1, At, B1); PG8_BAR;
            PG8_LDB(B0, 1, 0); PG8_SCHED; PG8_LDA(At, 1, 0); PG8_STAGE(PG8_SA(0, 1), a2 + hstep, voffA);
            PG8_WAIT_L(8); PG8_BAR; PG8_WAIT_L(0); PG8_MMA(0, 0, At, B0); PG8_BAR; PG8_SCHED;
            PG8_LDB(B1, 1, 1); PG8_STAGE(PG8_SB(1, 0), b3, voffB);
            PG8_BAR; PG8_WAIT_L(0); PG8_MMA(0, 1, At, B1); PG8_BAR;
            PG8_LDA(At, 1, 1); PG8_STAGE(PG8_SA(1, 0), a3, voffA);
            PG8_BAR; PG8_WAIT_L(0); PG8_MMA(1, 0, At, B0); PG8_BAR; PG8_SCHED;
            PG8_STAGE(PG8_SB(1, 1), b3 + hstep, voffB);
            PG8_WAIT_V(6); PG8_BAR; PG8_MMA(1, 1, At, B1); PG8_BAR;
            }
        }
        if constexpr (ALIGN_EPI) { if (wr == 0) PG8_BAR; }
        if constexpr (!Epi::AFTER_DRAIN) { E(acc, cur, wr, wc, fr, fq); S.done(cur); }
        if (!has_next) break;
#pragma unroll
        for (int a = 0; a < 2; ++a)
#pragma unroll
            for (int b = 0; b < 2; ++b)
#pragma unroll
                for (int m = 0; m < 4; ++m)
#pragma unroll
                    for (int n = 0; n < 2; ++n) acc[a][b][m][n] = (f32x4){0.f, 0.f, 0.f, 0.f};
        cur = nxt; cA = nA; cB = nB; ++ui;
        if constexpr (ALIGN_EPI) { if (wr == 1) PG8_BAR; }
    }
    PG8_WAIT_V(0);
    if constexpr (!ALIGN_EPI) { if (wr == 0) PG8_BAR; }
    PG8_BAR;
    if constexpr (Epi::AFTER_DRAIN) { E.fused(acc, cur, wr, wc, fr, fq, lds, wid, lane); S.done(cur); }
#undef PG8_SA
#undef PG8_SB
#undef PG8_STAGE
#undef PG8_LDA
#undef PG8_LDB
#undef PG8_MMA
#undef PG8_WAIT_V
#undef PG8_WAIT_L
#undef PG8_BAR
#undef PG8_SCHED
}
}

typedef unsigned short bf16_t;
typedef short bf16x8 __attribute__((ext_vector_type(8)));
typedef float f32x4 __attribute__((ext_vector_type(4)));
typedef float f32x2 __attribute__((ext_vector_type(2)));
typedef float f32x16 __attribute__((ext_vector_type(16)));
typedef unsigned u32x4 __attribute__((ext_vector_type(4)));
typedef unsigned u32x2 __attribute__((ext_vector_type(2)));
typedef __bf16 bf16x2_t __attribute__((ext_vector_type(2)));
#define LAS __attribute__((address_space(3)))
#define GAS __attribute__((address_space(1)))

constexpr int S = 16384, D = 1024, DFF = 4096, NL = 2, MEML = 256;
constexpr int INCOLS = 4768;
constexpr float EPS = 1e-6f;
constexpr float LOG2E = 1.4426950408889634f;
constexpr float QS_SCALE = 0.125f * LOG2E;
constexpr float QM_SCALE = 0.08838834764831845f * LOG2E;
constexpr float QMLA_SCALE = 0.10206207261596575f * LOG2E;

constexpr size_t W_IN = 0;
constexpr size_t W_G = W_IN + (size_t)1792 * 1024;
constexpr size_t W_UQ = W_G + (size_t)3072 * 1024;
constexpr size_t W_UKV = W_UQ + (size_t)768 * 256;
constexpr size_t W_MEM = W_UKV + (size_t)1024 * 128;
constexpr size_t W_O = W_MEM + (size_t)1024 * 1024;
constexpr size_t W_OUT = W_O + (size_t)3 * 1024 * 512;
constexpr size_t W_UP = W_OUT + (size_t)1024 * 1024;
constexpr size_t W_DOWN = W_UP + (size_t)4096 * 1024;
constexpr size_t W_LAYER_ELEMS = W_DOWN + (size_t)1024 * 4096;
constexpr size_t MiB = 1u << 20;
constexpr size_t W_LAYER_BYTES = 34 * MiB;
static_assert(W_LAYER_ELEMS * 2 <= W_LAYER_BYTES, "weights");
constexpr size_t WS_W = 0;
constexpr size_t WS_XB = 68 * MiB;
constexpr size_t WS_SMALL = 100 * MiB;
constexpr size_t WS_RS = WS_SMALL;
constexpr size_t WS_RSTDM = WS_RS + 9 * (size_t)S * 4;
constexpr size_t WS_BIAS = WS_RSTDM + 1024;
constexpr size_t WS_ROPE = WS_BIAS + 4096;
constexpr size_t WS_MEMB = WS_ROPE + (size_t)S * 16 * 8;
constexpr size_t WS_KMEM = WS_MEMB + (size_t)256 * 1024 * 2;
constexpr size_t WS_VMEM = WS_KMEM + (size_t)256 * 512 * 2;
constexpr size_t WS_PTAB = WS_VMEM + (size_t)256 * 512 * 2;
constexpr size_t WS_BG = WS_PTAB + 64;
constexpr size_t WS_SINK = WS_BG + 2 * 3072 * 4;
constexpr size_t WS_FN = WS_SINK + 64;
constexpr size_t WS_BAR = WS_FN + 4096;
static_assert(WS_BAR + 16384 <= 104 * MiB, "small region");
constexpr size_t WS_H = 104 * MiB;
constexpr size_t WS_QMLA = 104 * MiB;
constexpr size_t WS_KMLA = 128 * MiB;
constexpr size_t WS_VMLA = 152 * MiB;
constexpr size_t WS_QS = 168 * MiB;
constexpr size_t WS_KS = 184 * MiB;
constexpr size_t WS_VS = 188 * MiB;
constexpr size_t WS_QM = 192 * MiB;
constexpr size_t WS_CQ = 208 * MiB;
constexpr size_t WS_CKV = 216 * MiB;
constexpr size_t WS_OMLA = 220 * MiB;
constexpr size_t WS_T = 104 * MiB;
constexpr size_t WS_YB = 136 * MiB;
static_assert(WS_OMLA + (size_t)S * 512 * 2 <= 256 * MiB, "ws");
constexpr size_t WS_RSP = 236 * MiB;
static_assert(WS_RSP + 9 * (size_t)S * 16 * 4 <= 256 * MiB, "ws");

struct Args {
    const float* in[21];
    float* out; unsigned char* ws;
};
enum { I_X = 0, I_MEM, I_RELB, I_ATTN_NORM, I_MEM_NORM, I_W_IN, I_B_GATE, I_QNORM, I_W_UQ, I_KVNORM, I_W_UKV, I_SINKS, I_W_MEMKV, I_WO_MLA, I_WO_SWA, I_WO_MEM, I_W_OUT, I_MLP_NORM, I_W_UP, I_W_DOWN, I_FNORM };

__device__ __forceinline__ unsigned cvtpk(float lo, float hi) { f32x2 v = {lo, hi}; bf16x2_t b = __builtin_convertvector(v, bf16x2_t); return __builtin_bit_cast(unsigned, b); }
__device__ __forceinline__ float bf_lo(unsigned u) { return __uint_as_float(u << 16); }
__device__ __forceinline__ float bf_hi(unsigned u) { return __uint_as_float(u & 0xffff0000u); }
__device__ __forceinline__ float wave_sum(float v) {
#pragma unroll
    for (int o = 1; o < 64; o <<= 1) v += __shfl_xor(v, o);
    return v;
}

enum { M_WIN = 0, M_MEM, M_UQ, M_UKV, M_GATE, M_Z, M_RES, M_UP };
struct Epi {
    static constexpr bool PERM = true, AFTER_DRAIN = false;
    int mode, br, layer; unsigned char* ws;
    __device__ __forceinline__ void store8(GAS bf16_t* dst, const f32x4& a, const f32x4& b) const {
        u32x4 w; w.x = cvtpk(a[0], a[1]); w.y = cvtpk(a[2], a[3]); w.z = cvtpk(b[0], b[1]); w.w = cvtpk(b[2], b[3]);
        *(GAS u32x4*)dst = w;
    }
    __device__ __forceinline__ float sq8(const f32x4& a0, const f32x4& a1) const { return (a0[0]*a0[0] + a0[1]*a0[1]) + (a0[2]*a0[2] + a0[3]*a0[3]) + (a1[0]*a1[0] + a1[1]*a1[1]) + (a1[2]*a1[2] + a1[3]*a1[3]); }
    __device__ __forceinline__ void operator()(const f32x4 (&acc)[2][2][4][2], const pg8::Unit& u, int wr, int wc, int fr_in, int fq_in) const {
        int fr = fr_in, fq = fq_in; asm volatile("" : "+v"(fr), "+v"(fq));
        const int pn = u.pn;
        GAS unsigned char* wsg = (GAS unsigned char*)ws;
        GAS unsigned long long* RS = (GAS unsigned long long*)(wsg + WS_RSP);
        const GAS unsigned long long* rs_in = RS + (size_t)(4 * layer) * S; float inv_k = 1.0f / 1024.0f;
        const GAS float* rstdm = (const GAS float*)(wsg + WS_RSTDM);
        if (mode == M_UQ) { rs_in = RS + (size_t)(4 * layer + 1) * S; inv_k = 1.0f / 256.0f; }
        if (mode == M_UKV) { rs_in = RS + (size_t)(4 * layer + 2) * S; inv_k = 1.0f / 128.0f; }
        if (mode == M_UP) rs_in = RS + (size_t)(4 * layer + 3) * S;
        GAS unsigned long long* rs_out = RS + (size_t)(4 * layer + 1) * S;
        if (mode == M_WIN && pn == 1) rs_out = RS + (size_t)(4 * layer + 2) * S;
        if (mode == M_RES) rs_out = RS + (size_t)(4 * layer + 3 + br) * S;
        const GAS float* resid = nullptr; GAS float* X = nullptr;
        if (mode == M_RES && layer == 0 && br == 0) resid = (const GAS float*)*(const float* const GAS*)(wsg + WS_PTAB);
#pragma unroll
        for (int ai = 0; ai < 2; ++ai)
#pragma unroll
            for (int m = 0; m < 4; ++m) {
                const int row = u.pm * 256 + ai * 128 + wr * 64 + m * 16 + fr;
                float sc = 1.f;
                if (mode == M_MEM) sc = rstdm[row];
                else if (mode != M_Z && mode != M_RES) sc = __builtin_amdgcn_rsqf((float)rs_in[row] * (inv_k * (1.0f / 1048576.0f)) + EPS);
                if (mode == M_UQ) sc *= QMLA_SCALE;
                float ss = 0.f;
#pragma unroll
                for (int bj = 0; bj < 2; ++bj) {
                    const int ct = bj * 128 + wc * 32 + 8 * fq;
                    f32x4 a0 = acc[ai][bj][m][0] * sc, a1 = acc[ai][bj][m][1] * sc;
                    switch (mode) {
                    case M_WIN: {
                        if (pn == 0) { store8((GAS bf16_t*)(wsg + WS_CQ) + (size_t)row * 256 + ct, a0, a1); ss += sq8(a0, a1); }
                        else if (pn == 1) {
                            if (bj == 0) { store8((GAS bf16_t*)(wsg + WS_CKV) + (size_t)row * 128 + ct, a0, a1); ss += sq8(a0, a1); }
                            else if (wc == 0) {
                                const GAS f32x2* cs = (const GAS f32x2*)(wsg + WS_ROPE) + (size_t)row * 16 + 4 * fq;
                                f32x4 o1, o2;
#pragma unroll
                                for (int e = 0; e < 4; ++e) { const f32x2 c = cs[e]; o1[e] = a0[e] * c.x - a1[e] * c.y; o2[e] = a1[e] * c.x + a0[e] * c.y; }
                                u32x2 w1, w2; w1.x = cvtpk(o1[0], o1[1]); w1.y = cvtpk(o1[2], o1[3]); w2.x = cvtpk(o2[0], o2[1]); w2.y = cvtpk(o2[2], o2[3]);
                                GAS bf16_t* kr = (GAS bf16_t*)(wsg + WS_KMLA) + (size_t)row * 768 + 64 + 4 * fq;
#pragma unroll
                                for (int hh = 0; hh < 8; ++hh) { *(GAS u32x2*)(kr + hh * 96) = w1; *(GAS u32x2*)(kr + hh * 96 + 16) = w2; }
                            }
                        }
                        else if (pn < 4) { store8((GAS bf16_t*)(wsg + WS_QS) + (size_t)row * 512 + (pn - 2) * 256 + ct, a0 * QS_SCALE, a1 * QS_SCALE); }
                        else if (pn == 4) { if (bj == 0) store8((GAS bf16_t*)(wsg + WS_KS) + (size_t)row * 128 + ct, a0, a1); else store8((GAS bf16_t*)(wsg + WS_VS) + (size_t)row * 128 + ct - 128, a0, a1); }
                        else { store8((GAS bf16_t*)(wsg + WS_QM) + (size_t)row * 512 + (pn - 5) * 256 + ct, a0 * QM_SCALE, a1 * QM_SCALE); }
                    } break;
                    case M_MEM: {
                        if (pn < 2) store8((GAS bf16_t*)(wsg + WS_KMEM) + (size_t)row * 512 + pn * 256 + ct, a0, a1);
                        else store8((GAS bf16_t*)(wsg + WS_VMEM) + (size_t)row * 512 + (pn - 2) * 256 + ct, a0, a1);
                    } break;
                    case M_UQ: {
                        if (pn < 2) { const int c = pn * 256 + ct; store8((GAS bf16_t*)(wsg + WS_QMLA) + (size_t)row * 768 + (c >> 6) * 96 + (c & 63), a0, a1); }
                        else {
                            const int head = 4 * bj + wc;
                            const GAS f32x2* cs = (const GAS f32x2*)(wsg + WS_ROPE) + (size_t)row * 16 + 4 * fq;
                            f32x4 o1, o2;
#pragma unroll
                            for (int e = 0; e < 4; ++e) { const f32x2 c = cs[e]; o1[e] = a0[e] * c.x - a1[e] * c.y; o2[e] = a1[e] * c.x + a0[e] * c.y; }
                            u32x2 w1, w2; w1.x = cvtpk(o1[0], o1[1]); w1.y = cvtpk(o1[2], o1[3]); w2.x = cvtpk(o2[0], o2[1]); w2.y = cvtpk(o2[2], o2[3]);
                            GAS bf16_t* qrp = (GAS bf16_t*)(wsg + WS_QMLA) + (size_t)row * 768 + head * 96 + 64 + 4 * fq;
                            *(GAS u32x2*)qrp = w1; *(GAS u32x2*)(qrp + 16) = w2;
                        }
                    } break;
                    case M_UKV: {
                        if (pn < 2) { const int c = pn * 256 + ct; store8((GAS bf16_t*)(wsg + WS_KMLA) + (size_t)row * 768 + (c >> 6) * 96 + (c & 63), a0, a1); }
                        else {
                            GAS unsigned short* vt = (GAS unsigned short*)(wsg + WS_VMLA) + (size_t)((pn - 2) * 256 + ct) * S + row;
                            const unsigned w0 = cvtpk(a0[0], a0[1]), w1 = cvtpk(a0[2], a0[3]), w2 = cvtpk(a1[0], a1[1]), w3 = cvtpk(a1[2], a1[3]);
                            vt[0 * (size_t)S] = (unsigned short)(w0 & 0xffffu); vt[1 * (size_t)S] = (unsigned short)(w0 >> 16);
                            vt[2 * (size_t)S] = (unsigned short)(w1 & 0xffffu); vt[3 * (size_t)S] = (unsigned short)(w1 >> 16);
                            vt[4 * (size_t)S] = (unsigned short)(w2 & 0xffffu); vt[5 * (size_t)S] = (unsigned short)(w2 >> 16);
                            vt[6 * (size_t)S] = (unsigned short)(w3 & 0xffffu); vt[7 * (size_t)S] = (unsigned short)(w3 >> 16);
                        }
                    } break;
                    case M_GATE: {
                        const int c = pn * 256 + ct;
                        const GAS float* bg = (const GAS float*)(wsg + WS_BG) + layer * 3072 + br * 1024 + c;
                        const f32x4 b0 = *(const GAS f32x4*)bg, b1 = *(const GAS f32x4*)(bg + 4);
                        f32x4 g0, g1;
#pragma unroll
                        for (int e = 0; e < 4; ++e) { g0[e] = __builtin_amdgcn_rcpf(1.f + __builtin_amdgcn_exp2f(-(a0[e] + b0[e]) * LOG2E)); g1[e] = __builtin_amdgcn_rcpf(1.f + __builtin_amdgcn_exp2f(-(a1[e] + b1[e]) * LOG2E)); }
                        store8((GAS bf16_t*)(wsg + WS_T) + (size_t)row * 1024 + c, g0, g1);
                    } break;
                    case M_Z: {
                        const int c = pn * 256 + ct;
                        const u32x4 t = *(const GAS u32x4*)((GAS bf16_t*)(wsg + WS_T) + (size_t)row * 1024 + c);
                        GAS bf16_t* yp = (GAS bf16_t*)(wsg + WS_YB) + (size_t)row * 1024 + c;
                        f32x4 y0 = {0.f, 0.f, 0.f, 0.f}, y1 = {0.f, 0.f, 0.f, 0.f};
                        if (br > 0) { const u32x4 yo = *(const GAS u32x4*)yp;
                            y0 = (f32x4){bf_lo(yo.x), bf_hi(yo.x), bf_lo(yo.y), bf_hi(yo.y)}; y1 = (f32x4){bf_lo(yo.z), bf_hi(yo.z), bf_lo(yo.w), bf_hi(yo.w)}; }
                        y0 += a0 * (f32x4){bf_lo(t.x), bf_hi(t.x), bf_lo(t.y), bf_hi(t.y)};
                        y1 += a1 * (f32x4){bf_lo(t.z), bf_hi(t.z), bf_lo(t.w), bf_hi(t.w)};
                        store8(yp, y0, y1);
                    } break;
                    case M_RES: {
                        const int c = pn * 256 + ct;
                        GAS bf16_t* xbp = (GAS bf16_t*)(wsg + WS_XB) + (size_t)row * 1024 + c;
                        f32x4 x0, x1;
                        if (resid) { x0 = *(const GAS f32x4*)(resid + (size_t)row * 1024 + c); x1 = *(const GAS f32x4*)(resid + (size_t)row * 1024 + c + 4); }
                        else { const u32x4 xo = *(const GAS u32x4*)xbp; x0 = (f32x4){bf_lo(xo.x), bf_hi(xo.x), bf_lo(xo.y), bf_hi(xo.y)}; x1 = (f32x4){bf_lo(xo.z), bf_hi(xo.z), bf_lo(xo.w), bf_hi(xo.w)}; }
                        x0 += a0; x1 += a1;
                        store8(xbp, x0, x1);
                        ss += sq8(x0, x1);
                    } break;
                    default: {
                        f32x4 r0, r1;
#pragma unroll
                        for (int e = 0; e < 4; ++e) { const float v0 = fmaxf(a0[e], 0.f), v1 = fmaxf(a1[e], 0.f); r0[e] = v0 * v0; r1[e] = v1 * v1; }
                        store8((GAS bf16_t*)(wsg + WS_H) + (size_t)row * 4096 + pn * 256 + ct, r0, r1);
                    } break;
                    }
                }
                if (mode == M_RES || (mode == M_WIN && pn < 2)) {
                    ss += __shfl_xor(ss, 16); ss += __shfl_xor(ss, 32);
                    if (fq == 0) __hip_atomic_fetch_add(rs_out + row, (unsigned long long)(ss * 1048576.0f), __ATOMIC_RELAXED, __HIP_MEMORY_SCOPE_AGENT);
                }
            }
    }
};

__device__ __forceinline__ int crow(int i, int h) { return (i & 3) + 8 * (i >> 2) + 4 * h; }
#define MFMA32(a, b, c) __builtin_amdgcn_mfma_f32_32x32x16_bf16((a), (b), (c), 0, 0, 0)

template <int DQK, int DV, int MODE>
__device__ __forceinline__ void attn_unit(LAS unsigned char* lds, const GAS bf16_t* Q, int qpitch, const GAS bf16_t* K, int kpitch, const GAS bf16_t* V, int vpitch,
                                          GAS bf16_t* O, int opitch, int q0, int t_begin, int t_end, const GAS float* biasrow, float sink_l2, int tid) {
    constexpr int KSTR = (DQK + 8) * 2, VSTR = 144, KBUF = 64 * KSTR, VBUF = DV * VSTR;
    constexpr int NKC = DQK / 8, NKCH = 64 * NKC, KIT = (NKCH + 511) / 512, VIT = DV / 64, NC = DQK / 16, NDB = DV / 32;
    constexpr int OFF_K = 0, OFF_V = 2 * KBUF, OFF_BIAS = 2 * KBUF + 2 * VBUF;
    static_assert(OFF_BIAS + 512 <= 131072, "attention lds");
    const int lane = tid & 63, w = __builtin_amdgcn_readfirstlane(tid >> 6), r = lane & 31, h = lane >> 5;
    const int R0 = q0 + 32 * w;
    LAS float* biasl = (LAS float*)(lds + OFF_BIAS);
    if (MODE == 1) { if (tid < 128) biasl[tid] = biasrow[tid]; }
    bf16x8 qr[NC];
#pragma unroll
    for (int c = 0; c < NC; ++c) qr[c] = *(const GAS bf16x8*)(Q + (size_t)(R0 + r) * qpitch + 16 * c + 8 * h);
    u32x4 kst[KIT], vst[VIT];
    const int vpos = (lane & ~15) | (((lane >> 2) & 1) << 3) | (((lane >> 3) & 1) << 2) | (lane & 3);
#define ATT_LOAD(t) do { \
        _Pragma("unroll") for (int i_ = 0; i_ < KIT; ++i_) { const int c_ = tid + 512 * i_; if (c_ < NKCH) { const int row_ = c_ / NKC, col_ = c_ % NKC; \
            kst[i_] = *(const GAS u32x4*)(K + (size_t)(64 * (t) + row_) * kpitch + col_ * 8); } } \
        _Pragma("unroll") for (int i_ = 0; i_ < VIT; ++i_) vst[i_] = *(const GAS u32x4*)(V + (size_t)(64 * (t) + lane) * vpitch + (w + 8 * i_) * 8); } while (0)
#define ATT_STORE(buf) do { \
        _Pragma("unroll") for (int i_ = 0; i_ < KIT; ++i_) { const int c_ = tid + 512 * i_; if (c_ < NKCH) { const int row_ = c_ / NKC, col_ = c_ % NKC; \
            *(LAS u32x4*)(lds + OFF_K + (buf) * KBUF + row_ * KSTR + col_ * 16) = kst[i_]; } } \
        _Pragma("unroll") for (int i_ = 0; i_ < VIT; ++i_) { LAS unsigned short* vd_ = (LAS unsigned short*)(lds + OFF_V + (buf) * VBUF + ((w + 8 * i_) * 8) * VSTR + vpos * 2); \
            const u32x4 v_ = vst[i_]; \
            vd_[0 * (VSTR / 2)] = (unsigned short)(v_.x & 0xffffu); vd_[1 * (VSTR / 2)] = (unsigned short)(v_.x >> 16); \
            vd_[2 * (VSTR / 2)] = (unsigned short)(v_.y & 0xffffu); vd_[3 * (VSTR / 2)] = (unsigned short)(v_.y >> 16); \
            vd_[4 * (VSTR / 2)] = (unsigned short)(v_.z & 0xffffu); vd_[5 * (VSTR / 2)] = (unsigned short)(v_.z >> 16); \
            vd_[6 * (VSTR / 2)] = (unsigned short)(v_.w & 0xffffu); vd_[7 * (VSTR / 2)] = (unsigned short)(v_.w >> 16); } } while (0)

    float mrun = (MODE == 1) ? sink_l2 : -INFINITY;
    float lrun = (MODE == 1 && h == 0) ? 1.f : 0.f;
    f32x16 o[NDB];
#pragma unroll
    for (int db = 0; db < NDB; ++db)
#pragma unroll
        for (int i = 0; i < 16; ++i) o[db][i] = 0.f;

    ATT_LOAD(t_begin);
    ATT_STORE(0);
    __syncthreads();
    for (int t = t_begin; t < t_end; ++t) {
        const int buf = (t - t_begin) & 1;
        const bool more = (t + 1 < t_end);
        if (more) ATT_LOAD(t + 1);
        bool skip = false;
        if (MODE == 0) skip = (64 * t > R0 + 31);
        if (MODE == 1) skip = (64 * t > R0 + 31) || (64 * t + 63 < R0 - 127);
        if (!skip) {
            f32x16 p0, p1;
#pragma unroll
            for (int i = 0; i < 16; ++i) { p0[i] = 0.f; p1[i] = 0.f; }
            const LAS unsigned char* kp = lds + OFF_K + buf * KBUF + r * KSTR + h * 16;
#pragma unroll
            for (int c = 0; c < NC; ++c) {
                const bf16x8 k0 = *(const LAS bf16x8*)(kp + c * 32);
                const bf16x8 k1 = *(const LAS bf16x8*)(kp + 32 * KSTR + c * 32);
                p0 = MFMA32(k0, qr[c], p0); p1 = MFMA32(k1, qr[c], p1);
            }
            const int qa = R0 + r;
            if (MODE == 0) {
                if (64 * t + 63 > R0) {
#pragma unroll
                    for (int i = 0; i < 16; ++i) { const int kv = 64 * t + crow(i, h); if (kv > qa) p0[i] = -INFINITY; if (kv + 32 > qa) p1[i] = -INFINITY; }
                }
            }
            if (MODE == 1) {
#pragma unroll
                for (int i = 0; i < 16; ++i) { const int d0 = qa - (64 * t + crow(i, h)), d1 = d0 - 32;
                    const float b0 = biasl[d0 & 127], b1 = biasl[d1 & 127];
                    p0[i] = (d0 >= 0 && d0 < 128) ? p0[i] + b0 : -INFINITY; p1[i] = (d1 >= 0 && d1 < 128) ? p1[i] + b1 : -INFINITY; }
            }
            float mx = fmaxf(p0[0], p1[0]);
#pragma unroll
            for (int i = 1; i < 16; ++i) mx = fmaxf(mx, fmaxf(p0[i], p1[i]));
            mx = fmaxf(mx, __shfl_xor(mx, 32));
            const float mnew = fmaxf(mrun, mx);
            const float alpha = __builtin_amdgcn_exp2f(mrun - mnew);
            mrun = mnew;
            float ls = 0.f;
#pragma unroll
            for (int i = 0; i < 16; ++i) { p0[i] = __builtin_amdgcn_exp2f(p0[i] - mnew); p1[i] = __builtin_amdgcn_exp2f(p1[i] - mnew); ls += p0[i] + p1[i]; }
            lrun = lrun * alpha + ls;
#pragma unroll
            for (int db = 0; db < NDB; ++db)
#pragma unroll
                for (int i = 0; i < 16; ++i) o[db][i] *= alpha;
            bf16x8 pa[4];
#pragma unroll
            for (int s = 0; s < 4; ++s) {
                u32x4 pk;
                if (s < 2) { pk.x = cvtpk(p0[8 * s + 0], p0[8 * s + 1]); pk.y = cvtpk(p0[8 * s + 2], p0[8 * s + 3]); pk.z = cvtpk(p0[8 * s + 4], p0[8 * s + 5]); pk.w = cvtpk(p0[8 * s + 6], p0[8 * s + 7]); }
                else { const int s2 = s - 2; pk.x = cvtpk(p1[8 * s2 + 0], p1[8 * s2 + 1]); pk.y = cvtpk(p1[8 * s2 + 2], p1[8 * s2 + 3]); pk.z = cvtpk(p1[8 * s2 + 4], p1[8 * s2 + 5]); pk.w = cvtpk(p1[8 * s2 + 6], p1[8 * s2 + 7]); }
                pa[s] = __builtin_bit_cast(bf16x8, pk);
            }
            const LAS unsigned char* vp = lds + OFF_V + buf * VBUF + r * VSTR + h * 16;
#pragma unroll
            for (int db = 0; db < NDB; ++db)
#pragma unroll
                for (int s = 0; s < 4; ++s) {
                    const bf16x8 vf = *(const LAS bf16x8*)(vp + db * 32 * VSTR + s * 32);
                    o[db] = MFMA32(vf, pa[s], o[db]);
                }
        }
        if (more) ATT_STORE(buf ^ 1);
        __syncthreads();
    }
    lrun += __shfl_xor(lrun, 32);
    const float inv = 1.f / lrun;
    GAS bf16_t* orow = O + (size_t)(R0 + r) * opitch;
#pragma unroll
    for (int db = 0; db < NDB; ++db)
#pragma unroll
        for (int g = 0; g < 4; ++g) {
            u32x2 wv; wv.x = cvtpk(o[db][4 * g + 0] * inv, o[db][4 * g + 1] * inv); wv.y = cvtpk(o[db][4 * g + 2] * inv, o[db][4 * g + 3] * inv);
            *(GAS u32x2*)(orow + 32 * db + 8 * g + 4 * h) = wv;
        }
#undef ATT_LOAD
#undef ATT_STORE
}

constexpr float ATT_THR = 8.0f;
__device__ __forceinline__ float max3f(float a, float b, float c) { return __builtin_fmaxf(__builtin_fmaxf(a, b), c); }
template <int DQK>
__device__ __forceinline__ void att_qk(f32x16& s0, f32x16& s1, const LAS unsigned char* kp, const bf16x8 (&qr)[DQK / 16]) {
    constexpr int NC = DQK / 16, KSTR = (DQK + 8) * 2;
    f32x16 z;
#pragma unroll
    for (int i = 0; i < 16; ++i) z[i] = 0.f;
#pragma unroll
    for (int c = 0; c < NC; ++c) {
        const bf16x8 k0 = *(const LAS bf16x8*)(kp + c * 32);
        const bf16x8 k1 = *(const LAS bf16x8*)(kp + 32 * KSTR + c * 32);
        if (c == 0) { s0 = MFMA32(k0, qr[0], z); s1 = MFMA32(k1, qr[0], z); }
        else { s0 = MFMA32(k0, qr[c], s0); s1 = MFMA32(k1, qr[c], s1); }
    }
}
template <int MODE>
__device__ __forceinline__ void att_pre(f32x16& s0, f32x16& s1, f32x16 (&o)[2], float& mhat, float& lrun, bool& first, int t, int R0, int qa, int h, const LAS float* biasl) {
#pragma unroll
    for (int i = 0; i < 16; ++i) { s0[i] -= mhat; s1[i] -= mhat; }
    if (MODE == 0) {
        if (64 * t + 63 > R0) {
#pragma unroll
            for (int i = 0; i < 16; ++i) { const int kv = 64 * t + crow(i, h); if (kv > qa) s0[i] = -INFINITY; if (kv + 32 > qa) s1[i] = -INFINITY; }
        }
    }
    if (MODE == 1) {
#pragma unroll
        for (int i = 0; i < 16; ++i) { const int d0 = qa - (64 * t + crow(i, h)), d1 = d0 - 32;
            const float b0 = biasl[d0 & 127], b1 = biasl[d1 & 127];
            s0[i] = (d0 >= 0 && d0 < 128) ? s0[i] + b0 : -INFINITY; s1[i] = (d1 >= 0 && d1 < 128) ? s1[i] + b1 : -INFINITY; }
    }
    float a = max3f(s0[0], s0[1], s1[0]), b = max3f(s0[2], s0[3], s1[1]); a = max3f(a, s1[2], s1[3]);
#pragma unroll
    for (int i = 4; i < 16; i += 4) { a = max3f(a, s0[i], s0[i + 1]); b = max3f(b, s0[i + 2], s0[i + 3]); a = max3f(a, s1[i], s1[i + 1]); b = max3f(b, s1[i + 2], s1[i + 3]); }
    float rm = __builtin_fmaxf(a, b);
    { auto rr = __builtin_amdgcn_permlane32_swap(__float_as_uint(rm), __float_as_uint(rm), false, false); rm = __builtin_fmaxf(__uint_as_float(rr[0]), __uint_as_float(rr[1])); }
    if (first || __any(rm > ATT_THR)) {
        const float dl = first ? rm : __builtin_fmaxf(rm, 0.f);
        mhat += dl;
#pragma unroll
        for (int i = 0; i < 16; ++i) { s0[i] -= dl; s1[i] -= dl; }
        if (!first) { const float f = __builtin_amdgcn_exp2f(-dl); lrun *= f;
#pragma unroll
            for (int i = 0; i < 16; ++i) { o[0][i] *= f; o[1][i] *= f; } }
        first = false;
    }
}
__device__ __forceinline__ void att_post_half(f32x16& s, float& lrun, bf16x8& pa0, bf16x8& pa1) {
    float ls = 0.f;
#pragma unroll
    for (int i = 0; i < 16; ++i) { s[i] = __builtin_amdgcn_exp2f(s[i]); ls += s[i]; }
    lrun += ls;
    u32x4 pk; pk.x = cvtpk(s[0], s[1]); pk.y = cvtpk(s[2], s[3]); pk.z = cvtpk(s[4], s[5]); pk.w = cvtpk(s[6], s[7]);
    pa0 = __builtin_bit_cast(bf16x8, pk);
    u32x4 pq; pq.x = cvtpk(s[8], s[9]); pq.y = cvtpk(s[10], s[11]); pq.z = cvtpk(s[12], s[13]); pq.w = cvtpk(s[14], s[15]);
    pa1 = __builtin_bit_cast(bf16x8, pq);
}
__device__ __forceinline__ void att_pv(f32x16 (&o)[2], const bf16x8 (&pa)[4], const LAS unsigned char* vp) {
#pragma unroll
    for (int db = 0; db < 2; ++db)
#pragma unroll
        for (int s = 0; s < 4; ++s) {
            const bf16x8 vf = *(const LAS bf16x8*)(vp + db * 32 * 144 + s * 32);
            o[db] = MFMA32(vf, pa[s], o[db]);
        }
}
template <int DQK, int MODE, bool VT>
__device__ __forceinline__ void attn_unit_pipe(LAS unsigned char* lds, const GAS bf16_t* Q, int qpitch, const GAS bf16_t* K, int kpitch, const GAS bf16_t* V, int vpitch,
                                               GAS bf16_t* O, int opitch, int q0, int t_begin, int t_end, const GAS float* biasrow, float sink_l2, int tid_in) {
    int tid = tid_in; asm volatile("" : "+v"(tid));
    constexpr int DV = 64, KSTR = (DQK + 8) * 2, VSTR = 144, KBUF = 64 * KSTR, VBUF = DV * VSTR;
    constexpr int NKC = DQK / 8, NKCH = 64 * NKC, KIT = (NKCH + 511) / 512, NC = DQK / 16;
    constexpr int OFF_K = 0, OFF_V = 2 * KBUF, OFF_BIAS = 2 * KBUF + 2 * VBUF;
    const int lane = tid & 63, w = __builtin_amdgcn_readfirstlane(tid >> 6), r = lane & 31, h = lane >> 5;
    const int R0 = q0 + 32 * w, qa = R0 + r;
    LAS float* biasl = (LAS float*)(lds + OFF_BIAS);
    if (MODE == 1) { if (tid < 128) biasl[tid] = biasrow[tid]; }
    bf16x8 qr[NC];
#pragma unroll
    for (int c = 0; c < NC; ++c) qr[c] = *(const GAS bf16x8*)(Q + (size_t)(R0 + r) * qpitch + 16 * c + 8 * h);
    u32x4 kstA[KIT], vstA, kstB[KIT], vstB;
    const int vpos = (lane & ~15) | (((lane >> 2) & 1) << 3) | (((lane >> 3) & 1) << 2) | (lane & 3);
#define ATP_LOADK(KST, t) do { \
        _Pragma("unroll") for (int i_ = 0; i_ < KIT; ++i_) { const int c_ = tid + 512 * i_; if (c_ < NKCH) { const int row_ = c_ / NKC, col_ = c_ % NKC; \
            KST[i_] = *(const GAS u32x4*)(K + (size_t)(64 * (t) + row_) * kpitch + col_ * 8); } } } while (0)
#define ATP_LOADV(VST, t) do { if (VT) VST = *(const GAS u32x4*)(V + (size_t)(tid >> 3) * vpitch + 64 * (t) + (tid & 7) * 8); \
        else VST = *(const GAS u32x4*)(V + (size_t)(64 * (t) + lane) * vpitch + w * 8); } while (0)
#define ATP_STOREK(KST, buf) do { \
        _Pragma("unroll") for (int i_ = 0; i_ < KIT; ++i_) { const int c_ = tid + 512 * i_; if (c_ < NKCH) { const int row_ = c_ / NKC, col_ = c_ % NKC; \
            *(LAS u32x4*)(lds + OFF_K + (buf) * KBUF + row_ * KSTR + col_ * 16) = KST[i_]; } } } while (0)
#define ATP_STOREV(VST, buf) do { if (VT) { LAS unsigned char* vt_ = lds + OFF_V + (buf) * VBUF + (tid >> 3) * VSTR + (16 * ((tid & 7) >> 1) + 4 * (tid & 1)) * 2; \
            u32x2 lo_, hi_; lo_.x = VST.x; lo_.y = VST.y; hi_.x = VST.z; hi_.y = VST.w; *(LAS u32x2*)vt_ = lo_; *(LAS u32x2*)(vt_ + 16) = hi_; } else { \
            LAS unsigned short* vd_ = (LAS unsigned short*)(lds + OFF_V + (buf) * VBUF + (w * 8) * VSTR + vpos * 2); \
            vd_[0 * (VSTR / 2)] = (unsigned short)(VST.x & 0xffffu); vd_[1 * (VSTR / 2)] = (unsigned short)(VST.x >> 16); \
            vd_[2 * (VSTR / 2)] = (unsigned short)(VST.y & 0xffffu); vd_[3 * (VSTR / 2)] = (unsigned short)(VST.y >> 16); \
            vd_[4 * (VSTR / 2)] = (unsigned short)(VST.z & 0xffffu); vd_[5 * (VSTR / 2)] = (unsigned short)(VST.z >> 16); \
            vd_[6 * (VSTR / 2)] = (unsigned short)(VST.w & 0xffffu); vd_[7 * (VSTR / 2)] = (unsigned short)(VST.w >> 16); } } while (0)
#define ATP_SKIP(t) ((MODE == 0) ? (64 * (t) > R0 + 31) : ((MODE == 1) ? ((64 * (t) > R0 + 31) || (64 * (t) + 63 < R0 - 127)) : false))

    float mhat = (MODE == 1) ? sink_l2 : 0.f;
    float lrun = (MODE == 1 && h == 0) ? 1.f : 0.f;
    bool first = (MODE != 1);
    f32x16 o[2], sA0, sA1, sB0, sB1; bf16x8 pa[4];
#pragma unroll
    for (int i = 0; i < 16; ++i) { o[0][i] = 0.f; o[1][i] = 0.f; sA0[i] = 0.f; sA1[i] = 0.f; sB0[i] = 0.f; sB1[i] = 0.f; }
    const LAS unsigned char* kbase = lds + OFF_K + r * KSTR + h * 16;
    const LAS unsigned char* vbase = lds + OFF_V + r * VSTR + h * 16;

    ATP_LOADK(kstA, t_begin); ATP_LOADV(vstA, t_begin);
    if (t_begin + 1 < t_end) ATP_LOADK(kstB, t_begin + 1);
    ATP_STOREK(kstA, 0); ATP_STOREV(vstA, 0);
    if (t_begin + 1 < t_end) ATP_STOREK(kstB, 1);
    if (t_begin + 2 < t_end) ATP_LOADK(kstA, t_begin + 2);
    if (t_begin + 1 < t_end) ATP_LOADV(vstA, t_begin + 1);
    __syncthreads();
    if (!ATP_SKIP(t_begin)) att_qk<DQK>(sA0, sA1, kbase, qr);
    __syncthreads();
#define ATP_KF(c, hf) (*(const LAS bf16x8*)(kpn_ + (hf) * 32 * KSTR + (c) * 32))
#define ATP_VF(db, s_) (*(const LAS bf16x8*)(vpc_ + (db) * 32 * 144 + (s_) * 32))
#define ATP_SB() __builtin_amdgcn_sched_barrier(0)
#define ATP_ITER_FAST(C0, C1, N0, N1, KCUR, VCUR, KNXT, VNXT, T) do { \
        const int t_ = (T); const int sc_ = (t_ - t_begin) & 1; \
        const LAS unsigned char* kpn_ = kbase + (sc_ ^ 1) * KBUF; const LAS unsigned char* vpc_ = vbase + sc_ * VBUF; \
          \
        const bf16x8 ka0_ = ATP_KF(0, 0), kb0_ = ATP_KF(0, 1), ka1_ = ATP_KF(1, 0), kb1_ = ATP_KF(1, 1), ka2_ = ATP_KF(2, 0), kb2_ = ATP_KF(2, 1); \
        ATP_LOADK(KNXT, t_ + 3); ATP_LOADV(VNXT, t_ + 2); \
        att_pre<2>(C0, C1, o, mhat, lrun, first, t_, R0, qa, h, biasl); \
        ATP_SB(); \
          \
        const bf16x8 ka3_ = ATP_KF(3, 0), kb3_ = ATP_KF(3, 1), ka4_ = ATP_KF(4, 0), kb4_ = ATP_KF(4, 1), ka5_ = ATP_KF(5, 0), kb5_ = ATP_KF(5, 1); \
        { f32x16 z_; _Pragma("unroll") for (int i_ = 0; i_ < 16; ++i_) z_[i_] = 0.f; N0 = MFMA32(ka0_, qr[0], z_); N1 = MFMA32(kb0_, qr[0], z_); } \
        N0 = MFMA32(ka1_, qr[1], N0); N1 = MFMA32(kb1_, qr[1], N1); \
        N0 = MFMA32(ka2_, qr[2], N0); N1 = MFMA32(kb2_, qr[2], N1); \
        att_post_half(C0, lrun, pa[0], pa[1]); \
        ATP_SB(); \
          \
        const bf16x8 v00_ = ATP_VF(0, 0), v01_ = ATP_VF(0, 1), v10_ = ATP_VF(1, 0), v11_ = ATP_VF(1, 1); \
        const bf16x8 v02_ = ATP_VF(0, 2), v03_ = ATP_VF(0, 3), v12_ = ATP_VF(1, 2), v13_ = ATP_VF(1, 3); \
        N0 = MFMA32(ka3_, qr[3], N0); N1 = MFMA32(kb3_, qr[3], N1); \
        N0 = MFMA32(ka4_, qr[4], N0); N1 = MFMA32(kb4_, qr[4], N1); \
        N0 = MFMA32(ka5_, qr[5], N0); N1 = MFMA32(kb5_, qr[5], N1); \
        o[0] = MFMA32(v00_, pa[0], o[0]); o[1] = MFMA32(v10_, pa[0], o[1]); \
        o[0] = MFMA32(v01_, pa[1], o[0]); o[1] = MFMA32(v11_, pa[1], o[1]); \
        att_post_half(C1, lrun, pa[2], pa[3]); \
        ATP_SB(); \
          \
        o[0] = MFMA32(v02_, pa[2], o[0]); o[1] = MFMA32(v12_, pa[2], o[1]); \
        o[0] = MFMA32(v03_, pa[3], o[0]); o[1] = MFMA32(v13_, pa[3], o[1]); \
        ATP_STOREK(KCUR, sc_); ATP_STOREV(VCUR, sc_ ^ 1); \
        ATP_SB(); asm volatile("s_waitcnt lgkmcnt(0)\n\ts_barrier" ::: "memory"); ATP_SB(); } while (0)
#define ATP_ITER_GEN(C0, C1, N0, N1, KCUR, VCUR, KNXT, VNXT, T) do { \
        const int t_ = (T); const bool m1_ = (t_ + 1 < t_end), m2_ = (t_ + 2 < t_end), m3_ = (t_ + 3 < t_end); \
        if (m3_) ATP_LOADK(KNXT, t_ + 3); if (m2_) ATP_LOADV(VNXT, t_ + 2); \
        const bool sk_ = ATP_SKIP(t_), skn_ = !m1_ || ATP_SKIP(t_ + 1); \
        const int sc_ = (t_ - t_begin) & 1; \
        const LAS unsigned char* kpn_ = kbase + (sc_ ^ 1) * KBUF; const LAS unsigned char* vpc_ = vbase + sc_ * VBUF; \
        if (!sk_) att_pre<MODE>(C0, C1, o, mhat, lrun, first, t_, R0, qa, h, biasl); \
        if (!skn_) att_qk<DQK>(N0, N1, kpn_, qr); \
        if (!sk_) { att_post_half(C0, lrun, pa[0], pa[1]); att_post_half(C1, lrun, pa[2], pa[3]); att_pv(o, pa, vpc_); } \
        if (m2_) ATP_STOREK(KCUR, sc_); if (m1_) ATP_STOREV(VCUR, sc_ ^ 1); \
        ATP_SB(); asm volatile("s_waitcnt lgkmcnt(0)\n\ts_barrier" ::: "memory"); ATP_SB(); } while (0)
    int t = t_begin;
    if (MODE == 0) {
        const int n_fast = (q0 >> 6) - 1;
        for (; t + 1 < n_fast; t += 2) { ATP_ITER_FAST(sA0, sA1, sB0, sB1, kstA, vstA, kstB, vstB, t); ATP_ITER_FAST(sB0, sB1, sA0, sA1, kstB, vstB, kstA, vstA, t + 1); }
    }
    for (; t < t_end; ++t) {
        ATP_ITER_GEN(sA0, sA1, sB0, sB1, kstA, vstA, kstB, vstB, t);
        sA0 = sB0; sA1 = sB1; vstA = vstB;
#pragma unroll
        for (int i_ = 0; i_ < KIT; ++i_) kstA[i_] = kstB[i_];
    }

    { auto rr = __builtin_amdgcn_permlane32_swap(__float_as_uint(lrun), __float_as_uint(lrun), false, false); lrun = __uint_as_float(rr[0]) + __uint_as_float(rr[1]); }
    const float inv = 1.f / lrun;
    GAS bf16_t* orow = O + (size_t)(R0 + r) * opitch;
#pragma unroll
    for (int db = 0; db < 2; ++db)
#pragma unroll
        for (int g = 0; g < 4; ++g) {
            u32x2 wv; wv.x = cvtpk(o[db][4 * g + 0] * inv, o[db][4 * g + 1] * inv); wv.y = cvtpk(o[db][4 * g + 2] * inv, o[db][4 * g + 3] * inv);
            *(GAS u32x2*)(orow + 32 * db + 8 * g + 4 * h) = wv;
        }
#undef ATP_LOADK
#undef ATP_LOADV
#undef ATP_STOREK
#undef ATP_STOREV
#undef ATP_SKIP
#undef ATP_ITER_FAST
#undef ATP_ITER_GEN
#undef ATP_KF
#undef ATP_VF
#undef ATP_SB
}

__device__ __forceinline__ int map_col(int kind, int off, int n) {
    switch (kind) {
    case 1: {
        if (n < 256) return n;
        if (n < 512) { const int j = n - 256; if (j < 128) return 256 + j; if (j < 160) { const int p = j - 128; return 384 + 16 * ((p >> 2) & 1) + 4 * (p >> 3) + (p & 3); } return -1; }
        if (n < 1024) return 416 + (n - 512);
        if (n < 1280) return 928 + (n - 1024);
        return 1184 + (n - 1280);
    }
    case 2: {
        if (n < 512) return (n >> 6) * 96 + (n & 63);
        const int j = n - 512, hd = j >> 5, p = j & 31; return hd * 96 + 64 + 16 * ((p >> 2) & 1) + 4 * (p >> 3) + (p & 3);
    }
    case 3: {
        if (n < 512) return (n >> 6) * 128 + (n & 63);
        const int j = n - 512; return (j >> 6) * 128 + 64 + (j & 63);
    }
    default: return off + n;
    }
}
__device__ __forceinline__ void conv_item(const float* W, int K, int Nsrc, const float* gain, bf16_t* WT, int Ndst, int kind, int off, LAS float* scr, int it, int lane) {
    const int nblk = Ndst / 64;
    const int kq = lane >> 4, n4 = lane & 15;
    const int kb = it / nblk, nb = it % nblk, k0 = 64 * kb, n0 = 64 * nb;
    const int src = map_col(kind, off, n0 + 4 * n4);
    f32x4 v[16];
#pragma unroll
    for (int i = 0; i < 16; ++i) { v[i] = (f32x4){0.f, 0.f, 0.f, 0.f}; if (src >= 0) v[i] = *(const f32x4*)(W + (size_t)(k0 + 4 * i + kq) * Nsrc + src); }
    if (gain) {
#pragma unroll
        for (int i = 0; i < 16; ++i) v[i] = v[i] * gain[k0 + 4 * i + kq];
    }
#pragma unroll
    for (int i = 0; i < 16; ++i) { LAS float* d = scr + (4 * i + kq) * 65 + 4 * n4; d[0] = v[i][0]; d[1] = v[i][1]; d[2] = v[i][2]; d[3] = v[i][3]; }
    asm volatile("s_waitcnt lgkmcnt(0)" ::: "memory");
    const int c = lane & 7;
#pragma unroll
    for (int j = 0; j < 8; ++j) { const int n = (lane >> 3) + 8 * j; const LAS float* sp = scr + (8 * c) * 65 + n;
        u32x4 o; o.x = cvtpk(sp[0 * 65], sp[1 * 65]); o.y = cvtpk(sp[2 * 65], sp[3 * 65]); o.z = cvtpk(sp[4 * 65], sp[5 * 65]); o.w = cvtpk(sp[6 * 65], sp[7 * 65]);
        *(u32x4*)(WT + (size_t)(n0 + n) * K + k0 + 8 * c) = o; }
    asm volatile("s_waitcnt lgkmcnt(0)" ::: "memory");
}
__device__ __forceinline__ float row_to_bf16(const float* xrow, bf16_t* orow, int lane) {
    const f32x4* xr = (const f32x4*)xrow + lane;
    f32x4 v[4]; float s = 0.f;
#pragma unroll
    for (int j = 0; j < 4; ++j) { v[j] = xr[64 * j]; s += (v[j][0] * v[j][0] + v[j][1] * v[j][1]) + (v[j][2] * v[j][2] + v[j][3] * v[j][3]); }
    u32x2* o8 = (u32x2*)orow + lane;
#pragma unroll
    for (int j = 0; j < 4; ++j) { u32x2 wv; wv.x = cvtpk(v[j][0], v[j][1]); wv.y = cvtpk(v[j][2], v[j][3]); o8[64 * j] = wv; }
    return wave_sum(s);
}
__device__ __forceinline__ float rope_inv(int i) {
    const float t[16] = {1.000000000e+00f, 5.623413324e-01f, 3.162277639e-01f, 1.778279394e-01f, 1.000000015e-01f, 5.623412877e-02f, 3.162277862e-02f, 1.778279431e-02f,
                         9.999999776e-03f, 5.623413250e-03f, 3.162277862e-03f, 1.778279431e-03f, 1.000000047e-03f, 5.623413017e-04f, 3.162277862e-04f, 1.778279402e-04f};
    float r = t[0];
#pragma unroll
    for (int k = 1; k < 16; ++k) r = (i == k) ? t[k] : r;
    return r;
}

#define XB_TMO      128
#define XB_XCNT(j)  (256  + 64 * (j))
#define XB_XSUB(j)  (1280 + 64 * (j))
#define XB_XGEN(j)  (2304 + 64 * (j))
#define XB_TOP      3328
#define XB_TOPGEN   3392
#define XCD_BAR_WORDS 3456
#define XB_SPIN_CAP (1u << 18)

__device__ __forceinline__ unsigned xb_ld(unsigned* p)              { return __hip_atomic_load(p, __ATOMIC_RELAXED, __HIP_MEMORY_SCOPE_AGENT); }
__device__ __forceinline__ unsigned xb_add(unsigned* p, unsigned v) { return __hip_atomic_fetch_add(p, v, __ATOMIC_RELAXED, __HIP_MEMORY_SCOPE_AGENT); }
__device__ __forceinline__ unsigned xb_xcc_id() { return (unsigned)__builtin_amdgcn_s_getreg((3 << 11) | 20) & 0xFu; }
#define XB_SPIN(cond, bar) do { unsigned _sp = 0; while (cond) { __builtin_amdgcn_s_sleep(1); \
    if ((++_sp & 255u) == 0u) { if (xb_ld(&(bar)[XB_TMO])) break; if (_sp > XB_SPIN_CAP) { atomicAdd(&(bar)[XB_TMO], 1u); break; } } } } while (0)

struct XcdBarrier {
    unsigned* bar; unsigned x;
    volatile LAS unsigned* st;
};

__device__ __forceinline__ XcdBarrier xcd_barrier_post(unsigned* bar, volatile LAS unsigned* st) {
    XcdBarrier b; b.bar = bar; b.x = xb_xcc_id(); b.st = st;
    if (threadIdx.x == 0) (void)xb_add(&bar[XB_XCNT(b.x)], 1u);
    return b;
}
__device__ __forceinline__ void xcd_barrier_complete(unsigned* bar, unsigned x, unsigned& nloc, unsigned& nx) {
    const unsigned G = gridDim.x * gridDim.y * gridDim.z;
    unsigned sum, cnt, mine, sp = 0u;
    for (;;) {
        sum = 0u; cnt = 0u; mine = 0u;
#pragma unroll
        for (unsigned j = 0; j < 16; ++j) { const unsigned c = xb_ld(&bar[XB_XCNT(j)]); sum += c; cnt += (c > 0u) ? 1u : 0u; mine = (j == x) ? c : mine; }
        if (sum == G) break;
        __builtin_amdgcn_s_sleep(1);
        if ((++sp & 255u) == 0u) { if (xb_ld(&bar[XB_TMO])) break; if (sp > XB_SPIN_CAP) { atomicAdd(&bar[XB_TMO], 1u); break; } }
    }
    nloc = mine > 0u ? mine : 1u; nx = cnt > 0u ? cnt : 1u;
}

__device__ __forceinline__ void xcd_barrier(const XcdBarrier& b) {
    asm volatile("s_waitcnt vmcnt(0)" ::: "memory");
    __syncthreads();
    if (threadIdx.x == 0) {
        unsigned* bar = b.bar;
        __builtin_amdgcn_s_waitcnt(0);
        unsigned nloc = b.st[0], nx = b.st[1];
        if (nloc == 0u) { xcd_barrier_complete(bar, b.x, nloc, nx); b.st[0] = nloc; b.st[1] = nx; }
        const unsigned old = xb_add(&bar[XB_XSUB(b.x)], 1u);
        const unsigned gen = old / nloc;
        if (old + 1u == (gen + 1u) * nloc) {
            __builtin_amdgcn_fence(__ATOMIC_RELEASE, "agent");
            asm volatile("s_waitcnt vmcnt(0)" ::: "memory");
            const unsigned og = xb_add(&bar[XB_TOP], 1u);
            const unsigned tg = og / nx;
            if (og + 1u == (tg + 1u) * nx) xb_add(&bar[XB_TOPGEN], 1u);
            else XB_SPIN(xb_ld(&bar[XB_TOPGEN]) == tg, bar);
            __builtin_amdgcn_fence(__ATOMIC_ACQUIRE, "agent");
            xb_add(&bar[XB_XGEN(b.x)], 1u);
            asm volatile("s_waitcnt vmcnt(0)" ::: "memory");
        } else {
            XB_SPIN(xb_ld(&bar[XB_XGEN(b.x)]) == gen, bar);
            __builtin_amdgcn_fence(__ATOMIC_ACQUIRE, "agent");
            asm volatile("s_waitcnt vmcnt(0)" ::: "memory");
        }
    }
    __syncthreads();
}

constexpr int LDS_BYTES = 147456;
__global__ void __launch_bounds__(512, 2) fwd_mega(Args a) {
    extern __shared__ __attribute__((aligned(16))) unsigned char lds_raw[];
    LAS unsigned char* lds = (LAS unsigned char*)lds_raw;
    cg::grid_group grid = cg::this_grid();
    const int tid = threadIdx.x, lane = tid & 63, wave = __builtin_amdgcn_readfirstlane(tid >> 6);
    const int G = gridDim.x, bid = blockIdx.x;
    unsigned char* ws_k = a.ws;

    {
        unsigned char* ws = ws_k;
        bf16_t* XB = (bf16_t*)(ws + WS_XB);
        unsigned long long* RS = (unsigned long long*)(ws + WS_RSP);
        LAS float* scr = (LAS float*)(lds + wave * 16896);
        const int gw = bid * 8 + wave, ngw = G * 8;
        constexpr int IT_WG = 448, IT_UQ = 1216, IT_UKV = 1264, IT_MEM = 1296, IT_O0 = 1552, IT_O1 = 1680, IT_O2 = 1808, IT_OUT = 1936, IT_UP = 2192, IT_DOWN = 3216, IT_LAYER = 4240;
        for (int itg = gw; itg < NL * IT_LAYER; itg += ngw) {
            const int l = itg / IT_LAYER, r = itg % IT_LAYER;
            bf16_t* WL = (bf16_t*)(ws + WS_W + (size_t)l * W_LAYER_BYTES);
            const float* Wp; const float* gp = nullptr; bf16_t* Dp; int Kk, Ns, Nd, kind = 0, off = 0, it;
            if (r < IT_WG)        { it = r;           Wp = a.in[I_W_IN] + (size_t)l * D * INCOLS; Kk = D; Ns = INCOLS; gp = a.in[I_ATTN_NORM] + l * D; Dp = WL + W_IN; Nd = 1792; kind = 1; }
            else if (r < IT_UQ)   { it = r - IT_WG;   Wp = a.in[I_W_IN] + (size_t)l * D * INCOLS; Kk = D; Ns = INCOLS; gp = a.in[I_ATTN_NORM] + l * D; Dp = WL + W_G; Nd = 3072; off = 1696; }
            else if (r < IT_UKV)  { it = r - IT_UQ;   Wp = a.in[I_W_UQ] + (size_t)l * 256 * 768; Kk = 256; Ns = 768; gp = a.in[I_QNORM] + l * 256; Dp = WL + W_UQ; Nd = 768; kind = 2; }
            else if (r < IT_MEM)  { it = r - IT_UKV;  Wp = a.in[I_W_UKV] + (size_t)l * 128 * 1024; Kk = 128; Ns = 1024; gp = a.in[I_KVNORM] + l * 128; Dp = WL + W_UKV; Nd = 1024; kind = 3; }
            else if (r < IT_O0)   { it = r - IT_MEM;  Wp = a.in[I_W_MEMKV] + (size_t)l * D * 1024; Kk = D; Ns = 1024; gp = a.in[I_MEM_NORM] + l * D; Dp = WL + W_MEM; Nd = 1024; }
            else if (r < IT_O1)   { it = r - IT_O0;   Wp = a.in[I_WO_MLA] + (size_t)l * 512 * D; Kk = 512; Ns = D; Dp = WL + W_O; Nd = 1024; }
            else if (r < IT_O2)   { it = r - IT_O1;   Wp = a.in[I_WO_SWA] + (size_t)l * 512 * D; Kk = 512; Ns = D; Dp = WL + W_O + (size_t)1024 * 512; Nd = 1024; }
            else if (r < IT_OUT)  { it = r - IT_O2;   Wp = a.in[I_WO_MEM] + (size_t)l * 512 * D; Kk = 512; Ns = D; Dp = WL + W_O + (size_t)2 * 1024 * 512; Nd = 1024; }
            else if (r < IT_UP)   { it = r - IT_OUT;  Wp = a.in[I_W_OUT] + (size_t)l * D * D; Kk = D; Ns = D; Dp = WL + W_OUT; Nd = 1024; }
            else if (r < IT_DOWN) { it = r - IT_UP;   Wp = a.in[I_W_UP] + (size_t)l * D * DFF; Kk = D; Ns = DFF; gp = a.in[I_MLP_NORM] + l * D; Dp = WL + W_UP; Nd = 4096; }
            else                  { it = r - IT_DOWN; Wp = a.in[I_W_DOWN] + (size_t)l * DFF * D; Kk = DFF; Ns = D; Dp = WL + W_DOWN; Nd = 1024; }
            conv_item(Wp, Kk, Ns, gp, Dp, Nd, kind, off, scr, it, lane);
        }
        for (int m = gw; m < S; m += ngw) { const float ss = row_to_bf16(a.in[I_X] + (size_t)m * D, XB + (size_t)m * D, lane); if (lane == 0) RS[m] = (unsigned long long)(ss * 1048576.0f); }
        { bf16_t* MEMB = (bf16_t*)(ws + WS_MEMB); float* RSTDM = (float*)(ws + WS_RSTDM);
          for (int m = gw; m < MEML; m += ngw) { const float ss = row_to_bf16(a.in[I_MEM] + (size_t)m * D, MEMB + (size_t)m * D, lane); if (lane == 0) RSTDM[m] = 1.0f / sqrtf(ss * (1.0f / D) + EPS); } }
        const int gt = bid * 512 + tid, ngt = G * 512;
        for (int i = gt; i < 8 * S; i += ngt) RS[S + i] = 0ull;
        { f32x2* ROPE = (f32x2*)(ws + WS_ROPE);
          for (int i = gt; i < S * 16; i += ngt) {
            const int pos = i >> 4, fi = i & 15;
            const float ang = (float)pos * rope_inv(fi);
            const double rev = (double)ang * 0.15915494309189535;
            const float fr = (float)(rev - __builtin_rint(rev));
            f32x2 cs; cs.x = __builtin_amdgcn_cosf(fr); cs.y = __builtin_amdgcn_sinf(fr);
            ROPE[i] = cs;
          } }
        { float* BIAS = (float*)(ws + WS_BIAS);
          for (int i = gt; i < 8 * 128; i += ngt) {
            const int hh = i >> 7, n = i & 127;
            int bucket = n;
            if (n >= 16) { const float lg = __builtin_amdgcn_logf((float)n * 0.0625f) * (16.0f / 3.0f); bucket = 16 + (int)lg; if (bucket > 31) bucket = 31; }
            BIAS[i] = a.in[I_RELB][bucket * 8 + hh] * LOG2E;
          } }
        { float* BG = (float*)(ws + WS_BG); float* SK = (float*)(ws + WS_SINK); float* FN = (float*)(ws + WS_FN);
          for (int i = gt; i < 2 * 3072; i += ngt) BG[i] = a.in[I_B_GATE][i];
          for (int i = gt; i < 16; i += ngt) SK[i] = a.in[I_SINKS][i] * LOG2E;
          for (int i = gt; i < 1024; i += ngt) FN[i] = a.in[I_FNORM][i];
          for (int i = gt; i < 4096; i += ngt) ((unsigned*)(ws + WS_BAR))[i] = 0u;
          if (gt == 0) { unsigned long long* pt = (unsigned long long*)(ws + WS_PTAB); pt[0] = (unsigned long long)(uintptr_t)a.in[I_X]; pt[1] = (unsigned long long)(uintptr_t)a.out; } }
    }
    if (tid < 2) ((volatile LAS unsigned*)(lds + 143360))[tid] = 0u;
    grid.sync();
    const XcdBarrier xbar = xcd_barrier_post((unsigned*)(ws_k + WS_BAR), (volatile LAS unsigned*)(lds + 143360));

    constexpr int NSTEPS = 14 * NL;
    for (int step = 0; step < NSTEPS; ++step) {
        bool do_sync = true;
        const int l = step / 14, k = step % 14;
        unsigned char* ws = ws_k; asm volatile("" : "+s"(ws));
        if (k == 4) {
            int tidv = threadIdx.x; asm volatile("" : "+v"(tidv));
            GAS unsigned char* wsg = (GAS unsigned char*)ws;
            GAS bf16_t* QMLA = (GAS bf16_t*)(wsg + WS_QMLA); GAS bf16_t* KMLA = (GAS bf16_t*)(wsg + WS_KMLA); GAS bf16_t* VMLA = (GAS bf16_t*)(wsg + WS_VMLA); GAS bf16_t* OMLA = (GAS bf16_t*)(wsg + WS_OMLA);
            for (int u = bid; u < 256; u += G) {
                const int hh = u & 7, j = u >> 3;
                for (int kk = 0; kk < 2; ++kk) {
                    const int qb = kk == 0 ? 63 - j : j;
                    attn_unit_pipe<96, 0, true>(lds, QMLA + hh * 96, 768, KMLA + hh * 96, 768, VMLA + (size_t)(hh * 64) * S, S, OMLA + hh * 64, 512, 256 * qb, 0, 4 * (qb + 1), nullptr, 0.f, tidv);
                }
            }
            tidv = threadIdx.x; asm volatile("" : "+v"(tidv));
            GAS bf16_t* QS = (GAS bf16_t*)(wsg + WS_QS); GAS bf16_t* KS = (GAS bf16_t*)(wsg + WS_KS); GAS bf16_t* VS = (GAS bf16_t*)(wsg + WS_VS);
            const GAS float* BIAS = (const GAS float*)(wsg + WS_BIAS); const GAS float* SK = (const GAS float*)(wsg + WS_SINK);
            for (int u = bid; u < 512; u += G) {
                const int hh = u >> 6, qb = u & 63, g = hh >> 2;
                const int tb = 4 * qb - 2 < 0 ? 0 : 4 * qb - 2;
                attn_unit<64, 64, 1>(lds, QS + hh * 64, 512, KS + g * 64, 128, VS + g * 64, 128, QS + hh * 64, 512, 256 * qb, tb, 4 * qb + 4, BIAS + hh * 128, SK[l * 8 + hh], tidv);
            }
            tidv = threadIdx.x; asm volatile("" : "+v"(tidv));
            GAS bf16_t* QM = (GAS bf16_t*)(wsg + WS_QM); GAS bf16_t* KMEM = (GAS bf16_t*)(wsg + WS_KMEM); GAS bf16_t* VMEM = (GAS bf16_t*)(wsg + WS_VMEM);
            for (int u = bid; u < 256; u += G) {
                const int hh = u >> 6, qb = u & 63;
                attn_unit<128, 128, 2>(lds, QM + hh * 128, 512, KMEM + hh * 128, 512, VMEM + hh * 128, 512, QM + hh * 128, 512, 256 * qb, 0, 4, nullptr, 0.f, tidv);
            }
        } else {
            const bf16_t* WL = (const bf16_t*)(ws + WS_W + (size_t)l * W_LAYER_BYTES);
            const bf16_t* XB = (const bf16_t*)(ws + WS_XB);
            pg8::Gemm g{}; Epi E{}; int cid = bid;
            E.ws = ws; E.layer = l;
            switch (k) {
            case 0: g = pg8::Gemm{XB, WL + W_IN, S, 1792, 1024}; E.mode = M_WIN; do_sync = false; break;
            case 1: g = pg8::Gemm{(const bf16_t*)(ws + WS_MEMB), WL + W_MEM, MEML, 1024, 1024}; E.mode = M_MEM; cid = G - 1 - bid; break;
            case 2: g = pg8::Gemm{(const bf16_t*)(ws + WS_CQ), WL + W_UQ, S, 768, 256}; E.mode = M_UQ; do_sync = false; break;
            case 3: g = pg8::Gemm{(const bf16_t*)(ws + WS_CKV), WL + W_UKV, S, 1024, 128}; E.mode = M_UKV; cid = G - 1 - bid; break;
            case 5: case 7: case 9: { const int br = (k - 5) >> 1; g = pg8::Gemm{XB, WL + W_G + (size_t)br * 1024 * 1024, S, 1024, 1024}; E.mode = M_GATE; E.br = br; do_sync = false; } break;
            case 6: case 8: case 10: { const int br = (k - 6) >> 1; const bf16_t* Ab = (const bf16_t*)(ws + (br == 0 ? WS_OMLA : (br == 1 ? WS_QS : WS_QM)));
                    g = pg8::Gemm{Ab, WL + W_O + (size_t)br * 1024 * 512, S, 1024, 512}; E.mode = M_Z; E.br = br; do_sync = (k == 10); } break;
            case 11: g = pg8::Gemm{(const bf16_t*)(ws + WS_YB), WL + W_OUT, S, 1024, 1024}; E.mode = M_RES; E.br = 0; break;
            case 12: g = pg8::Gemm{XB, WL + W_UP, S, 4096, 1024}; E.mode = M_UP; break;
            default: g = pg8::Gemm{(const bf16_t*)(ws + WS_H), WL + W_DOWN, S, 1024, 4096}; E.mode = M_RES; E.br = 1; break;
            }
            pg8::StaticOrder SO; SO.init(g.M, g.N, G, cid);
            pg8::gemm_phase<Epi, pg8::StaticOrder, true, true>(lds, g, SO, E);
        }
        if (do_sync) xcd_barrier(xbar);
    }
    {
        unsigned char* ws = ws_k;
        int tidf = threadIdx.x; asm volatile("" : "+v"(tidf));
        const int lane = tidf & 63, wave = __builtin_amdgcn_readfirstlane(tidf >> 6);
        const int gw = bid * 8 + wave, ngw = G * 8;
        float* X = *(float* const*)(ws + WS_PTAB + 8);
        const unsigned long long* rsf = (const unsigned long long*)(ws + WS_RSP) + (size_t)(4 * NL) * S;
        const f32x4* gn = (const f32x4*)(ws + WS_FN) + lane;
        const bf16_t* XBf = (const bf16_t*)(ws + WS_XB);
        for (int m = gw; m < S; m += ngw) {
            f32x4* xr = (f32x4*)(X + (size_t)m * D) + lane;
            const u32x2* xb = (const u32x2*)(XBf + (size_t)m * D) + lane;
            const float rsum = (float)rsf[m] * (1.0f / 1048576.0f);
            const float rstd = 1.0f / sqrtf(rsum * (1.0f / D) + EPS);
#pragma unroll
            for (int j = 0; j < 4; ++j) { const u32x2 p = xb[64 * j]; f32x4 v = {bf_lo(p.x), bf_hi(p.x), bf_lo(p.y), bf_hi(p.y)}; v = v * rstd * gn[64 * j]; xr[64 * j] = v; }
        }
    }
}

extern "C" void kernel_launch(void* const* d_in, const int* in_sizes, int n_in, void* d_out, int out_size, void* d_ws, size_t ws_size, hipStream_t stream) {
    static int grid = 0;
    if (grid == 0) {
        int dev = 0, cus = 0, per_cu = 0;
        (void)hipGetDevice(&dev);
        (void)hipDeviceGetAttribute(&cus, hipDeviceAttributeMultiprocessorCount, dev);
        (void)hipFuncSetAttribute((const void*)fwd_mega, hipFuncAttributeMaxDynamicSharedMemorySize, LDS_BYTES);
        (void)hipOccupancyMaxActiveBlocksPerMultiprocessor(&per_cu, (const void*)fwd_mega, 512, LDS_BYTES);
        if (per_cu < 1) per_cu = 1;
        grid = cus * per_cu;
        if (grid <= 0) grid = 256;
    }
    Args a{};
    for (int i = 0; i < 21; ++i) a.in[i] = (const float*)d_in[i];
    a.out = (float*)d_out; a.ws = (unsigned char*)d_ws;
    void* args[] = {&a};
    hipError_t e = hipLaunchCooperativeKernel((void*)fwd_mega, dim3(grid), dim3(512), args, LDS_BYTES, stream);
    if (e != hipSuccess) fprintf(stderr, "cooperative launch failed: %s (grid %d)\n", hipGetErrorString(e), grid);
}
```

```cpp
#include <hip/hip_runtime.h>
#include <hip/hip_cooperative_groups.h>
#include <cstdio>
#include <cstdint>
namespace cg = cooperative_groups;
namespace pg8 {
#define PG8_LAS __attribute__((address_space(3)))
typedef unsigned short bf16_t;
typedef short bf16x8 __attribute__((ext_vector_type(8)));
typedef float f32x4 __attribute__((ext_vector_type(4)));
typedef unsigned u32x4 __attribute__((ext_vector_type(4)));
constexpr int BM = 256, BK = 64, HALF = 128, HTB = HALF * BK * 2  , STAGE_BYTES = 8 * HTB, NXCD = 8, WGM = 8;

__host__ __device__ __forceinline__ int lds_byte(int r, int c) { const int st = (r >> 4) * 2 + (c >> 5), rr = r & 15, cc = c & 31, ob = rr * 64 + cc * 2; return st * 1024 + (ob ^ (((ob >> 9) & 1) << 5)); }
__host__ __device__ __forceinline__ void stage_rc(int b, int& R, int& C) { const int st = b / 1024, sb = b % 1024, swz = sb ^ (((sb >> 9) & 1) << 5); R = (st >> 1) * 16 + swz / 64; C = (st & 1) * 32 + (swz % 64) / 2; }
__host__ __device__ __forceinline__ int perm32(int rho) { const int n = rho >> 4, i = rho & 15; return 8 * (i >> 2) + 4 * n + (i & 3); }

struct Unit { int pm, pn; };
struct Gemm { const bf16_t* A; const bf16_t* Bt; int M, N, K; };

struct StaticOrder {
    int nM, nN, nwg, G, c;
    __host__ __device__ void init(int M, int N, int G_, int c_) { nM = M / BM; nN = N / BM; nwg = nM * nN; G = G_; c = c_; }
    __host__ __device__ bool next(int i, Unit& u) const {
        const long L = (long)i * G + c; if (L >= nwg) return false;
        int wgid = (int)L; { const int q = nwg / NXCD, r = nwg % NXCD, xcd = wgid % NXCD, off = wgid / NXCD; wgid = (xcd < r ? xcd * (q + 1) : r * (q + 1) + (xcd - r) * q) + off; }
        const int nig = WGM * nN, gid = wgid / nig, fm = gid * WGM, gsz = (nM - fm) < WGM ? (nM - fm) : WGM;
        u.pm = fm + ((wgid % nig) % gsz); u.pn = (wgid % nig) / gsz; return true;
    }
    __device__ __forceinline__ void a_ready(const Unit&) const {}
    __device__ __forceinline__ void done(const Unit&) const {}
};

__device__ __forceinline__ unsigned cvt_pk_bf16(float lo, float hi) { unsigned r; asm volatile("v_cvt_pk_bf16_f32 %0, %1, %2" : "=v"(r) : "v"(lo), "v"(hi)); return r; }
typedef float f32x2 __attribute__((ext_vector_type(2)));
template <class Epi, class Sched, bool ALIGN_EPI = false, bool SP2 = false>
__device__ __forceinline__ void gemm_phase(PG8_LAS unsigned char* lds, const Gemm g, const Sched& S, const Epi& E) {
    int tid_o = threadIdx.x; asm volatile("" : "+v"(tid_o));
    const int tid = tid_o, wid = __builtin_amdgcn_readfirstlane(tid >> 6), lane = tid & 63, wr = wid >> 2, wc = wid & 3, fr = lane & 15, fq = lane >> 4;
    const int K = g.K, nt = K / BK;
    unsigned voffA[2], voffB[2];
#pragma unroll
    for (int i = 0; i < 2; ++i) { int R, C; stage_rc(tid * 16 + i * 8192, R, C); const int Rb = Epi::PERM ? ((R & ~31) + perm32(R & 31)) : R;
        voffA[i] = (unsigned)(R * K + C) * 2u; voffB[i] = (unsigned)(Rb * K + C) * 2u; }
    const size_t kstep = (size_t)(BK * 2);
    const size_t hstep = (size_t)HALF * K * 2;
    const size_t tstep = 2 * hstep;
    const unsigned ldsw = (unsigned)wid * 1024u;
    const int aoff = lds_byte(wr * 64 + fr, fq * 8), boff = lds_byte(wc * 32 + fr, fq * 8);
#define PG8_SA(b, h) (((b) * 2 + (h)) * HTB)
#define PG8_SB(b, h) ((4 + (b) * 2 + (h)) * HTB)
#define PG8_STAGE(bufoff, gbase, voff) do { _Pragma("unroll") for (int _i = 0; _i < 2; ++_i) \
        __builtin_amdgcn_global_load_lds((const unsigned*)((const char*)(gbase) + (voff)[_i]), (PG8_LAS unsigned*)(lds + (bufoff) + ldsw + _i * 8192), 16, 0, 0); } while (0)
#define PG8_LDA(dst, b, h) do { _Pragma("unroll") for (int m = 0; m < 4; ++m) _Pragma("unroll") for (int k = 0; k < 2; ++k) dst[m][k] = *(const PG8_LAS bf16x8*)(lds + PG8_SA(b, h) + aoff + m * 2048 + k * 1024); } while (0)
#define PG8_LDB(dst, b, h) do { _Pragma("unroll") for (int n = 0; n < 2; ++n) _Pragma("unroll") for (int k = 0; k < 2; ++k) dst[n][k] = *(const PG8_LAS bf16x8*)(lds + PG8_SB(b, h) + boff + n * 2048 + k * 1024); } while (0)
#define PG8_MMA(ai, bj, At, Bt) do { __builtin_amdgcn_s_setprio(1); _Pragma("unroll") for (int m = 0; m < 4; ++m) _Pragma("unroll") for (int n = 0; n < 2; ++n) _Pragma("unroll") for (int k = 0; k < 2; ++k) \
        acc[ai][bj][m][n] = __builtin_amdgcn_mfma_f32_16x16x32_bf16(Bt[n][k], At[m][k], acc[ai][bj][m][n], 0, 0, 0); __builtin_amdgcn_s_setprio(0); } while (0)
#define PG8_WAIT_V(n) asm volatile("s_waitcnt vmcnt(" #n ")" ::: "memory")
#define PG8_WAIT_L(n) asm volatile("s_waitcnt lgkmcnt(" #n ")" ::: "memory")
#define PG8_BAR __builtin_amdgcn_s_barrier()
#define PG8_SCHED __builtin_amdgcn_sched_barrier(0)
    Unit cur, nxt; int ui = 0;
    if (!S.next(0, cur)) return;
    f32x4 acc[2][2][4][2];
#pragma unroll
    for (int a = 0; a < 2; ++a)
#pragma unroll
        for (int b = 0; b < 2; ++b)
#pragma unroll
            for (int m = 0; m < 4; ++m)
#pragma unroll
                for (int n = 0; n < 2; ++n) acc[a][b][m][n] = (f32x4){0.f, 0.f, 0.f, 0.f};
    bf16x8 At[4][2], B0[2][2], B1[2][2];
    const char* cA = (const char*)g.A + (size_t)cur.pm * tstep; const char* cB = (const char*)g.Bt + (size_t)cur.pn * tstep;
    S.a_ready(cur);
    if constexpr (SP2) {
        PG8_STAGE(PG8_SB(0, 0), cB, voffB); PG8_STAGE(PG8_SB(0, 1), cB + hstep, voffB); PG8_STAGE(PG8_SA(0, 0), cA, voffA); PG8_STAGE(PG8_SA(0, 1), cA + hstep, voffA);
        if (wr == 1) PG8_BAR;
        PG8_WAIT_V(2); PG8_BAR;
        PG8_STAGE(PG8_SB(1, 0), cB + kstep, voffB); PG8_STAGE(PG8_SA(1, 0), cA + kstep, voffA); PG8_STAGE(PG8_SB(1, 1), cB + hstep + kstep, voffB);
        PG8_WAIT_V(6); PG8_BAR;
    } else {
        PG8_STAGE(PG8_SB(0, 0), cB, voffB); PG8_STAGE(PG8_SA(0, 0), cA, voffA); PG8_STAGE(PG8_SB(0, 1), cB + hstep, voffB); PG8_STAGE(PG8_SA(0, 1), cA + hstep, voffA);
        if (wr == 1) PG8_BAR;
        PG8_WAIT_V(4); PG8_BAR;
        PG8_STAGE(PG8_SB(1, 0), cB + kstep, voffB); PG8_STAGE(PG8_SA(1, 0), cA + kstep, voffA); PG8_STAGE(PG8_SB(1, 1), cB + hstep + kstep, voffB);
        PG8_WAIT_V(6); PG8_BAR;
    }
    for (;;) {
        const bool has_next = S.next(ui + 1, nxt);
        const char* nA = has_next ? (const char*)g.A + (size_t)nxt.pm * tstep : cA; const char* nB = has_next ? (const char*)g.Bt + (size_t)nxt.pn * tstep : cB;
        for (int t = 0; t < nt; t += 2) {
            const bool last = (t == nt - 2);
            const char* a1 = cA + (size_t)(t + 1) * kstep;
            const char* a2 = last ? nA : cA + (size_t)(t + 2) * kstep; const char* b2 = last ? nB : cB + (size_t)(t + 2) * kstep;
            const char* a3 = a2 + kstep; const char* b3 = b2 + kstep;
            if (last && has_next) S.a_ready(nxt);
            if constexpr (SP2) {
            PG8_LDB(B0, 0, 0); PG8_LDB(B1, 0, 1); PG8_SCHED; PG8_LDA(At, 0, 0); PG8_STAGE(PG8_SA(1, 1), a1 + hstep, voffA);
            PG8_WAIT_V(8); PG8_WAIT_L(0); PG8_BAR; PG8_MMA(0, 0, At, B0); PG8_MMA(0, 1, At, B1); PG8_BAR; PG8_SCHED;
            PG8_LDA(At, 0, 1); PG8_STAGE(PG8_SB(0, 0), b2, voffB); PG8_STAGE(PG8_SB(0, 1), b2 + hstep, voffB); PG8_STAGE(PG8_SA(0, 0), a2, voffA);
            PG8_WAIT_V(8); PG8_WAIT_L(0); PG8_BAR; PG8_MMA(1, 0, At, B0); PG8_MMA(1, 1, At, B1); PG8_BAR; PG8_SCHED;
            PG8_LDB(B0, 1, 0); PG8_LDB(B1, 1, 1); PG8_SCHED; PG8_LDA(At, 1, 0); PG8_STAGE(PG8_SA(0, 1), a2 + hstep, voffA);
            PG8_WAIT_V(8); PG8_WAIT_L(0); PG8_BAR; PG8_MMA(0, 0, At, B0); PG8_MMA(0, 1, At, B1); PG8_BAR; PG8_SCHED;
            PG8_LDA(At, 1, 1); PG8_STAGE(PG8_SB(1, 0), b3, voffB); PG8_STAGE(PG8_SB(1, 1), b3 + hstep, voffB); PG8_STAGE(PG8_SA(1, 0), a3, voffA);
            PG8_WAIT_V(8); PG8_WAIT_L(0); PG8_BAR; PG8_MMA(1, 0, At, B0); PG8_MMA(1, 1, At, B1); PG8_BAR; PG8_SCHED;
            } else {
            PG8_LDB(B0, 0, 0); PG8_SCHED; PG8_LDA(At, 0, 0); PG8_STAGE(PG8_SA(1, 1), a1 + hstep, voffA);
            PG8_WAIT_L(8); PG8_BAR; PG8_WAIT_L(0); PG8_MMA(0, 0, At, B0); PG8_BAR; PG8_SCHED;
            PG8_LDB(B1, 0, 1); PG8_STAGE(PG8_SB(0, 0), b2, voffB);
            PG8_BAR; PG8_WAIT_L(0); PG8_MMA(0, 1, At, B1); PG8_BAR;
            PG8_LDA(At, 0, 1); PG8_STAGE(PG8_SA(0, 0), a2, voffA);
            PG8_BAR; PG8_WAIT_L(0); PG8_MMA(1, 0, At, B0); PG8_BAR; PG8_SCHED;
            PG8_STAGE(PG8_SB(0, 1), b2 + hstep, voffB);
            PG8_WAIT_V(6); PG8_BAR; PG8_MMA(1, 1, At, B1); PG8_BAR;
            PG8_LDB(B0, 1, 0); PG8_SCHED; PG8_LDA(At, 1, 0); PG8_STAGE(PG8_SA(0, 1), a2 + hstep, voffA);
            PG8_WAIT_L(8); PG8_BAR; PG8_WAIT_L(0); PG8_MMA(0, 0, At, B0); PG8_BAR; PG8_SCHED;
            PG8_LDB(B1, 1, 1); PG8_STAGE(PG8_SB(1, 0), b3, voffB);
            PG8_BAR; PG8_WAIT_L(0); PG8_MMA(0, 1, At, B1); PG8_BAR;
            PG8_LDA(At, 1, 1); PG8_STAGE(PG8_SA(1, 0), a3, voffA);
            PG8_BAR; PG8_WAIT_L(0); PG8_MMA(1, 0, At, B0); PG8_BAR; PG8_SCHED;
            PG8_STAGE(PG8_SB(1, 1), b3 + hstep, voffB);
            PG8_WAIT_V(6); PG8_BAR; PG8_MMA(1, 1, At, B1); PG8_BAR;
            }
        }
        if constexpr (ALIGN_EPI) { if (wr == 0) PG8_BAR; }
        if constexpr (!Epi::AFTER_DRAIN) { E(acc, cur, wr, wc, fr, fq); S.done(cur); }
        if (!has_next) break;
#pragma unroll
        for (int a = 0; a < 2; ++a)
#pragma unroll
            for (int b = 0; b < 2; ++b)
#pragma unroll
                for (int m = 0; m < 4; ++m)
#pragma unroll
                    for (int n = 0; n < 2; ++n) acc[a][b][m][n] = (f32x4){0.f, 0.f, 0.f, 0.f};
        cur = nxt; cA = nA; cB = nB; ++ui;
        if constexpr (ALIGN_EPI) { if (wr == 1) PG8_BAR; }
    }
    PG8_WAIT_V(0);
    if constexpr (!ALIGN_EPI) { if (wr == 0) PG8_BAR; }
    PG8_BAR;
    if constexpr (Epi::AFTER_DRAIN) { E.fused(acc, cur, wr, wc, fr, fq, lds, wid, lane); S.done(cur); }
#undef PG8_SA
#undef PG8_SB
#undef PG8_STAGE
#undef PG8_LDA
#undef PG8_LDB
#undef PG8_MMA
#undef PG8_WAIT_V
#undef PG8_WAIT_L
#undef PG8_BAR
#undef PG8_SCHED
}
}

typedef unsigned short bf16_t;
typedef short bf16x8 __attribute__((ext_vector_type(8)));
typedef float f32x4 __attribute__((ext_vector_type(4)));
typedef float f32x2 __attribute__((ext_vector_type(2)));
typedef float f32x16 __attribute__((ext_vector_type(16)));
typedef unsigned u32x4 __attribute__((ext_vector_type(4)));
typedef unsigned u32x2 __attribute__((ext_vector_type(2)));
typedef __bf16 bf16x2_t __attribute__((ext_vector_type(2)));
#define LAS __attribute__((address_space(3)))
#define GAS __attribute__((address_space(1)))

constexpr int S = 16384, D = 1024, DFF = 4096, NL = 2, MEML = 256;
constexpr int INCOLS = 4768;
constexpr float EPS = 1e-6f;
constexpr float LOG2E = 1.4426950408889634f;
constexpr float QS_SCALE = 0.125f * LOG2E;
constexpr float QM_SCALE = 0.08838834764831845f * LOG2E;
constexpr float QMLA_SCALE = 0.10206207261596575f * LOG2E;

constexpr size_t W_IN = 0;
constexpr size_t W_G = W_IN + (size_t)1792 * 1024;
constexpr size_t W_UQ = W_G + (size_t)3072 * 1024;
constexpr size_t W_UKV = W_UQ + (size_t)768 * 256;
constexpr size_t W_MEM = W_UKV + (size_t)1024 * 128;
constexpr size_t W_O = W_MEM + (size_t)1024 * 1024;
constexpr size_t W_OUT = W_O + (size_t)3 * 1024 * 512;
constexpr size_t W_UP = W_OUT + (size_t)1024 * 1024;
constexpr size_t W_DOWN = W_UP + (size_t)4096 * 1024;
constexpr size_t W_LAYER_ELEMS = W_DOWN + (size_t)1024 * 4096;
constexpr size_t MiB = 1u << 20;
constexpr size_t W_LAYER_BYTES = 34 * MiB;
static_assert(W_LAYER_ELEMS * 2 <= W_LAYER_BYTES, "weights");
constexpr size_t WS_W = 0;
constexpr size_t WS_XB = 68 * MiB;
constexpr size_t WS_SMALL = 100 * MiB;
constexpr size_t WS_RS = WS_SMALL;
constexpr size_t WS_RSTDM = WS_RS + 9 * (size_t)S * 4;
constexpr size_t WS_BIAS = WS_RSTDM + 1024;
constexpr size_t WS_ROPE = WS_BIAS + 4096;
constexpr size_t WS_MEMB = WS_ROPE + (size_t)S * 16 * 8;
constexpr size_t WS_KMEM = WS_MEMB + (size_t)256 * 1024 * 2;
constexpr size_t WS_VMEM = WS_KMEM + (size_t)256 * 512 * 2;
constexpr size_t WS_PTAB = WS_VMEM + (size_t)256 * 512 * 2;
constexpr size_t WS_BG = WS_PTAB + 64;
constexpr size_t WS_SINK = WS_BG + 2 * 3072 * 4;
constexpr size_t WS_FN = WS_SINK + 64;
constexpr size_t WS_BAR = WS_FN + 4096;
static_assert(WS_BAR + 16384 <= 104 * MiB, "small region");
constexpr size_t WS_H = 104 * MiB;
constexpr size_t WS_QMLA = 104 * MiB;
constexpr size_t WS_KMLA = 128 * MiB;
constexpr size_t WS_VMLA = 152 * MiB;
constexpr size_t WS_QS = 168 * MiB;
constexpr size_t WS_KS = 184 * MiB;
constexpr size_t WS_VS = 188 * MiB;
constexpr size_t WS_QM = 192 * MiB;
constexpr size_t WS_CQ = 208 * MiB;
constexpr size_t WS_CKV = 216 * MiB;
constexpr size_t WS_OMLA = 220 * MiB;
constexpr size_t WS_T = 104 * MiB;
constexpr size_t WS_YB = 136 * MiB;
static_assert(WS_OMLA + (size_t)S * 512 * 2 <= 256 * MiB, "ws");
constexpr size_t WS_RSP = 236 * MiB;
static_assert(WS_RSP + 9 * (size_t)S * 16 * 4 <= 256 * MiB, "ws");

struct Args {
    const float* in[21];
    float* out; unsigned char* ws;
};
enum { I_X = 0, I_MEM, I_RELB, I_ATTN_NORM, I_MEM_NORM, I_W_IN, I_B_GATE, I_QNORM, I_W_UQ, I_KVNORM, I_W_UKV, I_SINKS, I_W_MEMKV, I_WO_MLA, I_WO_SWA, I_WO_MEM, I_W_OUT, I_MLP_NORM, I_W_UP, I_W_DOWN, I_FNORM };

__device__ __forceinline__ unsigned cvtpk(float lo, float hi) { f32x2 v = {lo, hi}; bf16x2_t b = __builtin_convertvector(v, bf16x2_t); return __builtin_bit_cast(unsigned, b); }
__device__ __forceinline__ float bf_lo(unsigned u) { return __uint_as_float(u << 16); }
__device__ __forceinline__ float bf_hi(unsigned u) { return __uint_as_float(u & 0xffff0000u); }
__device__ __forceinline__ float wave_sum(float v) {
#pragma unroll
    for (int o = 1; o < 64; o <<= 1) v += __shfl_xor(v, o);
    return v;
}

enum { M_WIN = 0, M_MEM, M_UQ, M_UKV, M_GATE, M_Z, M_RES, M_UP };
struct Epi {
    static constexpr bool PERM = true, AFTER_DRAIN = false;
    int mode, br, layer; unsigned char* ws;
    __device__ __forceinline__ void store8(GAS bf16_t* dst, const f32x4& a, const f32x4& b) const {
        u32x4 w; w.x = cvtpk(a[0], a[1]); w.y = cvtpk(a[2], a[3]); w.z = cvtpk(b[0], b[1]); w.w = cvtpk(b[2], b[3]);
        *(GAS u32x4*)dst = w;
    }
    __device__ __forceinline__ float sq8(const f32x4& a0, const f32x4& a1) const { return (a0[0]*a0[0] + a0[1]*a0[1]) + (a0[2]*a0[2] + a0[3]*a0[3]) + (a1[0]*a1[0] + a1[1]*a1[1]) + (a1[2]*a1[2] + a1[3]*a1[3]); }
    __device__ __forceinline__ void operator()(const f32x4 (&acc)[2][2][4][2], const pg8::Unit& u, int wr, int wc, int fr_in, int fq_in) const {
        int fr = fr_in, fq = fq_in; asm volatile("" : "+v"(fr), "+v"(fq));
        const int pn = u.pn;
        GAS unsigned char* wsg = (GAS unsigned char*)ws;
        GAS unsigned long long* RS = (GAS unsigned long long*)(wsg + WS_RSP);
        const GAS unsigned long long* rs_in = RS + (size_t)(4 * layer) * S; float inv_k = 1.0f / 1024.0f;
        const GAS float* rstdm = (const GAS float*)(wsg + WS_RSTDM);
        if (mode == M_UQ) { rs_in = RS + (size_t)(4 * layer + 1) * S; inv_k = 1.0f / 256.0f; }
        if (mode == M_UKV) { rs_in = RS + (size_t)(4 * layer + 2) * S; inv_k = 1.0f / 128.0f; }
        if (mode == M_UP) rs_in = RS + (size_t)(4 * layer + 3) * S;
        GAS unsigned long long* rs_out = RS + (size_t)(4 * layer + 1) * S;
        if (mode == M_WIN && pn == 1) rs_out = RS + (size_t)(4 * layer + 2) * S;
        if (mode == M_RES) rs_out = RS + (size_t)(4 * layer + 3 + br) * S;
        const GAS float* resid = nullptr; GAS float* X = nullptr;
        if (mode == M_RES && layer == 0 && br == 0) resid = (const GAS float*)*(const float* const GAS*)(wsg + WS_PTAB);
#pragma unroll
        for (int ai = 0; ai < 2; ++ai)
#pragma unroll
            for (int m = 0; m < 4; ++m) {
                const int row = u.pm * 256 + ai * 128 + wr * 64 + m * 16 + fr;
                float sc = 1.f;
                if (mode == M_MEM) sc = rstdm[row];
                else if (mode != M_Z && mode != M_RES) sc = __builtin_amdgcn_rsqf((float)rs_in[row] * (inv_k * (1.0f / 1048576.0f)) + EPS);
                if (mode == M_UQ) sc *= QMLA_SCALE;
                float ss = 0.f;
#pragma unroll
                for (int bj = 0; bj < 2; ++bj) {
                    const int ct = bj * 128 + wc * 32 + 8 * fq;
                    f32x4 a0 = acc[ai][bj][m][0] * sc, a1 = acc[ai][bj][m][1] * sc;
                    switch (mode) {
                    case M_WIN: {
                        if (pn == 0) { store8((GAS bf16_t*)(wsg + WS_CQ) + (size_t)row * 256 + ct, a0, a1); ss += sq8(a0, a1); }
                        else if (pn == 1) {
                            if (bj == 0) { store8((GAS bf16_t*)(wsg + WS_CKV) + (size_t)row * 128 + ct, a0, a1); ss += sq8(a0, a1); }
                            else if (wc == 0) {
                                const GAS f32x2* cs = (const GAS f32x2*)(wsg + WS_ROPE) + (size_t)row * 16 + 4 * fq;
                                f32x4 o1, o2;
#pragma unroll
                                for (int e = 0; e < 4; ++e) { const f32x2 c = cs[e]; o1[e] = a0[e] * c.x - a1[e] * c.y; o2[e] = a1[e] * c.x + a0[e] * c.y; }
                                u32x2 w1, w2; w1.x = cvtpk(o1[0], o1[1]); w1.y = cvtpk(o1[2], o1[3]); w2.x = cvtpk(o2[0], o2[1]); w2.y = cvtpk(o2[2], o2[3]);
                                GAS bf16_t* kr = (GAS bf16_t*)(wsg + WS_KMLA) + (size_t)row * 768 + 64 + 4 * fq;
#pragma unroll
                                for (int hh = 0; hh < 8; ++hh) { *(GAS u32x2*)(kr + hh * 96) = w1; *(GAS u32x2*)(kr + hh * 96 + 16) = w2; }
                            }
                        }
                        else if (pn < 4) { store8((GAS bf16_t*)(wsg + WS_QS) + (size_t)row * 512 + (pn - 2) * 256 + ct, a0 * QS_SCALE, a1 * QS_SCALE); }
                        else if (pn == 4) { if (bj == 0) store8((GAS bf16_t*)(wsg + WS_KS) + (size_t)row * 128 + ct, a0, a1); else store8((GAS bf16_t*)(wsg + WS_VS) + (size_t)row * 128 + ct - 128, a0, a1); }
                        else { store8((GAS bf16_t*)(wsg + WS_QM) + (size_t)row * 512 + (pn - 5) * 256 + ct, a0 * QM_SCALE, a1 * QM_SCALE); }
                    } break;
                    case M_MEM: {
                        if (pn < 2) store8((GAS bf16_t*)(wsg + WS_KMEM) + (size_t)row * 512 + pn * 256 + ct, a0, a1);
                        else store8((GAS bf16_t*)(wsg + WS_VMEM) + (size_t)row * 512 + (pn - 2) * 256 + ct, a0, a1);
                    } break;
                    case M_UQ: {
                        if (pn < 2) { const int c = pn * 256 + ct; store8((GAS bf16_t*)(wsg + WS_QMLA) + (size_t)row * 768 + (c >> 6) * 96 + (c & 63), a0, a1); }
                        else {
                            const int head = 4 * bj + wc;
                            const GAS f32x2* cs = (const GAS f32x2*)(wsg + WS_ROPE) + (size_t)row * 16 + 4 * fq;
                            f32x4 o1, o2;
#pragma unroll
                            for (int e = 0; e < 4; ++e) { const f32x2 c = cs[e]; o1[e] = a0[e] * c.x - a1[e] * c.y; o2[e] = a1[e] * c.x + a0[e] * c.y; }
                            u32x2 w1, w2; w1.x = cvtpk(o1[0], o1[1]); w1.y = cvtpk(o1[2], o1[3]); w2.x = cvtpk(o2[0], o2[1]); w2.y = cvtpk(o2[2], o2[3]);
                            GAS bf16_t* qrp = (GAS bf16_t*)(wsg + WS_QMLA) + (size_t)row * 768 + head * 96 + 64 + 4 * fq;
                            *(GAS u32x2*)qrp = w1; *(GAS u32x2*)(qrp + 16) = w2;
                        }
                    } break;
                    case M_UKV: {
                        if (pn < 2) { const int c = pn * 256 + ct; store8((GAS bf16_t*)(wsg + WS_KMLA) + (size_t)row * 768 + (c >> 6) * 96 + (c & 63), a0, a1); }
                        else {
                            GAS unsigned short* vt = (GAS unsigned short*)(wsg + WS_VMLA) + (size_t)((pn - 2) * 256 + ct) * S + row;
                            const unsigned w0 = cvtpk(a0[0], a0[1]), w1 = cvtpk(a0[2], a0[3]), w2 = cvtpk(a1[0], a1[1]), w3 = cvtpk(a1[2], a1[3]);
                            vt[0 * (size_t)S] = (unsigned short)(w0 & 0xffffu); vt[1 * (size_t)S] = (unsigned short)(w0 >> 16);
                            vt[2 * (size_t)S] = (unsigned short)(w1 & 0xffffu); vt[3 * (size_t)S] = (unsigned short)(w1 >> 16);
                            vt[4 * (size_t)S] = (unsigned short)(w2 & 0xffffu); vt[5 * (size_t)S] = (unsigned short)(w2 >> 16);
                            vt[6 * (size_t)S] = (unsigned short)(w3 & 0xffffu); vt[7 * (size_t)S] = (unsigned short)(w3 >> 16);
                        }
                    } break;
                    case M_GATE: {
                        const int c = pn * 256 + ct;
                        const GAS float* bg = (const GAS float*)(wsg + WS_BG) + layer * 3072 + br * 1024 + c;
                        const f32x4 b0 = *(const GAS f32x4*)bg, b1 = *(const GAS f32x4*)(bg + 4);
                        f32x4 g0, g1;
#pragma unroll
                        for (int e = 0; e < 4; ++e) { g0[e] = __builtin_amdgcn_rcpf(1.f + __builtin_amdgcn_exp2f(-(a0[e] + b0[e]) * LOG2E)); g1[e] = __builtin_amdgcn_rcpf(1.f + __builtin_amdgcn_exp2f(-(a1[e] + b1[e]) * LOG2E)); }
                        {
                            unsigned q[8];
#pragma unroll
                            for (int e = 0; e < 4; ++e) { q[e] = (unsigned)__builtin_rintf(g0[e] * 255.f); q[4 + e] = (unsigned)__builtin_rintf(g1[e] * 255.f); }
                            u32x2 w8; w8.x = q[0] | (q[1] << 8) | (q[2] << 16) | (q[3] << 24); w8.y = q[4] | (q[5] << 8) | (q[6] << 16) | (q[7] << 24);
                            *(GAS u32x2*)((GAS unsigned char*)(wsg + WS_T) + (size_t)row * 1024 + c) = w8;
                        }
                    } break;
                    case M_Z: {
                        const int c = pn * 256 + ct;
                        const u32x2 t8 = *(const GAS u32x2*)((GAS unsigned char*)(wsg + WS_T) + (size_t)row * 1024 + c);
                        GAS bf16_t* yp = (GAS bf16_t*)(wsg + WS_YB) + (size_t)row * 1024 + c;
                        f32x4 y0 = {0.f, 0.f, 0.f, 0.f}, y1 = {0.f, 0.f, 0.f, 0.f};
                        if (br > 0) { const u32x4 yo = *(const GAS u32x4*)yp;
                            y0 = (f32x4){bf_lo(yo.x), bf_hi(yo.x), bf_lo(yo.y), bf_hi(yo.y)}; y1 = (f32x4){bf_lo(yo.z), bf_hi(yo.z), bf_lo(yo.w), bf_hi(yo.w)}; }
                        constexpr float I255 = 1.0f / 255.0f;
                        y0 += a0 * ((f32x4){(float)(t8.x & 255u), (float)((t8.x >> 8) & 255u), (float)((t8.x >> 16) & 255u), (float)(t8.x >> 24)} * I255);
                        y1 += a1 * ((f32x4){(float)(t8.y & 255u), (float)((t8.y >> 8) & 255u), (float)((t8.y >> 16) & 255u), (float)(t8.y >> 24)} * I255);
                        store8(yp, y0, y1);
                    } break;
                    case M_RES: {
                        const int c = pn * 256 + ct;
                        GAS bf16_t* xbp = (GAS bf16_t*)(wsg + WS_XB) + (size_t)row * 1024 + c;
                        f32x4 x0, x1;
                        if (resid) { x0 = *(const GAS f32x4*)(resid + (size_t)row * 1024 + c); x1 = *(const GAS f32x4*)(resid + (size_t)row * 1024 + c + 4); }
                        else { const u32x4 xo = *(const GAS u32x4*)xbp; x0 = (f32x4){bf_lo(xo.x), bf_hi(xo.x), bf_lo(xo.y), bf_hi(xo.y)}; x1 = (f32x4){bf_lo(xo.z), bf_hi(xo.z), bf_lo(xo.w), bf_hi(xo.w)}; }
                        x0 += a0; x1 += a1;
                        store8(xbp, x0, x1);
                        ss += sq8(x0, x1);
                    } break;
                    default: {
                        f32x4 r0, r1;
#pragma unroll
                        for (int e = 0; e < 4; ++e) { const float v0 = fmaxf(a0[e], 0.f), v1 = fmaxf(a1[e], 0.f); r0[e] = v0 * v0; r1[e] = v1 * v1; }
                        store8((GAS bf16_t*)(wsg + WS_H) + (size_t)row * 4096 + pn * 256 + ct, r0, r1);
                    } break;
                    }
                }
                if (mode == M_RES || (mode == M_WIN && pn < 2)) {
                    ss += __shfl_xor(ss, 16); ss += __shfl_xor(ss, 32);
                    if (fq == 0) __hip_atomic_fetch_add(rs_out + row, (unsigned long long)(ss * 1048576.0f), __ATOMIC_RELAXED, __HIP_MEMORY_SCOPE_AGENT);
                }
            }
    }
};

__device__ __forceinline__ int crow(int i, int h) { return (i & 3) + 8 * (i >> 2) + 4 * h; }
#define MFMA32(a, b, c) __builtin_amdgcn_mfma_f32_32x32x16_bf16((a), (b), (c), 0, 0, 0)

template <int DQK, int DV, int MODE>
__device__ __forceinline__ void attn_unit(LAS unsigned char* lds, const GAS bf16_t* Q, int qpitch, const GAS bf16_t* K, int kpitch, const GAS bf16_t* V, int vpitch,
                                          GAS bf16_t* O, int opitch, int q0, int t_begin, int t_end, const GAS float* biasrow, float sink_l2, int tid) {
    constexpr int KSTR = (DQK + 8) * 2, VSTR = 144, KBUF = 64 * KSTR, VBUF = DV * VSTR;
    constexpr int NKC = DQK / 8, NKCH = 64 * NKC, KIT = (NKCH + 511) / 512, VIT = DV / 64, NC = DQK / 16, NDB = DV / 32;
    constexpr int OFF_K = 0, OFF_V = 2 * KBUF, OFF_BIAS = 2 * KBUF + 2 * VBUF;
    static_assert(OFF_BIAS + 512 <= 131072, "attention lds");
    const int lane = tid & 63, w = __builtin_amdgcn_readfirstlane(tid >> 6), r = lane & 31, h = lane >> 5;
    const int R0 = q0 + 32 * w;
    LAS float* biasl = (LAS float*)(lds + OFF_BIAS);
    if (MODE == 1) { if (tid < 128) biasl[tid] = biasrow[tid]; }
    bf16x8 qr[NC];
#pragma unroll
    for (int c = 0; c < NC; ++c) qr[c] = *(const GAS bf16x8*)(Q + (size_t)(R0 + r) * qpitch + 16 * c + 8 * h);
    u32x4 kst[KIT], vst[VIT];
    const int vpos = (lane & ~15) | (((lane >> 2) & 1) << 3) | (((lane >> 3) & 1) << 2) | (lane & 3);
#define ATT_LOAD(t) do { \
        _Pragma("unroll") for (int i_ = 0; i_ < KIT; ++i_) { const int c_ = tid + 512 * i_; if (c_ < NKCH) { const int row_ = c_ / NKC, col_ = c_ % NKC; \
            kst[i_] = *(const GAS u32x4*)(K + (size_t)(64 * (t) + row_) * kpitch + col_ * 8); } } \
        _Pragma("unroll") for (int i_ = 0; i_ < VIT; ++i_) vst[i_] = *(const GAS u32x4*)(V + (size_t)(64 * (t) + lane) * vpitch + (w + 8 * i_) * 8); } while (0)
#define ATT_STORE(buf) do { \
        _Pragma("unroll") for (int i_ = 0; i_ < KIT; ++i_) { const int c_ = tid + 512 * i_; if (c_ < NKCH) { const int row_ = c_ / NKC, col_ = c_ % NKC; \
            *(LAS u32x4*)(lds + OFF_K + (buf) * KBUF + row_ * KSTR + col_ * 16) = kst[i_]; } } \
        _Pragma("unroll") for (int i_ = 0; i_ < VIT; ++i_) { LAS unsigned short* vd_ = (LAS unsigned short*)(lds + OFF_V + (buf) * VBUF + ((w + 8 * i_) * 8) * VSTR + vpos * 2); \
            const u32x4 v_ = vst[i_]; \
            vd_[0 * (VSTR / 2)] = (unsigned short)(v_.x & 0xffffu); vd_[1 * (VSTR / 2)] = (unsigned short)(v_.x >> 16); \
            vd_[2 * (VSTR / 2)] = (unsigned short)(v_.y & 0xffffu); vd_[3 * (VSTR / 2)] = (unsigned short)(v_.y >> 16); \
            vd_[4 * (VSTR / 2)] = (unsigned short)(v_.z & 0xffffu); vd_[5 * (VSTR / 2)] = (unsigned short)(v_.z >> 16); \
            vd_[6 * (VSTR / 2)] = (unsigned short)(v_.w & 0xffffu); vd_[7 * (VSTR / 2)] = (unsigned short)(v_.w >> 16); } } while (0)

    float mrun = (MODE == 1) ? sink_l2 : -INFINITY;
    float lrun = (MODE == 1 && h == 0) ? 1.f : 0.f;
    f32x16 o[NDB];
#pragma unroll
    for (int db = 0; db < NDB; ++db)
#pragma unroll
        for (int i = 0; i < 16; ++i) o[db][i] = 0.f;

    ATT_LOAD(t_begin);
    ATT_STORE(0);
    __syncthreads();
    for (int t = t_begin; t < t_end; ++t) {
        const int buf = (t - t_begin) & 1;
        const bool more = (t + 1 < t_end);
        if (more) ATT_LOAD(t + 1);
        bool skip = false;
        if (MODE == 0) skip = (64 * t > R0 + 31);
        if (MODE == 1) skip = (64 * t > R0 + 31) || (64 * t + 63 < R0 - 127);
        if (!skip) {
            f32x16 p0, p1;
#pragma unroll
            for (int i = 0; i < 16; ++i) { p0[i] = 0.f; p1[i] = 0.f; }
            const LAS unsigned char* kp = lds + OFF_K + buf * KBUF + r * KSTR + h * 16;
#pragma unroll
            for (int c = 0; c < NC; ++c) {
                const bf16x8 k0 = *(const LAS bf16x8*)(kp + c * 32);
                const bf16x8 k1 = *(const LAS bf16x8*)(kp + 32 * KSTR + c * 32);
                p0 = MFMA32(k0, qr[c], p0); p1 = MFMA32(k1, qr[c], p1);
            }
            const int qa = R0 + r;
            if (MODE == 0) {
                if (64 * t + 63 > R0) {
#pragma unroll
                    for (int i = 0; i < 16; ++i) { const int kv = 64 * t + crow(i, h); if (kv > qa) p0[i] = -INFINITY; if (kv + 32 > qa) p1[i] = -INFINITY; }
                }
            }
            if (MODE == 1) {
#pragma unroll
                for (int i = 0; i < 16; ++i) { const int d0 = qa - (64 * t + crow(i, h)), d1 = d0 - 32;
                    const float b0 = biasl[d0 & 127], b1 = biasl[d1 & 127];
                    p0[i] = (d0 >= 0 && d0 < 128) ? p0[i] + b0 : -INFINITY; p1[i] = (d1 >= 0 && d1 < 128) ? p1[i] + b1 : -INFINITY; }
            }
            float mx = fmaxf(p0[0], p1[0]);
#pragma unroll
            for (int i = 1; i < 16; ++i) mx = fmaxf(mx, fmaxf(p0[i], p1[i]));
            mx = fmaxf(mx, __shfl_xor(mx, 32));
            const float mnew = fmaxf(mrun, mx);
            const float alpha = __builtin_amdgcn_exp2f(mrun - mnew);
            mrun = mnew;
            float ls = 0.f;
#pragma unroll
            for (int i = 0; i < 16; ++i) { p0[i] = __builtin_amdgcn_exp2f(p0[i] - mnew); p1[i] = __builtin_amdgcn_exp2f(p1[i] - mnew); ls += p0[i] + p1[i]; }
            lrun = lrun * alpha + ls;
#pragma unroll
            for (int db = 0; db < NDB; ++db)
#pragma unroll
                for (int i = 0; i < 16; ++i) o[db][i] *= alpha;
            bf16x8 pa[4];
#pragma unroll
            for (int s = 0; s < 4; ++s) {
                u32x4 pk;
                if (s < 2) { pk.x = cvtpk(p0[8 * s + 0], p0[8 * s + 1]); pk.y = cvtpk(p0[8 * s + 2], p0[8 * s + 3]); pk.z = cvtpk(p0[8 * s + 4], p0[8 * s + 5]); pk.w = cvtpk(p0[8 * s + 6], p0[8 * s + 7]); }
                else { const int s2 = s - 2; pk.x = cvtpk(p1[8 * s2 + 0], p1[8 * s2 + 1]); pk.y = cvtpk(p1[8 * s2 + 2], p1[8 * s2 + 3]); pk.z = cvtpk(p1[8 * s2 + 4], p1[8 * s2 + 5]); pk.w = cvtpk(p1[8 * s2 + 6], p1[8 * s2 + 7]); }
                pa[s] = __builtin_bit_cast(bf16x8, pk);
            }
            const LAS unsigned char* vp = lds + OFF_V + buf * VBUF + r * VSTR + h * 16;
#pragma unroll
            for (int db = 0; db < NDB; ++db)
#pragma unroll
                for (int s = 0; s < 4; ++s) {
                    const bf16x8 vf = *(const LAS bf16x8*)(vp + db * 32 * VSTR + s * 32);
                    o[db] = MFMA32(vf, pa[s], o[db]);
                }
        }
        if (more) ATT_STORE(buf ^ 1);
        __syncthreads();
    }
    lrun += __shfl_xor(lrun, 32);
    const float inv = 1.f / lrun;
    GAS bf16_t* orow = O + (size_t)(R0 + r) * opitch;
#pragma unroll
    for (int db = 0; db < NDB; ++db)
#pragma unroll
        for (int g = 0; g < 4; ++g) {
            u32x2 wv; wv.x = cvtpk(o[db][4 * g + 0] * inv, o[db][4 * g + 1] * inv); wv.y = cvtpk(o[db][4 * g + 2] * inv, o[db][4 * g + 3] * inv);
            *(GAS u32x2*)(orow + 32 * db + 8 * g + 4 * h) = wv;
        }
#undef ATT_LOAD
#undef ATT_STORE
}

constexpr float ATT_THR = 8.0f;
__device__ __forceinline__ float max3f(float a, float b, float c) { return __builtin_fmaxf(__builtin_fmaxf(a, b), c); }
template <int DQK>
__device__ __forceinline__ void att_qk(f32x16& s0, f32x16& s1, const LAS unsigned char* kp, const bf16x8 (&qr)[DQK / 16]) {
    constexpr int NC = DQK / 16, KSTR = (DQK + 8) * 2;
    f32x16 z;
#pragma unroll
    for (int i = 0; i < 16; ++i) z[i] = 0.f;
#pragma unroll
    for (int c = 0; c < NC; ++c) {
        const bf16x8 k0 = *(const LAS bf16x8*)(kp + c * 32);
        const bf16x8 k1 = *(const LAS bf16x8*)(kp + 32 * KSTR + c * 32);
        if (c == 0) { s0 = MFMA32(k0, qr[0], z); s1 = MFMA32(k1, qr[0], z); }
        else { s0 = MFMA32(k0, qr[c], s0); s1 = MFMA32(k1, qr[c], s1); }
    }
}
template <int MODE>
__device__ __forceinline__ void att_pre(f32x16& s0, f32x16& s1, f32x16 (&o)[2], float& mhat, float& lrun, bool& first, int t, int R0, int qa, int h, const LAS float* biasl) {
#pragma unroll
    for (int i = 0; i < 16; ++i) { s0[i] -= mhat; s1[i] -= mhat; }
    if (MODE == 0) {
        if (64 * t + 63 > R0) {
#pragma unroll
            for (int i = 0; i < 16; ++i) { const int kv = 64 * t + crow(i, h); if (kv > qa) s0[i] = -INFINITY; if (kv + 32 > qa) s1[i] = -INFINITY; }
        }
    }
    if (MODE == 1) {
#pragma unroll
        for (int i = 0; i < 16; ++i) { const int d0 = qa - (64 * t + crow(i, h)), d1 = d0 - 32;
            const float b0 = biasl[d0 & 127], b1 = biasl[d1 & 127];
            s0[i] = (d0 >= 0 && d0 < 128) ? s0[i] + b0 : -INFINITY; s1[i] = (d1 >= 0 && d1 < 128) ? s1[i] + b1 : -INFINITY; }
    }
    float a = max3f(s0[0], s0[1], s1[0]), b = max3f(s0[2], s0[3], s1[1]); a = max3f(a, s1[2], s1[3]);
#pragma unroll
    for (int i = 4; i < 16; i += 4) { a = max3f(a, s0[i], s0[i + 1]); b = max3f(b, s0[i + 2], s0[i + 3]); a = max3f(a, s1[i], s1[i + 1]); b = max3f(b, s1[i + 2], s1[i + 3]); }
    float rm = __builtin_fmaxf(a, b);
    { auto rr = __builtin_amdgcn_permlane32_swap(__float_as_uint(rm), __float_as_uint(rm), false, false); rm = __builtin_fmaxf(__uint_as_float(rr[0]), __uint_as_float(rr[1])); }
    if (first || __any(rm > ATT_THR)) {
        const float dl = first ? rm : __builtin_fmaxf(rm, 0.f);
        mhat += dl;
#pragma unroll
        for (int i = 0; i < 16; ++i) { s0[i] -= dl; s1[i] -= dl; }
        if (!first) { const float f = __builtin_amdgcn_exp2f(-dl); lrun *= f;
#pragma unroll
            for (int i = 0; i < 16; ++i) { o[0][i] *= f; o[1][i] *= f; } }
        first = false;
    }
}
__device__ __forceinline__ void att_post_half(f32x16& s, float& lrun, bf16x8& pa0, bf16x8& pa1) {
    float ls = 0.f;
#pragma unroll
    for (int i = 0; i < 16; ++i) { s[i] = __builtin_amdgcn_exp2f(s[i]); ls += s[i]; }
    lrun += ls;
    u32x4 pk; pk.x = cvtpk(s[0], s[1]); pk.y = cvtpk(s[2], s[3]); pk.z = cvtpk(s[4], s[5]); pk.w = cvtpk(s[6], s[7]);
    pa0 = __builtin_bit_cast(bf16x8, pk);
    u32x4 pq; pq.x = cvtpk(s[8], s[9]); pq.y = cvtpk(s[10], s[11]); pq.z = cvtpk(s[12], s[13]); pq.w = cvtpk(s[14], s[15]);
    pa1 = __builtin_bit_cast(bf16x8, pq);
}
__device__ __forceinline__ void att_pv(f32x16 (&o)[2], const bf16x8 (&pa)[4], const LAS unsigned char* vp) {
#pragma unroll
    for (int db = 0; db < 2; ++db)
#pragma unroll
        for (int s = 0; s < 4; ++s) {
            const bf16x8 vf = *(const LAS bf16x8*)(vp + db * 32 * 144 + s * 32);
            o[db] = MFMA32(vf, pa[s], o[db]);
        }
}
template <int DQK, int MODE, bool VT>
__device__ __forceinline__ void attn_unit_pipe(LAS unsigned char* lds, const GAS bf16_t* Q, int qpitch, const GAS bf16_t* K, int kpitch, const GAS bf16_t* V, int vpitch,
                                               GAS bf16_t* O, int opitch, int q0, int t_begin, int t_end, const GAS float* biasrow, float sink_l2, int tid_in) {
    int tid = tid_in; asm volatile("" : "+v"(tid));
    constexpr int DV = 64, KSTR = (DQK + 8) * 2, VSTR = 144, KBUF = 64 * KSTR, VBUF = DV * VSTR;
    constexpr int NKC = DQK / 8, NKCH = 64 * NKC, KIT = (NKCH + 511) / 512, NC = DQK / 16;
    constexpr int OFF_K = 0, OFF_V = 2 * KBUF, OFF_BIAS = 2 * KBUF + 2 * VBUF;
    const int lane = tid & 63, w = __builtin_amdgcn_readfirstlane(tid >> 6), r = lane & 31, h = lane >> 5;
    const int R0 = q0 + 32 * w, qa = R0 + r;
    LAS float* biasl = (LAS float*)(lds + OFF_BIAS);
    if (MODE == 1) { if (tid < 128) biasl[tid] = biasrow[tid]; }
    bf16x8 qr[NC];
#pragma unroll
    for (int c = 0; c < NC; ++c) qr[c] = *(const GAS bf16x8*)(Q + (size_t)(R0 + r) * qpitch + 16 * c + 8 * h);
    u32x4 kstA[KIT], vstA, kstB[KIT], vstB;
    const int vpos = (lane & ~15) | (((lane >> 2) & 1) << 3) | (((lane >> 3) & 1) << 2) | (lane & 3);
#define ATP_LOADK(KST, t) do { \
        _Pragma("unroll") for (int i_ = 0; i_ < KIT; ++i_) { const int c_ = tid + 512 * i_; if (c_ < NKCH) { const int row_ = c_ / NKC, col_ = c_ % NKC; \
            KST[i_] = *(const GAS u32x4*)(K + (size_t)(64 * (t) + row_) * kpitch + col_ * 8); } } } while (0)
#define ATP_LOADV(VST, t) do { if (VT) VST = *(const GAS u32x4*)(V + (size_t)(tid >> 3) * vpitch + 64 * (t) + (tid & 7) * 8); \
        else VST = *(const GAS u32x4*)(V + (size_t)(64 * (t) + lane) * vpitch + w * 8); } while (0)
#define ATP_STOREK(KST, buf) do { \
        _Pragma("unroll") for (int i_ = 0; i_ < KIT; ++i_) { const int c_ = tid + 512 * i_; if (c_ < NKCH) { const int row_ = c_ / NKC, col_ = c_ % NKC; \
            *(LAS u32x4*)(lds + OFF_K + (buf) * KBUF + row_ * KSTR + col_ * 16) = KST[i_]; } } } while (0)
#define ATP_STOREV(VST, buf) do { if (VT) { LAS unsigned char* vt_ = lds + OFF_V + (buf) * VBUF + (tid >> 3) * VSTR + (16 * ((tid & 7) >> 1) + 4 * (tid & 1)) * 2; \
            u32x2 lo_, hi_; lo_.x = VST.x; lo_.y = VST.y; hi_.x = VST.z; hi_.y = VST.w; *(LAS u32x2*)vt_ = lo_; *(LAS u32x2*)(vt_ + 16) = hi_; } else { \
            LAS unsigned short* vd_ = (LAS unsigned short*)(lds + OFF_V + (buf) * VBUF + (w * 8) * VSTR + vpos * 2); \
            vd_[0 * (VSTR / 2)] = (unsigned short)(VST.x & 0xffffu); vd_[1 * (VSTR / 2)] = (unsigned short)(VST.x >> 16); \
            vd_[2 * (VSTR / 2)] = (unsigned short)(VST.y & 0xffffu); vd_[3 * (VSTR / 2)] = (unsigned short)(VST.y >> 16); \
            vd_[4 * (VSTR / 2)] = (unsigned short)(VST.z & 0xffffu); vd_[5 * (VSTR / 2)] = (unsigned short)(VST.z >> 16); \
            vd_[6 * (VSTR / 2)] = (unsigned short)(VST.w & 0xffffu); vd_[7 * (VSTR / 2)] = (unsigned short)(VST.w >> 16); } } while (0)
#define ATP_SKIP(t) ((MODE == 0) ? (64 * (t) > R0 + 31) : ((MODE == 1) ? ((64 * (t) > R0 + 31) || (64 * (t) + 63 < R0 - 127)) : false))

    float mhat = (MODE == 1) ? sink_l2 : 0.f;
    float lrun = (MODE == 1 && h == 0) ? 1.f : 0.f;
    bool first = (MODE != 1);
    f32x16 o[2], sA0, sA1, sB0, sB1; bf16x8 pa[4];
#pragma unroll
    for (int i = 0; i < 16; ++i) { o[0][i] = 0.f; o[1][i] = 0.f; sA0[i] = 0.f; sA1[i] = 0.f; sB0[i] = 0.f; sB1[i] = 0.f; }
    const LAS unsigned char* kbase = lds + OFF_K + r * KSTR + h * 16;
    const LAS unsigned char* vbase = lds + OFF_V + r * VSTR + h * 16;

    ATP_LOADK(kstA, t_begin); ATP_LOADV(vstA, t_begin);
    if (t_begin + 1 < t_end) ATP_LOADK(kstB, t_begin + 1);
    ATP_STOREK(kstA, 0); ATP_STOREV(vstA, 0);
    if (t_begin + 1 < t_end) ATP_STOREK(kstB, 1);
    if (t_begin + 2 < t_end) ATP_LOADK(kstA, t_begin + 2);
    if (t_begin + 1 < t_end) ATP_LOADV(vstA, t_begin + 1);
    __syncthreads();
    if (!ATP_SKIP(t_begin)) att_qk<DQK>(sA0, sA1, kbase, qr);
    __syncthreads();
#define ATP_KF(c, hf) (*(const LAS bf16x8*)(kpn_ + (hf) * 32 * KSTR + (c) * 32))
#define ATP_VF(db, s_) (*(const LAS bf16x8*)(vpc_ + (db) * 32 * 144 + (s_) * 32))
#define ATP_SB() __builtin_amdgcn_sched_barrier(0)
#define ATP_ITER_FAST(C0, C1, N0, N1, KCUR, VCUR, KNXT, VNXT, T) do { \
        const int t_ = (T); const int sc_ = (t_ - t_begin) & 1; \
        const LAS unsigned char* kpn_ = kbase + (sc_ ^ 1) * KBUF; const LAS unsigned char* vpc_ = vbase + sc_ * VBUF; \
          \
        const bf16x8 ka0_ = ATP_KF(0, 0), kb0_ = ATP_KF(0, 1), ka1_ = ATP_KF(1, 0), kb1_ = ATP_KF(1, 1), ka2_ = ATP_KF(2, 0), kb2_ = ATP_KF(2, 1); \
        ATP_LOADK(KNXT, t_ + 3); ATP_LOADV(VNXT, t_ + 2); \
        att_pre<2>(C0, C1, o, mhat, lrun, first, t_, R0, qa, h, biasl); \
        ATP_SB(); \
          \
        const bf16x8 ka3_ = ATP_KF(3, 0), kb3_ = ATP_KF(3, 1), ka4_ = ATP_KF(4, 0), kb4_ = ATP_KF(4, 1), ka5_ = ATP_KF(5, 0), kb5_ = ATP_KF(5, 1); \
        { f32x16 z_; _Pragma("unroll") for (int i_ = 0; i_ < 16; ++i_) z_[i_] = 0.f; N0 = MFMA32(ka0_, qr[0], z_); N1 = MFMA32(kb0_, qr[0], z_); } \
        N0 = MFMA32(ka1_, qr[1], N0); N1 = MFMA32(kb1_, qr[1], N1); \
        N0 = MFMA32(ka2_, qr[2], N0); N1 = MFMA32(kb2_, qr[2], N1); \
        att_post_half(C0, lrun, pa[0], pa[1]); \
        ATP_SB(); \
          \
        const bf16x8 v00_ = ATP_VF(0, 0), v01_ = ATP_VF(0, 1), v10_ = ATP_VF(1, 0), v11_ = ATP_VF(1, 1); \
        const bf16x8 v02_ = ATP_VF(0, 2), v03_ = ATP_VF(0, 3), v12_ = ATP_VF(1, 2), v13_ = ATP_VF(1, 3); \
        N0 = MFMA32(ka3_, qr[3], N0); N1 = MFMA32(kb3_, qr[3], N1); \
        N0 = MFMA32(ka4_, qr[4], N0); N1 = MFMA32(kb4_, qr[4], N1); \
        N0 = MFMA32(ka5_, qr[5], N0); N1 = MFMA32(kb5_, qr[5], N1); \
        o[0] = MFMA32(v00_, pa[0], o[0]); o[1] = MFMA32(v10_, pa[0], o[1]); \
        o[0] = MFMA32(v01_, pa[1], o[0]); o[1] = MFMA32(v11_, pa[1], o[1]); \
        att_post_half(C1, lrun, pa[2], pa[3]); \
        ATP_SB(); \
          \
        o[0] = MFMA32(v02_, pa[2], o[0]); o[1] = MFMA32(v12_, pa[2], o[1]); \
        o[0] = MFMA32(v03_, pa[3], o[0]); o[1] = MFMA32(v13_, pa[3], o[1]); \
        ATP_STOREK(KCUR, sc_); ATP_STOREV(VCUR, sc_ ^ 1); \
        ATP_SB(); asm volatile("s_waitcnt lgkmcnt(0)\n\ts_barrier" ::: "memory"); ATP_SB(); } while (0)
#define ATP_ITER_GEN(C0, C1, N0, N1, KCUR, VCUR, KNXT, VNXT, T) do { \
        const int t_ = (T); const bool m1_ = (t_ + 1 < t_end), m2_ = (t_ + 2 < t_end), m3_ = (t_ + 3 < t_end); \
        if (m3_) ATP_LOADK(KNXT, t_ + 3); if (m2_) ATP_LOADV(VNXT, t_ + 2); \
        const bool sk_ = ATP_SKIP(t_), skn_ = !m1_ || ATP_SKIP(t_ + 1); \
        const int sc_ = (t_ - t_begin) & 1; \
        const LAS unsigned char* kpn_ = kbase + (sc_ ^ 1) * KBUF; const LAS unsigned char* vpc_ = vbase + sc_ * VBUF; \
        if (!sk_) att_pre<MODE>(C0, C1, o, mhat, lrun, first, t_, R0, qa, h, biasl); \
        if (!skn_) att_qk<DQK>(N0, N1, kpn_, qr); \
        if (!sk_) { att_post_half(C0, lrun, pa[0], pa[1]); att_post_half(C1, lrun, pa[2], pa[3]); att_pv(o, pa, vpc_); } \
        if (m2_) ATP_STOREK(KCUR, sc_); if (m1_) ATP_STOREV(VCUR, sc_ ^ 1); \
        ATP_SB(); asm volatile("s_waitcnt lgkmcnt(0)\n\ts_barrier" ::: "memory"); ATP_SB(); } while (0)
    int t = t_begin;
    if (MODE == 0) {
        const int n_fast = (q0 >> 6) - 1;
        for (; t + 1 < n_fast; t += 2) { ATP_ITER_FAST(sA0, sA1, sB0, sB1, kstA, vstA, kstB, vstB, t); ATP_ITER_FAST(sB0, sB1, sA0, sA1, kstB, vstB, kstA, vstA, t + 1); }
    }
    for (; t < t_end; ++t) {
        ATP_ITER_GEN(sA0, sA1, sB0, sB1, kstA, vstA, kstB, vstB, t);
        sA0 = sB0; sA1 = sB1; vstA = vstB;
#pragma unroll
        for (int i_ = 0; i_ < KIT; ++i_) kstA[i_] = kstB[i_];
    }

    { auto rr = __builtin_amdgcn_permlane32_swap(__float_as_uint(lrun), __float_as_uint(lrun), false, false); lrun = __uint_as_float(rr[0]) + __uint_as_float(rr[1]); }
    const float inv = 1.f / lrun;
    GAS bf16_t* orow = O + (size_t)(R0 + r) * opitch;
#pragma unroll
    for (int db = 0; db < 2; ++db)
#pragma unroll
        for (int g = 0; g < 4; ++g) {
            u32x2 wv; wv.x = cvtpk(o[db][4 * g + 0] * inv, o[db][4 * g + 1] * inv); wv.y = cvtpk(o[db][4 * g + 2] * inv, o[db][4 * g + 3] * inv);
            *(GAS u32x2*)(orow + 32 * db + 8 * g + 4 * h) = wv;
        }
#undef ATP_LOADK
#undef ATP_LOADV
#undef ATP_STOREK
#undef ATP_STOREV
#undef ATP_SKIP
#undef ATP_ITER_FAST
#undef ATP_ITER_GEN
#undef ATP_KF
#undef ATP_VF
#undef ATP_SB
}

__device__ __forceinline__ int map_col(int kind, int off, int n) {
    switch (kind) {
    case 1: {
        if (n < 256) return n;
        if (n < 512) { const int j = n - 256; if (j < 128) return 256 + j; if (j < 160) { const int p = j - 128; return 384 + 16 * ((p >> 2) & 1) + 4 * (p >> 3) + (p & 3); } return -1; }
        if (n < 1024) return 416 + (n - 512);
        if (n < 1280) return 928 + (n - 1024);
        return 1184 + (n - 1280);
    }
    case 2: {
        if (n < 512) return (n >> 6) * 96 + (n & 63);
        const int j = n - 512, hd = j >> 5, p = j & 31; return hd * 96 + 64 + 16 * ((p >> 2) & 1) + 4 * (p >> 3) + (p & 3);
    }
    case 3: {
        if (n < 512) return (n >> 6) * 128 + (n & 63);
        const int j = n - 512; return (j >> 6) * 128 + 64 + (j & 63);
    }
    default: return off + n;
    }
}
__device__ __forceinline__ void conv_item(const float* W, int K, int Nsrc, const float* gain, bf16_t* WT, int Ndst, int kind, int off, LAS float* scr, int it, int lane) {
    const int nblk = Ndst / 64;
    const int kq = lane >> 4, n4 = lane & 15;
    const int kb = it / nblk, nb = it % nblk, k0 = 64 * kb, n0 = 64 * nb;
    const int src = map_col(kind, off, n0 + 4 * n4);
    f32x4 v[16];
#pragma unroll
    for (int i = 0; i < 16; ++i) { v[i] = (f32x4){0.f, 0.f, 0.f, 0.f}; if (src >= 0) v[i] = *(const f32x4*)(W + (size_t)(k0 + 4 * i + kq) * Nsrc + src); }
    if (gain) {
#pragma unroll
        for (int i = 0; i < 16; ++i) v[i] = v[i] * gain[k0 + 4 * i + kq];
    }
#pragma unroll
    for (int i = 0; i < 16; ++i) { LAS float* d = scr + (4 * i + kq) * 65 + 4 * n4; d[0] = v[i][0]; d[1] = v[i][1]; d[2] = v[i][2]; d[3] = v[i][3]; }
    asm volatile("s_waitcnt lgkmcnt(0)" ::: "memory");
    const int c = lane & 7;
#pragma unroll
    for (int j = 0; j < 8; ++j) { const int n = (lane >> 3) + 8 * j; const LAS float* sp = scr + (8 * c) * 65 + n;
        u32x4 o; o.x = cvtpk(sp[0 * 65], sp[1 * 65]); o.y = cvtpk(sp[2 * 65], sp[3 * 65]); o.z = cvtpk(sp[4 * 65], sp[5 * 65]); o.w = cvtpk(sp[6 * 65], sp[7 * 65]);
        *(u32x4*)(WT + (size_t)(n0 + n) * K + k0 + 8 * c) = o; }
    asm volatile("s_waitcnt lgkmcnt(0)" ::: "memory");
}
__device__ __forceinline__ float row_to_bf16(const float* xrow, bf16_t* orow, int lane) {
    const f32x4* xr = (const f32x4*)xrow + lane;
    f32x4 v[4]; float s = 0.f;
#pragma unroll
    for (int j = 0; j < 4; ++j) { v[j] = xr[64 * j]; s += (v[j][0] * v[j][0] + v[j][1] * v[j][1]) + (v[j][2] * v[j][2] + v[j][3] * v[j][3]); }
    u32x2* o8 = (u32x2*)orow + lane;
#pragma unroll
    for (int j = 0; j < 4; ++j) { u32x2 wv; wv.x = cvtpk(v[j][0], v[j][1]); wv.y = cvtpk(v[j][2], v[j][3]); o8[64 * j] = wv; }
    return wave_sum(s);
}
__device__ __forceinline__ float rope_inv(int i) {
    const float t[16] = {1.000000000e+00f, 5.623413324e-01f, 3.162277639e-01f, 1.778279394e-01f, 1.000000015e-01f, 5.623412877e-02f, 3.162277862e-02f, 1.778279431e-02f,
                         9.999999776e-03f, 5.623413250e-03f, 3.162277862e-03f, 1.778279431e-03f, 1.000000047e-03f, 5.623413017e-04f, 3.162277862e-04f, 1.778279402e-04f};
    float r = t[0];
#pragma unroll
    for (int k = 1; k < 16; ++k) r = (i == k) ? t[k] : r;
    return r;
}

#define XB_TMO      128
#define XB_XCNT(j)  (256  + 64 * (j))
#define XB_XSUB(j)  (1280 + 64 * (j))
#define XB_XGEN(j)  (2304 + 64 * (j))
#define XB_TOP      3328
#define XB_TOPGEN   3392
#define XCD_BAR_WORDS 3456
#define XB_SPIN_CAP (1u << 18)

__device__ __forceinline__ unsigned xb_ld(unsigned* p)              { return __hip_atomic_load(p, __ATOMIC_RELAXED, __HIP_MEMORY_SCOPE_AGENT); }
__device__ __forceinline__ unsigned xb_add(unsigned* p, unsigned v) { return __hip_atomic_fetch_add(p, v, __ATOMIC_RELAXED, __HIP_MEMORY_SCOPE_AGENT); }
__device__ __forceinline__ unsigned xb_xcc_id() { return (unsigned)__builtin_amdgcn_s_getreg((3 << 11) | 20) & 0xFu; }
#define XB_SPIN(cond, bar) do { unsigned _sp = 0; while (cond) { __builtin_amdgcn_s_sleep(1); \
    if ((++_sp & 255u) == 0u) { if (xb_ld(&(bar)[XB_TMO])) break; if (_sp > XB_SPIN_CAP) { atomicAdd(&(bar)[XB_TMO], 1u); break; } } } } while (0)

struct XcdBarrier {
    unsigned* bar; unsigned x;
    volatile LAS unsigned* st;
};

__device__ __forceinline__ XcdBarrier xcd_barrier_post(unsigned* bar, volatile LAS unsigned* st) {
    XcdBarrier b; b.bar = bar; b.x = xb_xcc_id(); b.st = st;
    if (threadIdx.x == 0) (void)xb_add(&bar[XB_XCNT(b.x)], 1u);
    return b;
}
__device__ __forceinline__ void xcd_barrier_complete(unsigned* bar, unsigned x, unsigned& nloc, unsigned& nx) {
    const unsigned G = gridDim.x * gridDim.y * gridDim.z;
    unsigned sum, cnt, mine, sp = 0u;
    for (;;) {
        sum = 0u; cnt = 0u; mine = 0u;
#pragma unroll
        for (unsigned j = 0; j < 16; ++j) { const unsigned c = xb_ld(&bar[XB_XCNT(j)]); sum += c; cnt += (c > 0u) ? 1u : 0u; mine = (j == x) ? c : mine; }
        if (sum == G) break;
        __builtin_amdgcn_s_sleep(1);
        if ((++sp & 255u) == 0u) { if (xb_ld(&bar[XB_TMO])) break; if (sp > XB_SPIN_CAP) { atomicAdd(&bar[XB_TMO], 1u); break; } }
    }
    nloc = mine > 0u ? mine : 1u; nx = cnt > 0u ? cnt : 1u;
}

__device__ __forceinline__ void xcd_barrier(const XcdBarrier& b) {
    asm volatile("s_waitcnt vmcnt(0)" ::: "memory");
    __syncthreads();
    if (threadIdx.x == 0) {
        unsigned* bar = b.bar;
        __builtin_amdgcn_s_waitcnt(0);
        unsigned nloc = b.st[0], nx = b.st[1];
        if (nloc == 0u) { xcd_barrier_complete(bar, b.x, nloc, nx); b.st[0] = nloc; b.st[1] = nx; }
        const unsigned old = xb_add(&bar[XB_XSUB(b.x)], 1u);
        const unsigned gen = old / nloc;
        if (old + 1u == (gen + 1u) * nloc) {
            __builtin_amdgcn_fence(__ATOMIC_RELEASE, "agent");
            asm volatile("s_waitcnt vmcnt(0)" ::: "memory");
            const unsigned og = xb_add(&bar[XB_TOP], 1u);
            const unsigned tg = og / nx;
            if (og + 1u == (tg + 1u) * nx) xb_add(&bar[XB_TOPGEN], 1u);
            else XB_SPIN(xb_ld(&bar[XB_TOPGEN]) == tg, bar);
            __builtin_amdgcn_fence(__ATOMIC_ACQUIRE, "agent");
            xb_add(&bar[XB_XGEN(b.x)], 1u);
            asm volatile("s_waitcnt vmcnt(0)" ::: "memory");
        } else {
            XB_SPIN(xb_ld(&bar[XB_XGEN(b.x)]) == gen, bar);
            __builtin_amdgcn_fence(__ATOMIC_ACQUIRE, "agent");
            asm volatile("s_waitcnt vmcnt(0)" ::: "memory");
        }
    }
    __syncthreads();
}

constexpr int LDS_BYTES = 147456;
__global__ void __launch_bounds__(512, 2) fwd_mega(Args a) {
    extern __shared__ __attribute__((aligned(16))) unsigned char lds_raw[];
    LAS unsigned char* lds = (LAS unsigned char*)lds_raw;
    cg::grid_group grid = cg::this_grid();
    const int tid = threadIdx.x, lane = tid & 63, wave = __builtin_amdgcn_readfirstlane(tid >> 6);
    const int G = gridDim.x, bid = blockIdx.x;
    unsigned char* ws_k = a.ws;

    {
        unsigned char* ws = ws_k;
        bf16_t* XB = (bf16_t*)(ws + WS_XB);
        unsigned long long* RS = (unsigned long long*)(ws + WS_RSP);
        LAS float* scr = (LAS float*)(lds + wave * 16896);
        const int gw = bid * 8 + wave, ngw = G * 8;
        constexpr int IT_WG = 448, IT_UQ = 1216, IT_UKV = 1264, IT_MEM = 1296, IT_O0 = 1552, IT_O1 = 1680, IT_O2 = 1808, IT_OUT = 1936, IT_UP = 2192, IT_DOWN = 3216, IT_LAYER = 4240;
        for (int itg = gw; itg < NL * IT_LAYER; itg += ngw) {
            const int l = itg / IT_LAYER, r = itg % IT_LAYER;
            bf16_t* WL = (bf16_t*)(ws + WS_W + (size_t)l * W_LAYER_BYTES);
            const float* Wp; const float* gp = nullptr; bf16_t* Dp; int Kk, Ns, Nd, kind = 0, off = 0, it;
            if (r < IT_WG)        { it = r;           Wp = a.in[I_W_IN] + (size_t)l * D * INCOLS; Kk = D; Ns = INCOLS; gp = a.in[I_ATTN_NORM] + l * D; Dp = WL + W_IN; Nd = 1792; kind = 1; }
            else if (r < IT_UQ)   { it = r - IT_WG;   Wp = a.in[I_W_IN] + (size_t)l * D * INCOLS; Kk = D; Ns = INCOLS; gp = a.in[I_ATTN_NORM] + l * D; Dp = WL + W_G; Nd = 3072; off = 1696; }
            else if (r < IT_UKV)  { it = r - IT_UQ;   Wp = a.in[I_W_UQ] + (size_t)l * 256 * 768; Kk = 256; Ns = 768; gp = a.in[I_QNORM] + l * 256; Dp = WL + W_UQ; Nd = 768; kind = 2; }
            else if (r < IT_MEM)  { it = r - IT_UKV;  Wp = a.in[I_W_UKV] + (size_t)l * 128 * 1024; Kk = 128; Ns = 1024; gp = a.in[I_KVNORM] + l * 128; Dp = WL + W_UKV; Nd = 1024; kind = 3; }
            else if (r < IT_O0)   { it = r - IT_MEM;  Wp = a.in[I_W_MEMKV] + (size_t)l * D * 1024; Kk = D; Ns = 1024; gp = a.in[I_MEM_NORM] + l * D; Dp = WL + W_MEM; Nd = 1024; }
            else if (r < IT_O1)   { it = r - IT_O0;   Wp = a.in[I_WO_MLA] + (size_t)l * 512 * D; Kk = 512; Ns = D; Dp = WL + W_O; Nd = 1024; }
            else if (r < IT_O2)   { it = r - IT_O1;   Wp = a.in[I_WO_SWA] + (size_t)l * 512 * D; Kk = 512; Ns = D; Dp = WL + W_O + (size_t)1024 * 512; Nd = 1024; }
            else if (r < IT_OUT)  { it = r - IT_O2;   Wp = a.in[I_WO_MEM] + (size_t)l * 512 * D; Kk = 512; Ns = D; Dp = WL + W_O + (size_t)2 * 1024 * 512; Nd = 1024; }
            else if (r < IT_UP)   { it = r - IT_OUT;  Wp = a.in[I_W_OUT] + (size_t)l * D * D; Kk = D; Ns = D; Dp = WL + W_OUT; Nd = 1024; }
            else if (r < IT_DOWN) { it = r - IT_UP;   Wp = a.in[I_W_UP] + (size_t)l * D * DFF; Kk = D; Ns = DFF; gp = a.in[I_MLP_NORM] + l * D; Dp = WL + W_UP; Nd = 4096; }
            else                  { it = r - IT_DOWN; Wp = a.in[I_W_DOWN] + (size_t)l * DFF * D; Kk = DFF; Ns = D; Dp = WL + W_DOWN; Nd = 1024; }
            conv_item(Wp, Kk, Ns, gp, Dp, Nd, kind, off, scr, it, lane);
        }
        for (int m = gw; m < S; m += ngw) { const float ss = row_to_bf16(a.in[I_X] + (size_t)m * D, XB + (size_t)m * D, lane); if (lane == 0) RS[m] = (unsigned long long)(ss * 1048576.0f); }
        { bf16_t* MEMB = (bf16_t*)(ws + WS_MEMB); float* RSTDM = (float*)(ws + WS_RSTDM);
          for (int m = gw; m < MEML; m += ngw) { const float ss = row_to_bf16(a.in[I_MEM] + (size_t)m * D, MEMB + (size_t)m * D, lane); if (lane == 0) RSTDM[m] = 1.0f / sqrtf(ss * (1.0f / D) + EPS); } }
        const int gt = bid * 512 + tid, ngt = G * 512;
        for (int i = gt; i < 8 * S; i += ngt) RS[S + i] = 0ull;
        { f32x2* ROPE = (f32x2*)(ws + WS_ROPE);
          for (int i = gt; i < S * 16; i += ngt) {
            const int pos = i >> 4, fi = i & 15;
            const float ang = (float)pos * rope_inv(fi);
            const double rev = (double)ang * 0.15915494309189535;
            const float fr = (float)(rev - __builtin_rint(rev));
            f32x2 cs; cs.x = __builtin_amdgcn_cosf(fr); cs.y = __builtin_amdgcn_sinf(fr);
            ROPE[i] = cs;
          } }
        { float* BIAS = (float*)(ws + WS_BIAS);
          for (int i = gt; i < 8 * 128; i += ngt) {
            const int hh = i >> 7, n = i & 127;
            int bucket = n;
            if (n >= 16) { const float lg = __builtin_amdgcn_logf((float)n * 0.0625f) * (16.0f / 3.0f); bucket = 16 + (int)lg; if (bucket > 31) bucket = 31; }
            BIAS[i] = a.in[I_RELB][bucket * 8 + hh] * LOG2E;
          } }
        { float* BG = (float*)(ws + WS_BG); float* SK = (float*)(ws + WS_SINK); float* FN = (float*)(ws + WS_FN);
          for (int i = gt; i < 2 * 3072; i += ngt) BG[i] = a.in[I_B_GATE][i];
          for (int i = gt; i < 16; i += ngt) SK[i] = a.in[I_SINKS][i] * LOG2E;
          for (int i = gt; i < 1024; i += ngt) FN[i] = a.in[I_FNORM][i];
          for (int i = gt; i < 4096; i += ngt) ((unsigned*)(ws + WS_BAR))[i] = 0u;
          if (gt == 0) { unsigned long long* pt = (unsigned long long*)(ws + WS_PTAB); pt[0] = (unsigned long long)(uintptr_t)a.in[I_X]; pt[1] = (unsigned long long)(uintptr_t)a.out; } }
    }
    if (tid < 2) ((volatile LAS unsigned*)(lds + 143360))[tid] = 0u;
    grid.sync();
    const XcdBarrier xbar = xcd_barrier_post((unsigned*)(ws_k + WS_BAR), (volatile LAS unsigned*)(lds + 143360));

    constexpr int NSTEPS = 14 * NL;
    for (int step = 0; step < NSTEPS; ++step) {
        bool do_sync = true;
        const int l = step / 14, k = step % 14;
        unsigned char* ws = ws_k; asm volatile("" : "+s"(ws));
        if (k == 4) {
            int tidv = threadIdx.x; asm volatile("" : "+v"(tidv));
            GAS unsigned char* wsg = (GAS unsigned char*)ws;
            GAS bf16_t* QMLA = (GAS bf16_t*)(wsg + WS_QMLA); GAS bf16_t* KMLA = (GAS bf16_t*)(wsg + WS_KMLA); GAS bf16_t* VMLA = (GAS bf16_t*)(wsg + WS_VMLA); GAS bf16_t* OMLA = (GAS bf16_t*)(wsg + WS_OMLA);
            for (int u = bid; u < 256; u += G) {
                const int hh = u & 7, j = u >> 3;
                for (int kk = 0; kk < 2; ++kk) {
                    const int qb = kk == 0 ? 63 - j : j;
                    attn_unit_pipe<96, 0, true>(lds, QMLA + hh * 96, 768, KMLA + hh * 96, 768, VMLA + (size_t)(hh * 64) * S, S, OMLA + hh * 64, 512, 256 * qb, 0, 4 * (qb + 1), nullptr, 0.f, tidv);
                }
            }
            tidv = threadIdx.x; asm volatile("" : "+v"(tidv));
            GAS bf16_t* QS = (GAS bf16_t*)(wsg + WS_QS); GAS bf16_t* KS = (GAS bf16_t*)(wsg + WS_KS); GAS bf16_t* VS = (GAS bf16_t*)(wsg + WS_VS);
            const GAS float* BIAS = (const GAS float*)(wsg + WS_BIAS); const GAS float* SK = (const GAS float*)(wsg + WS_SINK);
            for (int u = bid; u < 512; u += G) {
                const int hh = u >> 6, qb = u & 63, g = hh >> 2;
                const int tb = 4 * qb - 2 < 0 ? 0 : 4 * qb - 2;
                attn_unit<64, 64, 1>(lds, QS + hh * 64, 512, KS + g * 64, 128, VS + g * 64, 128, QS + hh * 64, 512, 256 * qb, tb, 4 * qb + 4, BIAS + hh * 128, SK[l * 8 + hh], tidv);
            }
            tidv = threadIdx.x; asm volatile("" : "+v"(tidv));
            GAS bf16_t* QM = (GAS bf16_t*)(wsg + WS_QM); GAS bf16_t* KMEM = (GAS bf16_t*)(wsg + WS_KMEM); GAS bf16_t* VMEM = (GAS bf16_t*)(wsg + WS_VMEM);
            for (int u = bid; u < 256; u += G) {
                const int hh = u >> 6, qb = u & 63;
                attn_unit<128, 128, 2>(lds, QM + hh * 128, 512, KMEM + hh * 128, 512, VMEM + hh * 128, 512, QM + hh * 128, 512, 256 * qb, 0, 4, nullptr, 0.f, tidv);
            }
        } else {
            const bf16_t* WL = (const bf16_t*)(ws + WS_W + (size_t)l * W_LAYER_BYTES);
            const bf16_t* XB = (const bf16_t*)(ws + WS_XB);
            pg8::Gemm g{}; Epi E{}; int cid = bid;
            E.ws = ws; E.layer = l;
            switch (k) {
            case 0: g = pg8::Gemm{XB, WL + W_IN, S, 1792, 1024}; E.mode = M_WIN; do_sync = false; break;
            case 1: g = pg8::Gemm{(const bf16_t*)(ws + WS_MEMB), WL + W_MEM, MEML, 1024, 1024}; E.mode = M_MEM; cid = G - 1 - bid; break;
            case 2: g = pg8::Gemm{(const bf16_t*)(ws + WS_CQ), WL + W_UQ, S, 768, 256}; E.mode = M_UQ; do_sync = false; break;
            case 3: g = pg8::Gemm{(const bf16_t*)(ws + WS_CKV), WL + W_UKV, S, 1024, 128}; E.mode = M_UKV; cid = G - 1 - bid; break;
            case 5: case 7: case 9: { const int br = (k - 5) >> 1; g = pg8::Gemm{XB, WL + W_G + (size_t)br * 1024 * 1024, S, 1024, 1024}; E.mode = M_GATE; E.br = br; do_sync = false; } break;
            case 6: case 8: case 10: { const int br = (k - 6) >> 1; const bf16_t* Ab = (const bf16_t*)(ws + (br == 0 ? WS_OMLA : (br == 1 ? WS_QS : WS_QM)));
                    g = pg8::Gemm{Ab, WL + W_O + (size_t)br * 1024 * 512, S, 1024, 512}; E.mode = M_Z; E.br = br; do_sync = (k == 10); } break;
            case 11: g = pg8::Gemm{(const bf16_t*)(ws + WS_YB), WL + W_OUT, S, 1024, 1024}; E.mode = M_RES; E.br = 0; break;
            case 12: g = pg8::Gemm{XB, WL + W_UP, S, 4096, 1024}; E.mode = M_UP; break;
            default: g = pg8::Gemm{(const bf16_t*)(ws + WS_H), WL + W_DOWN, S, 1024, 4096}; E.mode = M_RES; E.br = 1; break;
            }
            pg8::StaticOrder SO; SO.init(g.M, g.N, G, cid);
            pg8::gemm_phase<Epi, pg8::StaticOrder, true, true>(lds, g, SO, E);
        }
        if (do_sync) xcd_barrier(xbar);
    }
    {
        unsigned char* ws = ws_k;
        int tidf = threadIdx.x; asm volatile("" : "+v"(tidf));
        const int lane = tidf & 63, wave = __builtin_amdgcn_readfirstlane(tidf >> 6);
        const int gw = bid * 8 + wave, ngw = G * 8;
        float* X = *(float* const*)(ws + WS_PTAB + 8);
        const unsigned long long* rsf = (const unsigned long long*)(ws + WS_RSP) + (size_t)(4 * NL) * S;
        const f32x4* gn = (const f32x4*)(ws + WS_FN) + lane;
        const bf16_t* XBf = (const bf16_t*)(ws + WS_XB);
        for (int m = gw; m < S; m += ngw) {
            f32x4* xr = (f32x4*)(X + (size_t)m * D) + lane;
            const u32x2* xb = (const u32x2*)(XBf + (size_t)m * D) + lane;
            const float rsum = (float)rsf[m] * (1.0f / 1048576.0f);
            const float rstd = 1.0f / sqrtf(rsum * (1.0f / D) + EPS);
#pragma unroll
            for (int j = 0; j < 4; ++j) { const u32x2 p = xb[64 * j]; f32x4 v = {bf_lo(p.x), bf_hi(p.x), bf_lo(p.y), bf_hi(p.y)}; v = v * rstd * gn[64 * j]; xr[64 * j] = v; }
        }
    }
}

extern "C" void kernel_launch(void* const* d_in, const int* in_sizes, int n_in, void* d_out, int out_size, void* d_ws, size_t ws_size, hipStream_t stream) {
    static int grid = 0;
    if (grid == 0) {
        int dev = 0, cus = 0, per_cu = 0;
        (void)hipGetDevice(&dev);
        (void)hipDeviceGetAttribute(&cus, hipDeviceAttributeMultiprocessorCount, dev);
        (void)hipFuncSetAttribute((const void*)fwd_mega, hipFuncAttributeMaxDynamicSharedMemorySize, LDS_BYTES);
        (void)hipOccupancyMaxActiveBlocksPerMultiprocessor(&per_cu, (const void*)fwd_mega, 512, LDS_BYTES);
        if (per_cu < 1) per_cu = 1;
        grid = cus * per_cu;
        if (grid <= 0) grid = 256;
    }
    Args a{};
    for (int i = 0; i < 21; ++i) a.in[i] = (const float*)d_in[i];
    a.out = (float*)d_out; a.ws = (unsigned char*)d_ws;
    void* args[] = {&a};
    hipError_t e = hipLaunchCooperativeKernel((void*)fwd_mega, dim3(grid), dim3(512), args, LDS_BYTES, stream);
    if (e != hipSuccess) fprintf(stderr, "cooperative launch failed: %s (grid %d)\n", hipGetErrorString(e), grid);
}
```
